# Optimizing an MI355X kernel written in HIP

```python
import math
import jax
import jax.numpy as jnp
from jax import lax
import numpy as np

D_MODEL = 1024
BATCH = 16
SEQ = 2048
DEPTH = 4

CHUNK = 64
EPS = 1e-6
N_BRANCH = 3
BRANCH_WIDTH = 512

DN_HEADS = 4
DN_DK = 128
DN_DV = 128
DN_CONV = 4
DN_QK = DN_HEADS * DN_DK
DN_VW = DN_HEADS * DN_DV
DN_QKV = 2 * DN_QK + DN_VW

RET_HEADS = 4
RET_DK = 64
RET_DV = 128
RET_QK = RET_HEADS * RET_DK
RET_VW = RET_HEADS * RET_DV
ROPE_BASE = 10000.0

LRU_WIDTH = 512
LRU_BLOCKS = 4
LRU_BLOCK = LRU_WIDTH // LRU_BLOCKS
LRU_CONV = 4
LRU_C = 8.0

D_FF = 2816
FFN_CONV = 3

IN_SIZES = (DN_QKV, DN_HEADS, DN_HEADS, DN_VW, RET_QK, RET_QK, RET_VW, RET_VW, LRU_WIDTH, LRU_WIDTH, N_BRANCH * D_MODEL)
N_IN = sum(IN_SIZES)

kernel_name = 'hybrid_deltanet_retention_rglru_convffn'


def _rms_norm(x, g):
    xf = x.astype(jnp.float32)
    y = xf * lax.rsqrt(jnp.mean(xf * xf, axis=-1, keepdims=True) + EPS)
    return (y * g.astype(jnp.float32)).astype(x.dtype)


def _l2norm(t):
    return t * lax.rsqrt(jnp.sum(t * t, axis=-1, keepdims=True) + EPS)


def _head_rms(t):
    return t * lax.rsqrt(jnp.mean(t * t, axis=-1, keepdims=True) + EPS)


def _head_groupnorm(t):
    mu = jnp.mean(t, axis=-1, keepdims=True)
    var = jnp.mean(jnp.square(t - mu), axis=-1, keepdims=True)
    return (t - mu) * lax.rsqrt(var + EPS)


def _causal_dwconv(x, w, b=None):
    width = w.shape[0]
    seq = x.shape[1]
    xp = jnp.pad(x, ((0, 0), (width - 1, 0), (0, 0)))
    y = xp[:, 0:seq, :] * w[0]
    for j in range(1, width):
        y = y + xp[:, j:j + seq, :] * w[j]
    return y if b is None else y + b


def _to_chunks(t, n):
    b, _, h, d = t.shape
    return t.reshape(b, n, CHUNK, h, d).transpose(0, 3, 1, 2, 4)


def _from_chunks(t):
    b, h, n, c, d = t.shape
    return t.transpose(0, 2, 3, 1, 4).reshape(b, n * c, h, d)


def _rotary(t, positions):
    half = t.shape[-1] // 2
    inv = ROPE_BASE ** (-jnp.arange(half, dtype=jnp.float32) / half)
    ang = positions.astype(jnp.float32)[:, :, None, None] * inv
    cos, sin = jnp.cos(ang), jnp.sin(ang)
    t1, t2 = t[..., :half], t[..., half:]
    return jnp.concatenate([t1 * cos - t2 * sin, t1 * sin + t2 * cos], axis=-1)


def _gated_delta_rule(q, k, v, g, beta):
    bsz, seq, nh, dk = q.shape
    dv = v.shape[-1]
    n = seq // CHUNK
    q = _l2norm(q) * (dk ** -0.5)
    k = _l2norm(k)
    q, k, v = _to_chunks(q, n), _to_chunks(k, n), _to_chunks(v, n)
    g = _to_chunks(g[..., None], n)[..., 0]
    beta = _to_chunks(beta[..., None], n)[..., 0]
    g = jnp.cumsum(g, axis=-1)
    causal = jnp.tril(jnp.ones((CHUNK, CHUNK), dtype=bool))
    strict = jnp.tril(jnp.ones((CHUNK, CHUNK), dtype=bool), -1)
    diff = g[..., :, None] - g[..., None, :]
    decay = jnp.where(causal, jnp.exp(jnp.where(causal, diff, 0.0)), 0.0)
    k_beta = k * beta[..., None]
    kk = jnp.einsum('bhnck,bhnsk->bhncs', k_beta, k)
    eye = jnp.eye(CHUNK, dtype=jnp.float32)
    lower = eye + jnp.where(strict, kk * decay, 0.0)
    t_inv = lax.linalg.triangular_solve(lower, jnp.broadcast_to(eye, lower.shape), left_side=True, lower=True)
    u = jnp.einsum('bhncs,bhnsv->bhncv', t_inv, v * beta[..., None])
    w = jnp.einsum('bhncs,bhnsk->bhnck', t_inv, k_beta * jnp.exp(g)[..., None])
    attn = jnp.einsum('bhnck,bhnsk->bhncs', q, k) * decay
    q_dec = q * jnp.exp(g)[..., None]
    k_dec = k * jnp.exp(g[..., -1:] - g)[..., None]
    g_end = jnp.exp(g[..., -1])

    def step(state, inp):
        qd, kd, uc, wc, ac, ge = inp
        v_new = uc - jnp.einsum('bhck,bhkv->bhcv', wc, state)
        out = jnp.einsum('bhck,bhkv->bhcv', qd, state) + jnp.einsum('bhcs,bhsv->bhcv', ac, v_new)
        state = state * ge[..., None, None] + jnp.einsum('bhck,bhcv->bhkv', kd, v_new)
        return state, out

    xs = (jnp.moveaxis(q_dec, 2, 0), jnp.moveaxis(k_dec, 2, 0), jnp.moveaxis(u, 2, 0),
          jnp.moveaxis(w, 2, 0), jnp.moveaxis(attn, 2, 0), jnp.moveaxis(g_end, 2, 0))
    s0 = jnp.zeros((bsz, nh, dk, dv), jnp.float32)
    _, out = lax.scan(step, s0, xs)
    return _from_chunks(jnp.moveaxis(out, 0, 2))


def _retention(q, k, v, log_gamma):
    bsz, seq, nh, dk = q.shape
    dv = v.shape[-1]
    n = seq // CHUNK
    k = k * (dk ** -0.5)
    q, k, v = _to_chunks(q, n), _to_chunks(k, n), _to_chunks(v, n)
    idx = jnp.arange(CHUNK, dtype=jnp.float32)
    dist = idx[:, None] - idx[None, :]
    causal = dist >= 0
    dmask = jnp.where(causal, jnp.exp(jnp.where(causal, dist, 0.0) * log_gamma[:, None, None]), 0.0)
    scores = jnp.einsum('bhnck,bhnsk->bhncs', q, k) * dmask[:, None]
    inner = jnp.einsum('bhncs,bhnsv->bhncv', scores, v)
    xi = jnp.exp((idx + 1.0) * log_gamma[:, None])
    zeta = jnp.exp((CHUNK - 1.0 - idx) * log_gamma[:, None])
    g_chunk = jnp.exp(CHUNK * log_gamma)
    kz = k * zeta[:, None, :, None]

    def step(state, inp):
        qc, kc, vc = inp
        out = jnp.einsum('bhck,bhkv->bhcv', qc, state) * xi[:, :, None]
        state = state * g_chunk[:, None, None] + jnp.einsum('bhck,bhcv->bhkv', kc, vc)
        return state, out

    s0 = jnp.zeros((bsz, nh, dk, dv), jnp.float32)
    _, cross = lax.scan(step, s0, (jnp.moveaxis(q, 2, 0), jnp.moveaxis(kz, 2, 0), jnp.moveaxis(v, 2, 0)))
    return _from_chunks(jnp.moveaxis(cross, 0, 2) + inner)


def _rg_lru(x, w_a, b_a, w_x, b_x, lam):
    bsz, seq, width = x.shape
    xb = x.reshape(bsz, seq, LRU_BLOCKS, LRU_BLOCK)
    r = jax.nn.sigmoid(jnp.einsum('btnc,ncd->btnd', xb, w_a) + b_a).reshape(bsz, seq, width)
    i = jax.nn.sigmoid(jnp.einsum('btnc,ncd->btnd', xb, w_x) + b_x).reshape(bsz, seq, width)
    log_a = -LRU_C * r * jax.nn.softplus(-lam)
    a = jnp.exp(log_a)
    b = jnp.sqrt(-jnp.expm1(2.0 * log_a)) * (i * x)

    def combine(left, right):
        a1, b1 = left
        a2, b2 = right
        return a1 * a2, a2 * b1 + b2

    _, h = lax.associative_scan(combine, (a, b), axis=1)
    return h


def _hybrid_mixer(h, positions, log_gamma, w_in, dn_conv_w, dn_a_log, dn_dt_bias, dn_norm_w,
                  lru_conv_w, lru_conv_b, lru_wa, lru_ba, lru_wx, lru_bx, lru_lambda, w_branch, w_out):
    bsz, seq, _ = h.shape
    f32 = jnp.float32
    u = h @ w_in
    split_points = [int(p) for p in np.cumsum(IN_SIZES)[:-1]]
    (a_qkv, a_alpha, a_beta, a_z, b_q, b_k, b_v, b_g, c_x, c_g, gate_logits) = jnp.split(u, split_points, axis=-1)

    a_qkv = jax.nn.silu(_causal_dwconv(a_qkv, dn_conv_w)).astype(f32)
    qa, ka, va = jnp.split(a_qkv, [DN_QK, 2 * DN_QK], axis=-1)
    qa = qa.reshape(bsz, seq, DN_HEADS, DN_DK)
    ka = ka.reshape(bsz, seq, DN_HEADS, DN_DK)
    va = va.reshape(bsz, seq, DN_HEADS, DN_DV)
    g_a = -jnp.exp(dn_a_log.astype(f32)) * jax.nn.softplus(a_alpha.astype(f32) + dn_dt_bias.astype(f32))
    beta_a = jax.nn.sigmoid(a_beta.astype(f32))
    oa = _gated_delta_rule(qa, ka, va, g_a, beta_a)
    z_a = a_z.astype(f32).reshape(bsz, seq, DN_HEADS, DN_DV)
    oa = _head_rms(oa) * dn_norm_w.astype(f32) * jax.nn.silu(z_a)
    y_a = oa.reshape(bsz, seq, DN_VW).astype(h.dtype)

    qb = _rotary(b_q.astype(f32).reshape(bsz, seq, RET_HEADS, RET_DK), positions)
    kb = _rotary(b_k.astype(f32).reshape(bsz, seq, RET_HEADS, RET_DK), positions)
    vb = b_v.astype(f32).reshape(bsz, seq, RET_HEADS, RET_DV)
    ob = _retention(qb, kb, vb, log_gamma)
    ob = _head_groupnorm(ob) * jax.nn.silu(b_g.astype(f32).reshape(bsz, seq, RET_HEADS, RET_DV))
    y_b = ob.reshape(bsz, seq, RET_VW).astype(h.dtype)

    xc = _causal_dwconv(c_x, lru_conv_w, lru_conv_b).astype(f32)
    hc = _rg_lru(xc, lru_wa.astype(f32), lru_ba.astype(f32), lru_wx.astype(f32), lru_bx.astype(f32), lru_lambda.astype(f32))
    y_c = (hc * jax.nn.gelu(c_g.astype(f32))).astype(h.dtype)

    ys = jnp.stack([y_a, y_b, y_c], axis=2)
    branch = jnp.einsum('btnw,nwd->btnd', ys, w_branch)
    gates = jax.nn.sigmoid(gate_logits.reshape(bsz, seq, N_BRANCH, D_MODEL))
    merged = jnp.sum(gates * branch, axis=2)
    return merged @ w_out


def _conv_ffn(h, w_up, conv_w, conv_b, w_down):
    up = _causal_dwconv(h @ w_up, conv_w, conv_b)
    gate, val = jnp.split(up, 2, axis=-1)
    return (jax.nn.silu(gate) * val) @ w_down


def setup_inputs(seed: int = 0) -> dict:
    key = jax.random.key(seed)
    ks = jax.random.split(key, 24)
    f32 = jnp.float32

    def nrm(k, shape, scale):
        return jax.random.normal(k, shape, f32) * scale

    x = nrm(ks[0], (BATCH, SEQ, D_MODEL), 1.0)
    offsets = jax.random.randint(ks[1], (BATCH, 1), 0, 4096, dtype=jnp.int32)
    positions = offsets + jnp.arange(SEQ, dtype=jnp.int32)[None, :]
    attn_norm = 1.0 + nrm(ks[2], (DEPTH, D_MODEL), 0.02)
    w_in = nrm(ks[3], (DEPTH, D_MODEL, N_IN), D_MODEL ** -0.5)
    dn_conv_w = nrm(ks[4], (DEPTH, DN_CONV, DN_QKV), DN_CONV ** -0.5)
    dn_a_log = jnp.log(jax.random.uniform(ks[5], (DEPTH, DN_HEADS), f32, 1.0, 16.0))
    dt = jnp.exp(jax.random.uniform(ks[6], (DEPTH, DN_HEADS), f32, math.log(0.001), math.log(0.1)))
    dn_dt_bias = dt + jnp.log(-jnp.expm1(-dt))
    dn_norm_w = 1.0 + nrm(ks[7], (DEPTH, DN_DV), 0.02)
    lru_conv_w = nrm(ks[8], (DEPTH, LRU_CONV, LRU_WIDTH), LRU_CONV ** -0.5)
    lru_conv_b = nrm(ks[9], (DEPTH, LRU_WIDTH), 0.01)
    lru_wa = nrm(ks[10], (DEPTH, LRU_BLOCKS, LRU_BLOCK, LRU_BLOCK), LRU_BLOCK ** -0.5)
    lru_ba = nrm(ks[11], (DEPTH, LRU_BLOCKS, LRU_BLOCK), 0.01)
    lru_wx = nrm(ks[12], (DEPTH, LRU_BLOCKS, LRU_BLOCK, LRU_BLOCK), LRU_BLOCK ** -0.5)
    lru_bx = nrm(ks[13], (DEPTH, LRU_BLOCKS, LRU_BLOCK), 0.01)
    a0 = jax.random.uniform(ks[14], (DEPTH, LRU_WIDTH), f32, 0.9, 0.999) ** (1.0 / LRU_C)
    lru_lambda = jnp.log(a0) - jnp.log1p(-a0)
    w_branch = nrm(ks[15], (DEPTH, N_BRANCH, BRANCH_WIDTH, D_MODEL), BRANCH_WIDTH ** -0.5)
    w_out = nrm(ks[16], (DEPTH, D_MODEL, D_MODEL), D_MODEL ** -0.5)
    ffn_norm = 1.0 + nrm(ks[17], (DEPTH, D_MODEL), 0.02)
    w_up = nrm(ks[18], (DEPTH, D_MODEL, 2 * D_FF), D_MODEL ** -0.5)
    ffn_conv_w = nrm(ks[19], (DEPTH, FFN_CONV, 2 * D_FF), FFN_CONV ** -0.5)
    ffn_conv_b = nrm(ks[20], (DEPTH, 2 * D_FF), 0.01)
    w_down = nrm(ks[21], (DEPTH, D_FF, D_MODEL), D_FF ** -0.5)
    final_norm = 1.0 + nrm(ks[22], (D_MODEL,), 0.02)
    return {'x': x, 'positions': positions, 'attn_norm': attn_norm, 'w_in': w_in, 'dn_conv_w': dn_conv_w,
            'dn_a_log': dn_a_log, 'dn_dt_bias': dn_dt_bias, 'dn_norm_w': dn_norm_w, 'lru_conv_w': lru_conv_w,
            'lru_conv_b': lru_conv_b, 'lru_wa': lru_wa, 'lru_ba': lru_ba, 'lru_wx': lru_wx, 'lru_bx': lru_bx,
            'lru_lambda': lru_lambda, 'w_branch': w_branch, 'w_out': w_out, 'ffn_norm': ffn_norm, 'w_up': w_up,
            'ffn_conv_w': ffn_conv_w, 'ffn_conv_b': ffn_conv_b, 'w_down': w_down, 'final_norm': final_norm}


def reference(x, positions, attn_norm, w_in, dn_conv_w, dn_a_log, dn_dt_bias, dn_norm_w, lru_conv_w, lru_conv_b,
              lru_wa, lru_ba, lru_wx, lru_bx, lru_lambda, w_branch, w_out, ffn_norm, w_up, ffn_conv_w, ffn_conv_b,
              w_down, final_norm):
    log_gamma = jnp.log(1.0 - 2.0 ** (-5.0 - jnp.arange(RET_HEADS, dtype=jnp.float32)))
    for layer in range(DEPTH):
        h = _rms_norm(x, attn_norm[layer])
        x = x + _hybrid_mixer(h, positions, log_gamma, w_in[layer], dn_conv_w[layer], dn_a_log[layer],
                              dn_dt_bias[layer], dn_norm_w[layer], lru_conv_w[layer], lru_conv_b[layer],
                              lru_wa[layer], lru_ba[layer], lru_wx[layer], lru_bx[layer], lru_lambda[layer],
                              w_branch[layer], w_out[layer])
        h = _rms_norm(x, ffn_norm[layer])
        x = x + _conv_ffn(h, w_up[layer], ffn_conv_w[layer], ffn_conv_b[layer], w_down[layer])
    return _rms_norm(x, final_norm)
```

```cpp
#include <hip/hip_runtime.h>
#include <hip/hip_cooperative_groups.h>
#include <cstdio>
#include <cstdint>
namespace cg = cooperative_groups;

#define LAS __attribute__((address_space(3)))
typedef unsigned short bf16_t;
typedef short bf16x8 __attribute__((ext_vector_type(8)));
typedef float f32x4 __attribute__((ext_vector_type(4)));
typedef float f32x2 __attribute__((ext_vector_type(2)));
typedef unsigned u32x4 __attribute__((ext_vector_type(4)));
typedef unsigned u32x2 __attribute__((ext_vector_type(2)));

constexpr int MTOK = 32768, DM = 1024, SEQ = 2048, NU = 4608, NG = 3072, NIN = 7688, DFF = 2816, NUP = 5632, DEPTH = 4;
constexpr float EPS = 1e-6f;
constexpr size_t MiB = 1u << 20;
constexpr size_t WS_ROWSQ = 0;
constexpr size_t WS_AB = 2 * MiB;
constexpr size_t WS_STA = 3 * MiB;
constexpr size_t WS_STB = 5 * MiB;
constexpr size_t WS_WAB = 9 * MiB;
constexpr size_t WS_BAR = 9 * MiB + 65536;
constexpr size_t WS_U0 = 9 * MiB + 131072;
constexpr size_t WS_XB = 10 * MiB;
constexpr size_t WS_W = 74 * MiB;
constexpr size_t WS_U = 112 * MiB;
constexpr size_t WS_ROT = 496 * MiB;
constexpr size_t WS_Y = 400 * MiB;
constexpr size_t W_IN = 0, W_G = W_IN + (size_t)NU * 1024, W_B = W_G + (size_t)NG * 1024, W_O = W_B + (size_t)3 * 1024 * 512,
                 W_UP = W_O + (size_t)1024 * 1024, W_DN = W_UP + (size_t)NUP * 1024;

struct Params {
    const float* x; const int* pos; const float* attn_norm; const float* w_in; const float* dn_conv_w; const float* dn_a_log; const float* dn_dt_bias; const float* dn_norm_w;
    const float* lru_conv_w; const float* lru_conv_b; const float* lru_wa; const float* lru_ba; const float* lru_wx; const float* lru_bx; const float* lru_lambda;
    const float* w_branch; const float* w_out; const float* ffn_norm; const float* w_up; const float* ffn_conv_w; const float* ffn_conv_b; const float* w_down; const float* final_norm;
    float* out; unsigned char* ws;
};


__device__ __forceinline__ int opaque0() { int z; asm volatile("v_mov_b32 %0, 0" : "=v"(z)); return z; }
constexpr int LDS_PARAMS = 163328;
__device__ __forceinline__ const void* ldptr(LAS const unsigned* lp, int i) {
    const unsigned lo = __builtin_amdgcn_readfirstlane(lp[2 * i]), hi = __builtin_amdgcn_readfirstlane(lp[2 * i + 1]);
    typedef const __attribute__((address_space(1))) unsigned char* gptr_t;
    return (const void*)(gptr_t)(((unsigned long long)hi << 32) | lo);
}
__device__ __forceinline__ Params ldp(LAS const unsigned char* ldsbase) {
    LAS const unsigned* lp = (LAS const unsigned*)(ldsbase + LDS_PARAMS + opaque0());
    Params p;
    p.x = (const float*)ldptr(lp, 0); p.pos = (const int*)ldptr(lp, 1); p.attn_norm = (const float*)ldptr(lp, 2); p.w_in = (const float*)ldptr(lp, 3); p.dn_conv_w = (const float*)ldptr(lp, 4);
    p.dn_a_log = (const float*)ldptr(lp, 5); p.dn_dt_bias = (const float*)ldptr(lp, 6); p.dn_norm_w = (const float*)ldptr(lp, 7); p.lru_conv_w = (const float*)ldptr(lp, 8); p.lru_conv_b = (const float*)ldptr(lp, 9);
    p.lru_wa = (const float*)ldptr(lp, 10); p.lru_ba = (const float*)ldptr(lp, 11); p.lru_wx = (const float*)ldptr(lp, 12); p.lru_bx = (const float*)ldptr(lp, 13); p.lru_lambda = (const float*)ldptr(lp, 14);
    p.w_branch = (const float*)ldptr(lp, 15); p.w_out = (const float*)ldptr(lp, 16); p.ffn_norm = (const float*)ldptr(lp, 17); p.w_up = (const float*)ldptr(lp, 18); p.ffn_conv_w = (const float*)ldptr(lp, 19);
    p.ffn_conv_b = (const float*)ldptr(lp, 20); p.w_down = (const float*)ldptr(lp, 21); p.final_norm = (const float*)ldptr(lp, 22); p.out = (float*)ldptr(lp, 23); p.ws = (unsigned char*)ldptr(lp, 24);
    return p;
}
__device__ __forceinline__ void stp(LAS unsigned char* ldsbase, const Params& p) {
    LAS unsigned long long* lp = (LAS unsigned long long*)(ldsbase + LDS_PARAMS);
    lp[0] = (unsigned long long)p.x; lp[1] = (unsigned long long)p.pos; lp[2] = (unsigned long long)p.attn_norm; lp[3] = (unsigned long long)p.w_in; lp[4] = (unsigned long long)p.dn_conv_w;
    lp[5] = (unsigned long long)p.dn_a_log; lp[6] = (unsigned long long)p.dn_dt_bias; lp[7] = (unsigned long long)p.dn_norm_w; lp[8] = (unsigned long long)p.lru_conv_w; lp[9] = (unsigned long long)p.lru_conv_b;
    lp[10] = (unsigned long long)p.lru_wa; lp[11] = (unsigned long long)p.lru_ba; lp[12] = (unsigned long long)p.lru_wx; lp[13] = (unsigned long long)p.lru_bx; lp[14] = (unsigned long long)p.lru_lambda;
    lp[15] = (unsigned long long)p.w_branch; lp[16] = (unsigned long long)p.w_out; lp[17] = (unsigned long long)p.ffn_norm; lp[18] = (unsigned long long)p.w_up; lp[19] = (unsigned long long)p.ffn_conv_w;
    lp[20] = (unsigned long long)p.ffn_conv_b; lp[21] = (unsigned long long)p.w_down; lp[22] = (unsigned long long)p.final_norm; lp[23] = (unsigned long long)p.out; lp[24] = (unsigned long long)p.ws;
}
__device__ __forceinline__ int lane_fresh() { int l; asm volatile("v_mbcnt_lo_u32_b32 %0, -1, 0\n\tv_mbcnt_hi_u32_b32 %0, -1, %0" : "=&v"(l)); return l; }
#define TIDX ((wv_ << 6) + lane_fresh())
__device__ __forceinline__ float opaque0_after(float dep) { float z; asm volatile("v_mov_b32 %0, 0" : "=v"(z) : "v"(dep)); return z; }
__device__ __forceinline__ float bflo(unsigned u) { return __uint_as_float(u << 16); }
__device__ __forceinline__ float bfhi(unsigned u) { return __uint_as_float(u & 0xffff0000u); }
typedef __bf16 bf16x2_t __attribute__((ext_vector_type(2)));
__device__ __forceinline__ unsigned cvt_pk_bf16(float lo, float hi) { const f32x2 v = {lo, hi}; return __builtin_bit_cast(unsigned, __builtin_convertvector(v, bf16x2_t)); }
__device__ __forceinline__ float sigmoidf_(float x) { return __builtin_amdgcn_rcpf(1.f + __expf(-x)); }
__device__ __forceinline__ float siluf_(float x) { return x * __builtin_amdgcn_rcpf(1.f + __expf(-x)); }
__device__ __forceinline__ float softplusf_(float x) { return fmaxf(x, 0.f) + log1pf(__expf(-fabsf(x))); }
__device__ __forceinline__ float gelu_tanh(float x) { const float u = 0.7978845608028654f * (x + 0.044715f * x * x * x); return x * __builtin_amdgcn_rcpf(1.f + __expf(-2.f * u)); }
template <int CTRL> __device__ __forceinline__ float dppmov(float v) { return __int_as_float(__builtin_amdgcn_update_dpp(0, __float_as_int(v), CTRL, 0xf, 0xf, true)); }
__device__ __forceinline__ float allreduce16(float x) {
    x += dppmov<0xB1>(x); x += dppmov<0x4E>(x); x += dppmov<0x141>(x); x += dppmov<0x140>(x); return x;
}
__device__ __forceinline__ float row_rs(const float* rowsq, int row) { const f32x4 q = *(const f32x4*)(rowsq + (size_t)row * 4); return rsqrtf(((q[0] + q[1]) + (q[2] + q[3])) * (1.0f / 1024.0f) + EPS); }

constexpr int BM = 256, BK = 64, HALF = 128, HTB = HALF * BK * 2, STAGE_BYTES = 8 * HTB, NXCD = 8, WGM = 8;
__device__ __forceinline__ int lds_byte(int r, int c) { const int st = (r >> 4) * 2 + (c >> 5), rr = r & 15, cc = c & 31, ob = rr * 64 + cc * 2; return st * 1024 + (ob ^ (((ob >> 9) & 1) << 5)); }
__device__ __forceinline__ void stage_rc(int b, int& R, int& C) { const int st = b / 1024, sb = b % 1024, swz = sb ^ (((sb >> 9) & 1) << 5); R = (st >> 1) * 16 + swz / 64; C = (st & 1) * 32 + (swz % 64) / 2; }
__device__ __forceinline__ int perm32(int rho) { const int n = rho >> 4, i = rho & 15; return 8 * (i >> 2) + 4 * n + (i & 3); }
struct Unit { int pm, pn, aux; };

struct StaticOrder {
    const char* A; const char* B; int nM, nN, nwg, G, c; size_t tstep;
    __device__ void init(const void* A_, const void* B_, int M, int N, int K, int G_, int c_) { A = (const char*)A_; B = (const char*)B_; nM = M / BM; nN = N / BM; nwg = nM * nN; G = G_; c = c_; tstep = (size_t)BM * K * 2; }
    __device__ __forceinline__ bool next(int i, Unit& u) const {
        const long L = (long)i * G + c; if (L >= nwg) return false;
        int wgid = (int)L; { const int q = nwg / NXCD, r = nwg % NXCD, xcd = wgid % NXCD, off = wgid / NXCD; wgid = (xcd < r ? xcd * (q + 1) : r * (q + 1) + (xcd - r) * q) + off; }
        const int nig = WGM * nN, gid = wgid / nig, fm = gid * WGM, gsz = (nM - fm) < WGM ? (nM - fm) : WGM;
        u.pm = fm + ((wgid % nig) % gsz); u.pn = (wgid % nig) / gsz; u.aux = 0; return true;
    }
    __device__ __forceinline__ void ptrs(const Unit& u, const char*& a, const char*& b) const { a = A + (size_t)u.pm * tstep; b = B + (size_t)u.pn * tstep; }
};
struct BranchOrder {
    const char* Y; const char* Wb; int G, c;
    __device__ __forceinline__ bool next(int i, Unit& u) const {
        const int tile = c + G * (i / 3); if (tile >= 512) return false;
        u.pm = tile >> 2; u.pn = tile & 3; u.aux = i % 3; return true;
    }
    __device__ __forceinline__ void ptrs(const Unit& u, const char*& a, const char*& b) const {
        a = Y + (size_t)u.aux * ((size_t)MTOK * 512 * 2) + (size_t)u.pm * (256 * 512 * 2);
        b = Wb + (size_t)u.aux * ((size_t)1024 * 512 * 2) + (size_t)u.pn * (256 * 512 * 2);
    }
};

template <class Epi, class Sched>
__device__ __forceinline__ void gemm_phase(LAS unsigned char* lds, const int K, const Sched& S, const Epi& E, const int wv_) {
    const int tid = TIDX, wid = __builtin_amdgcn_readfirstlane(tid >> 6), lane = tid & 63, wr = wid >> 2, wc = wid & 3, fr = lane & 15, fq = lane >> 4;
    const int nt = K / BK;
    unsigned voffA[2], voffB[2];
#pragma unroll
    for (int i = 0; i < 2; ++i) { int R, C; stage_rc(tid * 16 + i * 8192, R, C); const int Rb = Epi::PERM ? ((R & ~31) + perm32(R & 31)) : R;
        voffA[i] = (unsigned)(R * K + C) * 2u; voffB[i] = (unsigned)(Rb * K + C) * 2u; }
    const size_t kstep = (size_t)(BK * 2);
    const size_t hstep = (size_t)HALF * K * 2;
    const unsigned ldsw = (unsigned)wid * 1024u;
    const int aoff = lds_byte(wr * 64 + fr, fq * 8), boff = lds_byte(wc * 32 + fr, fq * 8);
#define PG8_SA(b, h) (((b) * 2 + (h)) * HTB)
#define PG8_SB(b, h) ((4 + (b) * 2 + (h)) * HTB)
#define PG8_STAGE(bufoff, gbase, voff) do { _Pragma("unroll") for (int _i = 0; _i < 2; ++_i) \
        __builtin_amdgcn_global_load_lds((const unsigned*)((const char*)(gbase) + (voff)[_i]), (LAS unsigned*)(lds + (bufoff) + ldsw + _i * 8192), 16, 0, 0); } while (0)
#define PG8_LDA(dst, b, h) do { _Pragma("unroll") for (int m = 0; m < 4; ++m) _Pragma("unroll") for (int k = 0; k < 2; ++k) dst[m][k] = *(const LAS bf16x8*)(lds + PG8_SA(b, h) + aoff + m * 2048 + k * 1024); } while (0)
#define PG8_LDB(dst, b, h) do { _Pragma("unroll") for (int n = 0; n < 2; ++n) _Pragma("unroll") for (int k = 0; k < 2; ++k) dst[n][k] = *(const LAS bf16x8*)(lds + PG8_SB(b, h) + boff + n * 2048 + k * 1024); } while (0)
#define PG8_MMA(ai, bj, At, Bt) do { __builtin_amdgcn_s_setprio(1); _Pragma("unroll") for (int m = 0; m < 4; ++m) _Pragma("unroll") for (int n = 0; n < 2; ++n) _Pragma("unroll") for (int k = 0; k < 2; ++k) \
        acc[ai][bj][m][n] = __builtin_amdgcn_mfma_f32_16x16x32_bf16(Bt[n][k], At[m][k], acc[ai][bj][m][n], 0, 0, 0); __builtin_amdgcn_s_setprio(0); } while (0)
#define PG8_WAIT_V(n) asm volatile("s_waitcnt vmcnt(" #n ")" ::: "memory")
#define PG8_WAIT_L(n) asm volatile("s_waitcnt lgkmcnt(" #n ")" ::: "memory")
#define PG8_BAR __builtin_amdgcn_s_barrier()
#define PG8_SCHED __builtin_amdgcn_sched_barrier(0)
    Unit cur, nxt; int ui = 0;
    if (!S.next(0, cur)) return;
    f32x4 acc[2][2][4][2];
#pragma unroll
    for (int a = 0; a < 2; ++a)
#pragma unroll
        for (int b = 0; b < 2; ++b)
#pragma unroll
            for (int m = 0; m < 4; ++m)
#pragma unroll
                for (int n = 0; n < 2; ++n) acc[a][b][m][n] = (f32x4){0.f, 0.f, 0.f, 0.f};
    bf16x8 At[4][2], B0[2][2], B1[2][2];
    const char* cA; const char* cB; S.ptrs(cur, cA, cB);
    PG8_STAGE(PG8_SB(0, 0), cB, voffB); PG8_STAGE(PG8_SB(0, 1), cB + hstep, voffB); PG8_STAGE(PG8_SA(0, 0), cA, voffA); PG8_STAGE(PG8_SA(0, 1), cA + hstep, voffA);
    if (wr == 1) PG8_BAR;
    PG8_WAIT_V(2); PG8_BAR;
    PG8_STAGE(PG8_SB(1, 0), cB + kstep, voffB); PG8_STAGE(PG8_SA(1, 0), cA + kstep, voffA); PG8_STAGE(PG8_SB(1, 1), cB + hstep + kstep, voffB);
    PG8_WAIT_V(6); PG8_BAR;
    for (;;) {
        const bool has_next = S.next(ui + 1, nxt);
        const char* nA = cA; const char* nB = cB; if (has_next) S.ptrs(nxt, nA, nB);
        for (int t = 0; t < nt; t += 2) {
            const bool last = (t == nt - 2);
            const char* a1 = cA + (size_t)(t + 1) * kstep;
            const char* a2 = last ? nA : cA + (size_t)(t + 2) * kstep; const char* b2 = last ? nB : cB + (size_t)(t + 2) * kstep;
            const char* a3 = a2 + kstep; const char* b3 = b2 + kstep;
            PG8_LDB(B0, 0, 0); PG8_LDB(B1, 0, 1); PG8_SCHED; PG8_LDA(At, 0, 0); PG8_STAGE(PG8_SA(1, 1), a1 + hstep, voffA);
            PG8_WAIT_V(8); PG8_WAIT_L(0); PG8_BAR; PG8_MMA(0, 0, At, B0); PG8_MMA(0, 1, At, B1); PG8_BAR; PG8_SCHED;
            PG8_LDA(At, 0, 1); PG8_STAGE(PG8_SB(0, 0), b2, voffB); PG8_STAGE(PG8_SB(0, 1), b2 + hstep, voffB); PG8_STAGE(PG8_SA(0, 0), a2, voffA);
            PG8_WAIT_V(8); PG8_WAIT_L(0); PG8_BAR; PG8_MMA(1, 0, At, B0); PG8_MMA(1, 1, At, B1); PG8_BAR; PG8_SCHED;
            PG8_LDB(B0, 1, 0); PG8_LDB(B1, 1, 1); PG8_SCHED; PG8_LDA(At, 1, 0); PG8_STAGE(PG8_SA(0, 1), a2 + hstep, voffA);
            PG8_WAIT_V(8); PG8_WAIT_L(0); PG8_BAR; PG8_MMA(0, 0, At, B0); PG8_MMA(0, 1, At, B1); PG8_BAR; PG8_SCHED;
            PG8_LDA(At, 1, 1); PG8_STAGE(PG8_SB(1, 0), b3, voffB); PG8_STAGE(PG8_SB(1, 1), b3 + hstep, voffB); PG8_STAGE(PG8_SA(1, 0), a3, voffA);
            PG8_WAIT_V(8); PG8_WAIT_L(0); PG8_BAR; PG8_MMA(1, 0, At, B0); PG8_MMA(1, 1, At, B1); PG8_BAR; PG8_SCHED;
        }
        if (wr == 0) PG8_BAR;
        E(acc, cur, wv_);
        if (!has_next) break;
#pragma unroll
        for (int a = 0; a < 2; ++a)
#pragma unroll
            for (int b = 0; b < 2; ++b)
#pragma unroll
                for (int m = 0; m < 4; ++m)
#pragma unroll
                    for (int n = 0; n < 2; ++n) acc[a][b][m][n] = (f32x4){0.f, 0.f, 0.f, 0.f};
        cur = nxt; cA = nA; cB = nB; ++ui;
        if (wr == 1) PG8_BAR;
    }
    PG8_WAIT_V(0);
    PG8_BAR;
#undef PG8_SA
#undef PG8_SB
#undef PG8_STAGE
#undef PG8_LDA
#undef PG8_LDB
#undef PG8_MMA
#undef PG8_WAIT_V
#undef PG8_WAIT_L
#undef PG8_BAR
#undef PG8_SCHED
}

#define EPI_FENCE __builtin_amdgcn_sched_barrier(0)
template <int ACT> struct EpiScale {
    static constexpr bool PERM = true;
    bf16_t* O; int ldc; const float* rowsq;
    __device__ __forceinline__ void operator()(f32x4 (&acc)[2][2][4][2], const Unit& u, const int wv_) const {
        const int lane_ = TIDX & 63, wr = wv_ >> 2, wc = wv_ & 3, fr = lane_ & 15, fq = lane_ >> 4;
        const int row0 = u.pm * BM + wr * 64 + fr + opaque0(), col0 = u.pn * BM + wc * 32 + 8 * fq;
#pragma unroll
        for (int ai = 0; ai < 2; ++ai) {
            float rs[4];
#pragma unroll
            for (int m = 0; m < 4; ++m) rs[m] = row_rs(rowsq, row0 + ai * HALF + m * 16);
            EPI_FENCE;
#pragma unroll
            for (int m = 0; m < 4; ++m) {
                const int row = row0 + ai * HALF + m * 16;
                bf16_t* rowp = O + (size_t)row * ldc + col0;
#pragma unroll
                for (int bj = 0; bj < 2; ++bj) {
                    f32x4 v0 = acc[ai][bj][m][0] * rs[m], v1 = acc[ai][bj][m][1] * rs[m];
                    if (ACT == 1) {
#pragma unroll
                        for (int j = 0; j < 4; ++j) { v0[j] = sigmoidf_(v0[j]); v1[j] = sigmoidf_(v1[j]); } }
                    u32x4 w; w.x = cvt_pk_bf16(v0[0], v0[1]); w.y = cvt_pk_bf16(v0[2], v0[3]); w.z = cvt_pk_bf16(v1[0], v1[1]); w.w = cvt_pk_bf16(v1[2], v1[3]);
                    *(u32x4*)(rowp + bj * HALF) = w; }
            }
            EPI_FENCE;
        }
    }
};
struct EpiMerge {
    static constexpr bool PERM = true;
    const bf16_t* gates; float* scratch; bf16_t* merged;
    __device__ __forceinline__ void operator()(f32x4 (&acc)[2][2][4][2], const Unit& u, const int wv_) const {
        const int tid_ = TIDX, lane_ = tid_ & 63, wr = wv_ >> 2, wc = wv_ & 3, fr = lane_ & 15, fq = lane_ >> 4;
        const int n = u.aux; const int row0 = u.pm * BM + wr * 64 + fr + opaque0(), col0 = u.pn * BM + wc * 32 + 8 * fq;
        char* sb = (char*)scratch; const unsigned so = (unsigned)tid_ * 16u;
#pragma unroll
        for (int ai = 0; ai < 2; ++ai)
#pragma unroll
            for (int m = 0; m < 4; ++m) {
                const int row = row0 + ai * HALF + m * 16;
#pragma unroll
                for (int bj = 0; bj < 2; ++bj) {
                    const u32x4 g = *(const u32x4*)(gates + (size_t)row * NG + n * 1024 + col0 + bj * HALF);
                    f32x4 p0 = acc[ai][bj][m][0], p1 = acc[ai][bj][m][1];
                    p0[0] *= bflo(g.x); p0[1] *= bfhi(g.x); p0[2] *= bflo(g.y); p0[3] *= bfhi(g.y);
                    p1[0] *= bflo(g.z); p1[1] *= bfhi(g.z); p1[2] *= bflo(g.w); p1[3] *= bfhi(g.w);
                    const unsigned o0 = so + (unsigned)((ai * 2 + bj) * 4 + m) * 8192u;
                    if (n > 0) { const u32x4 t = *(const u32x4*)(sb + o0);
                        p0[0] += bflo(t.x); p0[1] += bfhi(t.x); p0[2] += bflo(t.y); p0[3] += bfhi(t.y); p1[0] += bflo(t.z); p1[1] += bfhi(t.z); p1[2] += bflo(t.w); p1[3] += bfhi(t.w); }
                    if (n < 2) { u32x4 t; t.x = cvt_pk_bf16(p0[0], p0[1]); t.y = cvt_pk_bf16(p0[2], p0[3]); t.z = cvt_pk_bf16(p1[0], p1[1]); t.w = cvt_pk_bf16(p1[2], p1[3]); *(u32x4*)(sb + o0) = t; }
                    else { u32x4 w; w.x = cvt_pk_bf16(p0[0], p0[1]); w.y = cvt_pk_bf16(p0[2], p0[3]); w.z = cvt_pk_bf16(p1[0], p1[1]); w.w = cvt_pk_bf16(p1[2], p1[3]);
                        *(u32x4*)(merged + (size_t)row * DM + col0 + bj * HALF) = w; }
                }
                EPI_FENCE;
            }
    }
};
struct EpiResid {
    static constexpr bool PERM = false;
    const float* xin; float* xout; bf16_t* xb; float* rowsq; LAS float* ex;
    __device__ __forceinline__ void operator()(f32x4 (&acc)[2][2][4][2], const Unit& u, const int wv_) const {
        const int tid_ = TIDX, lane_ = tid_ & 63, wr = wv_ >> 2, wc = wv_ & 3, fr = lane_ & 15, fq = lane_ >> 4;
        const int row0 = u.pm * BM + wr * 64 + fr + opaque0(), col0 = u.pn * BM + wc * 32 + 4 * fq;
#pragma unroll
        for (int ai = 0; ai < 2; ++ai)
#pragma unroll
            for (int m = 0; m < 4; ++m) {
                const int row = row0 + ai * HALF + m * 16; float ss = 0.f;
#pragma unroll
                for (int bj = 0; bj < 2; ++bj)
#pragma unroll
                    for (int n = 0; n < 2; ++n) {
                        const size_t o = (size_t)row * DM + col0 + bj * HALF + n * 16;
                        const f32x4 xn = *(const f32x4*)(xin + o) + acc[ai][bj][m][n];
                        *(f32x4*)(xout + o) = xn;
                        ss += (xn[0] * xn[0] + xn[1] * xn[1]) + (xn[2] * xn[2] + xn[3] * xn[3]);
                        u32x2 w; w.x = cvt_pk_bf16(xn[0], xn[1]); w.y = cvt_pk_bf16(xn[2], xn[3]); *(u32x2*)(xb + o) = w;
                    }
                ss += __shfl_xor(ss, 16); ss += __shfl_xor(ss, 32);
                if (fq == 0) ex[(ai * HALF + wr * 64 + m * 16 + fr) * 4 + wc] = ss;
                if (m & 1) EPI_FENCE;
            }
        asm volatile("s_waitcnt lgkmcnt(0)" ::: "memory"); __builtin_amdgcn_s_barrier(); asm volatile("" ::: "memory");
        if (tid_ < 256) { const f32x4 q = *(LAS f32x4*)(ex + tid_ * 4); rowsq[(size_t)(u.pm * BM + tid_) * 4 + u.pn] = (q[0] + q[1]) + (q[2] + q[3]); }
    }
};
struct EpiFfn {
    static constexpr bool PERM = false;
    bf16_t* act; const float* rowsq; const float* cw; const float* cb; float* side;
    __device__ __forceinline__ void operator()(f32x4 (&acc)[2][2][4][2], const Unit& u, const int wv_) const {
        const int lane_ = TIDX & 63, wr = wv_ >> 2, wc = wv_ & 3, fr = lane_ & 15, fq = lane_ >> 4;
        const int row0 = u.pm * BM + wr * 64 + fr + opaque0();
        float rs[2][4];
#pragma unroll
        for (int ai = 0; ai < 2; ++ai)
#pragma unroll
            for (int m = 0; m < 4; ++m) rs[ai][m] = row_rs(rowsq, row0 + ai * HALF + m * 16);
        EPI_FENCE;
        float chain = rs[0][0];
#pragma unroll
        for (int nn = 0; nn < 2; ++nn) {
#pragma unroll
            for (int hf = 0; hf < 2; ++hf) {
                const int ch0 = hf * DFF + u.pn * 128 + wc * 32 + 16 * nn + 4 * fq + __float_as_int(opaque0_after(chain));
                const f32x4 w0 = *(const f32x4*)(cw + ch0), w1 = *(const f32x4*)(cw + NUP + ch0), w2 = *(const f32x4*)(cw + 2 * NUP + ch0), wb = *(const f32x4*)(cb + ch0);
                const int fr2 = fr + __float_as_int(opaque0_after(chain));
                if (fr2 < 2 || fr2 >= 14) {
                    const int slot = fr2 < 2 ? fr2 : fr2 - 12;
#pragma unroll
                    for (int ai = 0; ai < 2; ++ai) {
                        const int blk = u.pm * 4 + ai * 2 + wr;
                        const f32x4 xe = fr2 < 2 ? acc[ai][hf][0][nn] * rs[ai][0] : acc[ai][hf][3][nn] * rs[ai][3];
                        *(f32x4*)((char*)side + (unsigned)(((blk * 4 + slot) * NUP + ch0) * 4)) = xe;
                    }
                }
                EPI_FENCE;
#pragma unroll
                for (int ai = 0; ai < 2; ++ai) {
                    f32x4 p1 = (f32x4){0.f, 0.f, 0.f, 0.f}, p2 = p1;
#pragma unroll
                    for (int m = 0; m < 4; ++m) {
                        const float rsm = rs[ai][m] + ((m & 1) ? 0.f : opaque0_after(chain));
                        f32x4 r1, r2, res;
#pragma unroll
                        for (int j = 0; j < 4; ++j) {
                            const float x = acc[ai][hf][m][nn][j] * rsm;
                            r1[j] = dppmov<0x121>(x); r2[j] = dppmov<0x122>(x);
                            const float q1 = fr >= 1 ? r1[j] : p1[j], q2 = fr >= 2 ? r2[j] : p2[j];
                            const float pre = w2[j] * x + w1[j] * q1 + w0[j] * q2 + wb[j];
                            res[j] = (hf == 0) ? siluf_(pre) : acc[ai][0][m][nn][j] * pre;
                        }
                        chain = res[3];
                        if (hf == 0) acc[ai][0][m][nn] = res;
                        else {
                            u32x2 w; w.x = cvt_pk_bf16(res[0], res[1]); w.y = cvt_pk_bf16(res[2], res[3]);
                            *(u32x2*)((char*)act + (unsigned)(((row0 + ai * HALF + m * 16) * DFF + (ch0 - DFF)) * 2)) = w;
                        }
                        p1 = r1; p2 = r2;
                    }
                }
            }
        }
    }
};

__device__ __forceinline__ int srccol(int map, int s0, int n) {
    if (map == 1) return n < 1536 ? n : n + 8;
    if (map == 2) return ((n >> 7) & 1) * DFF + (n >> 8) * 128 + (n & 127);
    return s0 + n;
}
__device__ void prep_w(LAS float* L, bf16_t* dst, const float* src, int K, int N, int ld, int s0, int map, const float* g, int& off, const int wv_) {
    const int G = gridDim.x, c = blockIdx.x, tid = TIDX;
    const int nkt = K >> 6, ntiles = (N >> 6) * nkt;
    const int i0 = tid >> 6, j = tid & 63, nn = tid >> 3, kc = tid & 7;
    float r[8];
#define PREP_LOAD(T) do { const int n0_ = ((T) / nkt) << 6, k0_ = ((T) % nkt) << 6; const int col_ = srccol(map, s0, n0_) + j; \
        _Pragma("unroll") for (int pp = 0; pp < 8; ++pp) { const int k_ = k0_ + i0 + 8 * pp; float v_ = src[(size_t)k_ * ld + col_]; if (g) v_ *= g[k_]; r[pp] = v_; } } while (0)
    int t = (c + G - off % G) % G;
    if (t < ntiles) PREP_LOAD(t);
    for (; t < ntiles; t += G) {
        const int n0 = (t / nkt) << 6, k0 = (t % nkt) << 6;
#pragma unroll
        for (int pp = 0; pp < 8; ++pp) L[(i0 + 8 * pp) * 65 + j] = r[pp];
        __syncthreads();
        if (t + G < ntiles) PREP_LOAD(t + G);
        u32x4 w;
        w.x = cvt_pk_bf16(L[(kc * 8 + 0) * 65 + nn], L[(kc * 8 + 1) * 65 + nn]); w.y = cvt_pk_bf16(L[(kc * 8 + 2) * 65 + nn], L[(kc * 8 + 3) * 65 + nn]);
        w.z = cvt_pk_bf16(L[(kc * 8 + 4) * 65 + nn], L[(kc * 8 + 5) * 65 + nn]); w.w = cvt_pk_bf16(L[(kc * 8 + 6) * 65 + nn], L[(kc * 8 + 7) * 65 + nn]);
        *(u32x4*)(dst + (size_t)(n0 + nn) * K + k0 + kc * 8) = w;
        __syncthreads();
    }
#undef PREP_LOAD
    off += ntiles;
}
__device__ void prep_layer_main(const Params& p, int l, LAS float* L, const int wv_) {
    bf16_t* W = (bf16_t*)(p.ws + WS_W); int off = 0;
    const float* win = p.w_in + (size_t)l * 1024 * NIN; const float* gn = p.attn_norm + l * 1024;
    prep_w(L, W + W_IN, win, 1024, NU, NIN, 0, 1, gn, off, wv_);
    prep_w(L, W + W_G, win, 1024, NG, NIN, 4616, 0, gn, off, wv_);
    for (int n = 0; n < 3; ++n) prep_w(L, W + W_B + (size_t)n * 1024 * 512, p.w_branch + ((size_t)l * 3 + n) * 512 * 1024, 512, 1024, 1024, 0, 0, nullptr, off, wv_);
    prep_w(L, W + W_O, p.w_out + (size_t)l * 1024 * 1024, 1024, 1024, 1024, 0, 0, nullptr, off, wv_);
    prep_w(L, W + W_UP, p.w_up + (size_t)l * 1024 * NUP, 1024, NUP, NUP, 0, 2, p.ffn_norm + l * 1024, off, wv_);
    bf16_t* wab = (bf16_t*)(p.ws + WS_WAB);
    for (int i0 = blockIdx.x * 512; i0 < 8192; i0 += gridDim.x * 512) { const int i = i0 + TIDX; const int jj = i >> 10, k = i & 1023; const float wv = win[(size_t)k * NIN + 1536 + jj] * gn[k];
        const unsigned hi = cvt_pk_bf16(wv, 0.f) & 0xffffu; const float lo = wv - bflo(hi); wab[jj * 1024 + k] = (bf16_t)hi; wab[(8 + jj) * 1024 + k] = (bf16_t)(cvt_pk_bf16(lo, 0.f) & 0xffffu); }
}
__device__ void prep_layer_down(const Params& p, int l, LAS float* L, const int wv_) {
    bf16_t* W = (bf16_t*)(p.ws + WS_W); int off = 0;
    prep_w(L, W + W_DN, p.w_down + (size_t)l * DFF * 1024, DFF, 1024, 1024, 0, 0, nullptr, off, wv_);
}

__device__ void rownorm(const Params& p, const float* src, float* rowsq, const int wv_) {
    const int tid = TIDX, lane = tid & 63, gw = blockIdx.x * 8 + (tid >> 6), nw = gridDim.x * 8;
    bf16_t* xb = (bf16_t*)(p.ws + WS_XB);
    for (int row = gw; row < MTOK; row += nw) {
        float ss = 0.f;
#pragma unroll
        for (int i = 0; i < 4; ++i) { const size_t o = (size_t)row * DM + i * 256 + lane * 4; const f32x4 v = *(const f32x4*)(src + o);
            ss += (v[0] * v[0] + v[1] * v[1]) + (v[2] * v[2] + v[3] * v[3]); u32x2 w; w.x = cvt_pk_bf16(v[0], v[1]); w.y = cvt_pk_bf16(v[2], v[3]); *(u32x2*)(xb + o) = w; }
#pragma unroll
        for (int s = 32; s >= 1; s >>= 1) ss += __shfl_xor(ss, s);
        if (lane == 0) *(f32x4*)(rowsq + (size_t)row * 4) = (f32x4){ss, 0.f, 0.f, 0.f};
    }
}

__device__ void rot_table(const Params& p, const int wv_) {
    const int t_ = TIDX; float* tab = (float*)(p.ws + WS_ROT);
    for (int i0 = blockIdx.x * 512; i0 < MTOK * 32; i0 += gridDim.x * 512) {
        const int i = i0 + t_, token = i >> 5, j = i & 31;
        const float inv = (float)pow(10000.0, -(double)j / 32.0); float sn, cs; sincosf((float)p.pos[token] * inv, &sn, &cs);
        *(f32x2*)(tab + (size_t)i * 2) = (f32x2){cs, sn};
    }
}
__device__ void ab_tail(const Params& p, const int wv_) {
    const int tid = TIDX, lane = tid & 63, gw = blockIdx.x * 8 + (tid >> 6), nw = gridDim.x * 8, r16 = lane & 15, kq = lane >> 4;
    const bf16_t* xb = (const bf16_t*)(p.ws + WS_XB); const float* rowsq = (const float*)(p.ws + WS_ROWSQ + MiB); const bf16_t* wab = (const bf16_t*)(p.ws + WS_WAB); float* ab = (float*)(p.ws + WS_AB);
    for (int rb = gw; rb < MTOK / 16; rb += nw) {
        const bf16_t* ap = xb + (size_t)(rb * 16 + r16) * DM + kq * 8; const bf16_t* bp = wab + r16 * 1024 + kq * 8;
        f32x4 acc = (f32x4){0.f, 0.f, 0.f, 0.f};
#pragma unroll 8
        for (int kk = 0; kk < 32; ++kk) acc = __builtin_amdgcn_mfma_f32_16x16x32_bf16(*(const bf16x8*)(ap + kk * 32), *(const bf16x8*)(bp + kk * 32), acc, 0, 0, 0);
#pragma unroll
        for (int j = 0; j < 4; ++j) { const float v = acc[j] + __shfl_xor(acc[j], 8); const int row = rb * 16 + kq * 4 + j; if (r16 < 8) ab[(size_t)row * 8 + r16] = v * row_rs(rowsq, row); }
    }
}

__device__ void u0_tail(const Params& p, int layer, LAS float* L, const int wv_) {
    const int tid = TIDX;
    if ((int)blockIdx.x >= 192) return;
    const int cgp = (int)blockIdx.x % 24, ksl = (int)blockIdx.x / 24, kb0 = ksl * 128;
    const float* xs = (layer == 0) ? p.x : p.out; const float* rowsq = (const float*)(p.ws + WS_ROWSQ + MiB); const float* gn = p.attn_norm + layer * 1024;
    const float* win = p.w_in + (size_t)layer * 1024 * NIN; float* u0 = (float*)(p.ws + WS_U0) + (size_t)ksl * 16 * 1536;
    for (int i = tid; i < 16 * 128; i += 512) { const int r = i >> 7, k = kb0 + (i & 127); L[i] = xs[(size_t)(r * SEQ) * DM + k] * row_rs(rowsq, r * SEQ) * gn[k]; }
    __syncthreads();
    const int c = cgp * 64 + (tid & 63), rg = tid >> 6;
    const int sc = c < 1024 ? c : 2056 + (c - 1024);
    const float* wp = win + (size_t)kb0 * NIN + sc;
    float a0 = 0.f, a1 = 0.f;
#pragma unroll 32
    for (int k = 0; k < 128; ++k) { const float w = wp[(size_t)k * NIN]; a0 += L[(2 * rg) * 128 + k] * w; a1 += L[(2 * rg + 1) * 128 + k] * w; }
    u0[(2 * rg) * 1536 + c] = a0; u0[(2 * rg + 1) * 1536 + c] = a1;
    __syncthreads();
}
__device__ __forceinline__ float u0_read(const float* u0, int b, int col) {
    float s = 0.f;
#pragma unroll
    for (int ks = 0; ks < 8; ++ks) s += u0[((size_t)ks * 16 + b) * 1536 + col];
    return s;
}

__device__ __forceinline__ void lds_barrier() { asm volatile("s_waitcnt lgkmcnt(0)" ::: "memory"); __builtin_amdgcn_s_barrier(); asm volatile("" ::: "memory"); }
constexpr int DN_QF = 0, DN_KF = 32768, DN_LM = 0, DN_OS = 16384, DN_QB = 65536, DN_KB = 82944, DN_KT = 100352, DN_AB = 118784, DN_ST = 128000, DN_U = 145408, DN_VT = 32768, DN_VTS = 41984, DN_MISC = 162048;
__device__ void deltanet_item(const Params& p, int layer, int item, LAS unsigned char* Lb, const int wv_) {
    const int tid0 = TIDX, w = wv_;
    const int b = item >> 3, h = (item >> 1) & 3, sl = item & 1;
    LAS float* qs = (LAS float*)(Lb + DN_QF); LAS float* ks = (LAS float*)(Lb + DN_KF);
    LAS bf16_t* XT = (LAS bf16_t*)(Lb + DN_OS); LAS bf16_t* LB21 = (LAS bf16_t*)(Lb + DN_OS + 12288);
    LAS float* Lm = (LAS float*)(Lb + DN_LM); LAS float* os = (LAS float*)(Lb + DN_OS);
    LAS bf16_t* qb = (LAS bf16_t*)(Lb + DN_QB); LAS bf16_t* kb = (LAS bf16_t*)(Lb + DN_KB);
    LAS bf16_t* kT = (LAS bf16_t*)(Lb + DN_KT);
    LAS bf16_t* Ab = (LAS bf16_t*)(Lb + DN_AB);
    LAS bf16_t* Stl = (LAS bf16_t*)(Lb + DN_ST);
    LAS float* U = (LAS float*)(Lb + DN_U);
    LAS bf16_t* vT = (LAS bf16_t*)(Lb + DN_VT); LAS bf16_t* vTs = (LAS bf16_t*)(Lb + DN_VTS);
    LAS float* gcs = (LAS float*)(Lb + DN_MISC); LAS float* bes = gcs + 64; LAS float* egs = gcs + 128; LAS float* egl = gcs + 192;
    const bf16_t* u = (const bf16_t*)(p.ws + WS_U); const float* ab = (const float*)(p.ws + WS_AB);
    float* sta = (float*)(p.ws + WS_STA); bf16_t* ya = (bf16_t*)(p.ws + WS_Y);
    const float* cw = p.dn_conv_w + (size_t)layer * 4 * 1536;
    const int cp0 = tid0 & 127;
    const int colq = (cp0 < 64) ? (h * 128 + 2 * cp0) : (512 + h * 128 + 2 * (cp0 - 64));
    float cwa[4], cwb[4];
#pragma unroll
    for (int j = 0; j < 4; ++j) { cwa[j] = cw[j * 1536 + colq]; cwb[j] = cw[j * 1536 + colq + 1]; }
    const int c80 = tid0 & 7;
    const int colv = 1024 + h * 128 + sl * 64 + c80 * 8;
    const float Aexp = __expf(p.dn_a_log[layer * 4 + h]), dtb = p.dn_dt_bias[layer * 4 + h];
    f32x4 Sacc[4] = {(f32x4){0.f, 0.f, 0.f, 0.f}, (f32x4){0.f, 0.f, 0.f, 0.f}, (f32x4){0.f, 0.f, 0.f, 0.f}, (f32x4){0.f, 0.f, 0.f, 0.f}};
    for (int i = tid0; i < 64 * 136 / 2; i += 512) ((LAS unsigned*)Stl)[i] = 0u;
    unsigned rq[19]; u32x4 rv[4]; float ralpha = 0.f, rbeta = 0.f;
#define DN_PREFETCH(CH) do { const int tid_ = TIDX; const int tq_ = tid_ >> 7, tl8_ = tid_ >> 3, ln_ = tid_ & 63; \
        const int t0_ = (CH) * 64 + tq_ * 16; const bf16_t* up_ = u + (size_t)(b * SEQ + t0_) * NU + colq; \
        _Pragma("unroll") for (int i_ = 0; i_ < 19; ++i_) { rq[i_] = 0u; if (t0_ - 3 + i_ >= 0) rq[i_] = *(const unsigned*)(up_ + (ptrdiff_t)(i_ - 3) * NU); } \
        const int t_ = (CH) * 64 + tl8_; \
        _Pragma("unroll") for (int j_ = 0; j_ < 4; ++j_) { rv[j_] = (u32x4){0u, 0u, 0u, 0u}; if (t_ - 3 + j_ >= 0) rv[j_] = *(const u32x4*)(u + (size_t)(b * SEQ + t_ - 3 + j_) * NU + colv); } \
        if (w == 0) { const float* abp_ = ab + (size_t)(b * SEQ + (CH) * 64 + ln_) * 8; ralpha = abp_[h]; rbeta = abp_[4 + h]; } } while (0)
    DN_PREFETCH(0);
    for (int ch = 0; ch < 32; ++ch) {
        const int tbase = b * SEQ + ch * 64;
        const int tid = TIDX, lane = tid & 63, cp = tid & 127, tq = tid >> 7, tl8 = tid >> 3, c8 = tid & 7, r16 = lane & 15, kq = lane >> 4;
        LAS float* dstq = (cp < 64) ? (qs + 2 * cp) : (ks + 2 * (cp - 64));
        {
            const int t0 = ch * 64 + tq * 16;
            float xa[3] = {bflo(rq[0]), bflo(rq[1]), bflo(rq[2])}, xb_[3] = {bfhi(rq[0]), bfhi(rq[1]), bfhi(rq[2])};
#pragma unroll
            for (int i = 0; i < 16; ++i) {
                float ca = bflo(rq[3 + i]), cb = bfhi(rq[3 + i]);
                if (i == 0 && t0 == 0) { const float* u0p = (const float*)(p.ws + WS_U0); ca = u0_read(u0p, b, colq); cb = u0_read(u0p, b, colq + 1); }
                const float ya_ = cwa[0] * xa[0] + cwa[1] * xa[1] + cwa[2] * xa[2] + cwa[3] * ca, yb_ = cwb[0] * xb_[0] + cwb[1] * xb_[1] + cwb[2] * xb_[2] + cwb[3] * cb;
                *(LAS f32x2*)(dstq + (tq * 16 + i) * 128) = (f32x2){siluf_(ya_), siluf_(yb_)};
                xa[0] = xa[1]; xa[1] = xa[2]; xa[2] = ca; xb_[0] = xb_[1]; xb_[1] = xb_[2]; xb_[2] = cb;
            }
        }
        {
            f32x4 cwv[4][2]; { const float* cwp = cw + colv + opaque0();
#pragma unroll
                for (int j = 0; j < 4; ++j) { cwv[j][0] = *(const f32x4*)(cwp + j * 1536); cwv[j][1] = *(const f32x4*)(cwp + j * 1536 + 4); } }
            f32x4 accv0 = (f32x4){0.f, 0.f, 0.f, 0.f}, accv1 = accv0;
#pragma unroll
            for (int j = 0; j < 4; ++j) { accv0 += cwv[j][0] * (f32x4){bflo(rv[j].x), bfhi(rv[j].x), bflo(rv[j].y), bfhi(rv[j].y)}; accv1 += cwv[j][1] * (f32x4){bflo(rv[j].z), bfhi(rv[j].z), bflo(rv[j].w), bfhi(rv[j].w)}; }
#pragma unroll
            for (int j = 0; j < 4; ++j) { U[tl8 * 65 + c8 * 8 + j] = siluf_(accv0[j]); U[tl8 * 65 + c8 * 8 + 4 + j] = siluf_(accv1[j]); }
        }
        if (w == 0) {
            float g = -Aexp * softplusf_(ralpha + dtb);
#pragma unroll
            for (int sft = 1; sft < 64; sft <<= 1) { const float o = __shfl_up(g, sft); if (lane >= sft) g += o; }
            const float gl = __shfl(g, 63);
            gcs[lane] = g; bes[lane] = sigmoidf_(rbeta); egs[lane] = __expf(g); egl[lane] = __expf(gl - g);
        }
        lds_barrier();
        {
            LAS f32x4* qp = (LAS f32x4*)(qs + tl8 * 128 + c8 * 16); LAS f32x4* kp = (LAS f32x4*)(ks + tl8 * 128 + c8 * 16);
            f32x4 q0 = qp[0], q1 = qp[1], q2 = qp[2], q3 = qp[3], k0 = kp[0], k1 = kp[1], k2 = kp[2], k3 = kp[3];
            float sq = 0.f, sk = 0.f;
#pragma unroll
            for (int j = 0; j < 4; ++j) { sq += q0[j] * q0[j] + q1[j] * q1[j] + q2[j] * q2[j] + q3[j] * q3[j]; sk += k0[j] * k0[j] + k1[j] * k1[j] + k2[j] * k2[j] + k3[j] * k3[j]; }
            sq += __shfl_xor(sq, 1); sq += __shfl_xor(sq, 2); sq += __shfl_xor(sq, 4); sk += __shfl_xor(sk, 1); sk += __shfl_xor(sk, 2); sk += __shfl_xor(sk, 4);
            const float fq_ = rsqrtf(sq + EPS) * 0.08838834764831845f, fk = rsqrtf(sk + EPS);
            q0 *= fq_; q1 *= fq_; q2 *= fq_; q3 *= fq_; k0 *= fk; k1 *= fk; k2 *= fk; k3 *= fk;
            if (ch == 0) {
                float d = 0.f;
#pragma unroll
                for (int j = 0; j < 4; ++j) d += q0[j] * k0[j] + q1[j] * k1[j] + q2[j] * k2[j] + q3[j] * k3[j];
                d += __shfl_xor(d, 1); d += __shfl_xor(d, 2); d += __shfl_xor(d, 4);
                if (tid == 0) gcs[256] = d;
            }
            u32x4 wq0, wq1, wk0, wk1;
            wq0.x = cvt_pk_bf16(q0[0], q0[1]); wq0.y = cvt_pk_bf16(q0[2], q0[3]); wq0.z = cvt_pk_bf16(q1[0], q1[1]); wq0.w = cvt_pk_bf16(q1[2], q1[3]);
            wq1.x = cvt_pk_bf16(q2[0], q2[1]); wq1.y = cvt_pk_bf16(q2[2], q2[3]); wq1.z = cvt_pk_bf16(q3[0], q3[1]); wq1.w = cvt_pk_bf16(q3[2], q3[3]);
            wk0.x = cvt_pk_bf16(k0[0], k0[1]); wk0.y = cvt_pk_bf16(k0[2], k0[3]); wk0.z = cvt_pk_bf16(k1[0], k1[1]); wk0.w = cvt_pk_bf16(k1[2], k1[3]);
            wk1.x = cvt_pk_bf16(k2[0], k2[1]); wk1.y = cvt_pk_bf16(k2[2], k2[3]); wk1.z = cvt_pk_bf16(k3[0], k3[1]); wk1.w = cvt_pk_bf16(k3[2], k3[3]);
            *(LAS u32x4*)(qb + tl8 * 136 + c8 * 16) = wq0; *(LAS u32x4*)(qb + tl8 * 136 + c8 * 16 + 8) = wq1;
            *(LAS u32x4*)(kb + tl8 * 136 + c8 * 16) = wk0; *(LAS u32x4*)(kb + tl8 * 136 + c8 * 16 + 8) = wk1;
            const unsigned kw[8] = {wk0.x, wk0.y, wk0.z, wk0.w, wk1.x, wk1.y, wk1.z, wk1.w};
#pragma unroll
            for (int j = 0; j < 8; ++j) { kT[(c8 * 16 + 2 * j) * 72 + tl8] = (bf16_t)(kw[j] & 0xffffu); kT[(c8 * 16 + 2 * j + 1) * 72 + tl8] = (bf16_t)(kw[j] >> 16); }
            const float be = bes[tl8], bg = be * egs[tl8];
            kp[0] = k0 * bg; kp[1] = k1 * bg; kp[2] = k2 * bg; kp[3] = k3 * bg;
#pragma unroll
            for (int j = 0; j < 8; ++j) U[tl8 * 65 + c8 * 8 + j] *= be;
        }
        lds_barrier();
        if (ch + 1 < 32) DN_PREFETCH(ch + 1);
        {
            const int mt = w & 3, ntb = (w >> 2) * 2;
            f32x4 akk[2] = {(f32x4){0.f, 0.f, 0.f, 0.f}, (f32x4){0.f, 0.f, 0.f, 0.f}}, aqk[2] = {akk[0], akk[0]};
#pragma unroll
            for (int kk = 0; kk < 4; ++kk) {
                const bf16x8 fk_ = *(const LAS bf16x8*)(kb + (mt * 16 + r16) * 136 + kk * 32 + kq * 8);
                const bf16x8 fq2 = *(const LAS bf16x8*)(qb + (mt * 16 + r16) * 136 + kk * 32 + kq * 8);
#pragma unroll
                for (int q = 0; q < 2; ++q) {
                    const bf16x8 fb = *(const LAS bf16x8*)(kb + ((ntb + q) * 16 + r16) * 136 + kk * 32 + kq * 8);
                    akk[q] = __builtin_amdgcn_mfma_f32_16x16x32_bf16(fk_, fb, akk[q], 0, 0, 0);
                    aqk[q] = __builtin_amdgcn_mfma_f32_16x16x32_bf16(fq2, fb, aqk[q], 0, 0, 0);
                }
            }
#pragma unroll
            for (int q = 0; q < 2; ++q)
#pragma unroll
                for (int j = 0; j < 4; ++j) {
                    const int c_ = mt * 16 + kq * 4 + j, s_ = (ntb + q) * 16 + r16;
                    const float dec = __expf(s_ <= c_ ? gcs[c_] - gcs[s_] : 0.f);
                    const float lv = (s_ < c_) ? bes[c_] * akk[q][j] * dec : 0.f;
                    Lm[c_ * 64 + s_] = lv;
                    if (c_ >= 32 && s_ < 32) LB21[(c_ - 32) * 40 + s_] = (bf16_t)(cvt_pk_bf16(lv, 0.f) & 0xffffu);
                    float av = (s_ <= c_) ? aqk[q][j] * dec : 0.f; if (ch == 0 && c_ == 0 && s_ == 0) av = gcs[256];
                    Ab[c_ * 72 + s_] = (bf16_t)(cvt_pk_bf16(av, 0.f) & 0xffffu);
                }
        }
        lds_barrier();
        {
            LAS float* bp = (tid < 64) ? (U + tid) : (ks + (tid - 64)); const int bstr = (tid < 64) ? 65 : 128;
            if (tid < 192) {
                float x[32];
#pragma unroll
                for (int i = 0; i < 32; ++i) x[i] = 0.f;
#pragma unroll
                for (int i = 0; i < 32; ++i) {
                    float a0 = bp[i * bstr], a1 = 0.f;
#pragma unroll
                    for (int m4 = 0; m4 < (i + 3) / 4; ++m4) { const f32x4 l = *(LAS f32x4*)(Lm + i * 64 + m4 * 4);
                        a0 -= l[0] * x[m4 * 4 + 0]; a1 -= l[1] * x[m4 * 4 + 1]; a0 -= l[2] * x[m4 * 4 + 2]; a1 -= l[3] * x[m4 * 4 + 3]; }
                    x[i] = a0 + a1;
                }
                if (tid < 64) {
#pragma unroll
                    for (int i = 0; i < 32; ++i) U[i * 65 + tid] = x[i];
                } else {
#pragma unroll
                    for (int i = 0; i < 32; ++i) kb[i * 136 + (tid - 64)] = (bf16_t)(cvt_pk_bf16(x[i], 0.f) & 0xffffu);
                }
#pragma unroll
                for (int i8 = 0; i8 < 4; ++i8) { u32x4 t; t.x = cvt_pk_bf16(x[i8 * 8 + 0], x[i8 * 8 + 1]); t.y = cvt_pk_bf16(x[i8 * 8 + 2], x[i8 * 8 + 3]); t.z = cvt_pk_bf16(x[i8 * 8 + 4], x[i8 * 8 + 5]); t.w = cvt_pk_bf16(x[i8 * 8 + 6], x[i8 * 8 + 7]);
                    *(LAS u32x4*)(XT + tid * 32 + i8 * 8) = t; }
            }
            lds_barrier();
#pragma unroll
            for (int q = 0; q < 3; ++q) {
                const int t_ = w * 3 + q, mt = t_ & 1, nt = t_ >> 1;
                const bf16x8 fa = *(const LAS bf16x8*)(LB21 + (mt * 16 + r16) * 40 + kq * 8);
                const bf16x8 fb = *(const LAS bf16x8*)(XT + (nt * 16 + r16) * 32 + kq * 8);
                const f32x4 cacc = __builtin_amdgcn_mfma_f32_16x16x32_bf16(fa, fb, (f32x4){0.f, 0.f, 0.f, 0.f}, 0, 0, 0);
                const int col_ = nt * 16 + r16;
                LAS float* cp_ = (col_ < 64) ? (U + col_) : (ks + (col_ - 64)); const int cstr = (col_ < 64) ? 65 : 128;
#pragma unroll
                for (int j = 0; j < 4; ++j) cp_[(32 + mt * 16 + kq * 4 + j) * cstr] -= cacc[j];
            }
            lds_barrier();
            if (tid < 192) {
                float x[32];
#pragma unroll
                for (int i = 0; i < 32; ++i) x[i] = 0.f;
#pragma unroll
                for (int i = 0; i < 32; ++i) {
                    float a0 = bp[(32 + i) * bstr], a1 = 0.f;
#pragma unroll
                    for (int m4 = 0; m4 < (i + 3) / 4; ++m4) { const f32x4 l = *(LAS f32x4*)(Lm + (32 + i) * 64 + 32 + m4 * 4);
                        a0 -= l[0] * x[m4 * 4 + 0]; a1 -= l[1] * x[m4 * 4 + 1]; a0 -= l[2] * x[m4 * 4 + 2]; a1 -= l[3] * x[m4 * 4 + 3]; }
                    x[i] = a0 + a1;
                }
                if (tid < 64) {
#pragma unroll
                    for (int i = 0; i < 32; ++i) U[(32 + i) * 65 + tid] = x[i];
                } else {
#pragma unroll
                    for (int i = 0; i < 32; ++i) kb[(32 + i) * 136 + (tid - 64)] = (bf16_t)(cvt_pk_bf16(x[i], 0.f) & 0xffffu);
                }
            }
        }
        lds_barrier();
        const u32x4 zr = *(const u32x4*)(u + (size_t)(tbase + tl8) * NU + 1536 + h * 128 + sl * 64 + c8 * 8);
        const float* nwp = p.dn_norm_w + layer * 128 + sl * 64 + c8 * 8 + opaque0(); const f32x4 nw0 = *(const f32x4*)nwp, nw1 = *(const f32x4*)(nwp + 4);
        f32x4 qsv[2];
        const int mtE = w & 3, ntE = (w >> 2) * 2;
        {
            f32x4 aws[2] = {(f32x4){0.f, 0.f, 0.f, 0.f}, (f32x4){0.f, 0.f, 0.f, 0.f}}, aqs[2] = {aws[0], aws[0]};
#pragma unroll
            for (int kk = 0; kk < 4; ++kk) {
                const bf16x8 fw = *(const LAS bf16x8*)(kb + (mtE * 16 + r16) * 136 + kk * 32 + kq * 8);
                const bf16x8 fq2 = *(const LAS bf16x8*)(qb + (mtE * 16 + r16) * 136 + kk * 32 + kq * 8);
#pragma unroll
                for (int q = 0; q < 2; ++q) {
                    const bf16x8 fs = *(const LAS bf16x8*)(Stl + ((ntE + q) * 16 + r16) * 136 + kk * 32 + kq * 8);
                    aws[q] = __builtin_amdgcn_mfma_f32_16x16x32_bf16(fw, fs, aws[q], 0, 0, 0);
                    aqs[q] = __builtin_amdgcn_mfma_f32_16x16x32_bf16(fq2, fs, aqs[q], 0, 0, 0);
                }
            }
#pragma unroll
            for (int q = 0; q < 2; ++q)
#pragma unroll
                for (int j = 0; j < 4; ++j) {
                    const int c_ = mtE * 16 + kq * 4 + j, v_ = (ntE + q) * 16 + r16;
                    const float vn = U[c_ * 65 + v_] - aws[q][j];
                    qsv[q][j] = aqs[q][j] * egs[c_];
                    vT[v_ * 72 + c_] = (bf16_t)(cvt_pk_bf16(vn, 0.f) & 0xffffu);
                    vTs[v_ * 72 + c_] = (bf16_t)(cvt_pk_bf16(vn * egl[c_], 0.f) & 0xffffu);
                }
        }
        lds_barrier();
        {
            f32x4 aav[2] = {(f32x4){0.f, 0.f, 0.f, 0.f}, (f32x4){0.f, 0.f, 0.f, 0.f}};
#pragma unroll
            for (int kk = 0; kk < 2; ++kk) {
                const bf16x8 fa = *(const LAS bf16x8*)(Ab + (mtE * 16 + r16) * 72 + kk * 32 + kq * 8);
#pragma unroll
                for (int q = 0; q < 2; ++q) { const bf16x8 fv = *(const LAS bf16x8*)(vT + ((ntE + q) * 16 + r16) * 72 + kk * 32 + kq * 8); aav[q] = __builtin_amdgcn_mfma_f32_16x16x32_bf16(fa, fv, aav[q], 0, 0, 0); }
            }
#pragma unroll
            for (int q = 0; q < 2; ++q)
#pragma unroll
                for (int j = 0; j < 4; ++j) os[(mtE * 16 + kq * 4 + j) * 64 + (ntE + q) * 16 + r16] = qsv[q][j] + aav[q][j];
            const float ge = __expf(gcs[63]);
            const int mtS = w & 3, ntS = (w >> 2) * 4;
#pragma unroll
            for (int q = 0; q < 4; ++q) {
                Sacc[q] *= ge;
#pragma unroll
                for (int kk = 0; kk < 2; ++kk) {
                    const bf16x8 fv = *(const LAS bf16x8*)(vTs + (mtS * 16 + r16) * 72 + kk * 32 + kq * 8);
                    const bf16x8 fk_ = *(const LAS bf16x8*)(kT + ((ntS + q) * 16 + r16) * 72 + kk * 32 + kq * 8);
                    Sacc[q] = __builtin_amdgcn_mfma_f32_16x16x32_bf16(fv, fk_, Sacc[q], 0, 0, 0);
                }
            }
        }
        lds_barrier();
#pragma unroll
        for (int q = 0; q < 4; ++q)
#pragma unroll
            for (int j = 0; j < 4; ++j) Stl[((w & 3) * 16 + kq * 4 + j) * 136 + ((w >> 2) * 4 + q) * 16 + r16] = (bf16_t)(cvt_pk_bf16(Sacc[q][j], 0.f) & 0xffffu);
        {
            const int token = tbase + tl8;
            const f32x4 o4 = *(LAS f32x4*)(os + tl8 * 64 + c8 * 8), o5 = *(LAS f32x4*)(os + tl8 * 64 + c8 * 8 + 4);
            float ss = ((o4[0] * o4[0] + o4[1] * o4[1]) + (o4[2] * o4[2] + o4[3] * o4[3])) + ((o5[0] * o5[0] + o5[1] * o5[1]) + (o5[2] * o5[2] + o5[3] * o5[3]));
            ss += __shfl_xor(ss, 1); ss += __shfl_xor(ss, 2); ss += __shfl_xor(ss, 4);
            if (c8 == 0) { sta[((size_t)token * 4 + h) * 4 + sl] = ss; sta[((size_t)token * 4 + h) * 4 + 2 + sl] = 0.f; }
            u32x4 wv2;
            wv2.x = cvt_pk_bf16(o4[0] * nw0[0] * siluf_(bflo(zr.x)), o4[1] * nw0[1] * siluf_(bfhi(zr.x))); wv2.y = cvt_pk_bf16(o4[2] * nw0[2] * siluf_(bflo(zr.y)), o4[3] * nw0[3] * siluf_(bfhi(zr.y)));
            wv2.z = cvt_pk_bf16(o5[0] * nw1[0] * siluf_(bflo(zr.z)), o5[1] * nw1[1] * siluf_(bfhi(zr.z))); wv2.w = cvt_pk_bf16(o5[2] * nw1[2] * siluf_(bflo(zr.w)), o5[3] * nw1[3] * siluf_(bfhi(zr.w)));
            *(u32x4*)(ya + (size_t)token * 512 + h * 128 + sl * 64 + c8 * 8) = wv2;
        }
        lds_barrier();
    }
#undef DN_PREFETCH
}

constexpr int RT_QB = 0, RT_KB = 9216, RT_KZT = 18432, RT_VT = 27648, RT_PB = 32256, RT_ST = 41472, RT_OS = 46080, RT_MISC = 54272;
__device__ void retention_item(const Params& p, int item, LAS unsigned char* Lb, const int wv_) {
    const int tid0 = TIDX, w = wv_;
    const int b = item >> 4, h = (item >> 2) & 3, sl = item & 3;
    LAS bf16_t* qb = (LAS bf16_t*)(Lb + RT_QB); LAS bf16_t* kb = (LAS bf16_t*)(Lb + RT_KB);
    LAS bf16_t* kzT = (LAS bf16_t*)(Lb + RT_KZT);
    LAS bf16_t* vT = (LAS bf16_t*)(Lb + RT_VT);
    LAS bf16_t* Pb = (LAS bf16_t*)(Lb + RT_PB);
    LAS bf16_t* Stl = (LAS bf16_t*)(Lb + RT_ST);
    LAS float* os = (LAS float*)(Lb + RT_OS); LAS float* misc = (LAS float*)(Lb + RT_MISC);
    const bf16_t* u = (const bf16_t*)(p.ws + WS_U);
    float* stb = (float*)(p.ws + WS_STB); bf16_t* yb = (bf16_t*)(p.ws + WS_Y) + (size_t)MTOK * 512;
    const float* rtab = (const float*)(p.ws + WS_ROT);
    const float lg2 = log2f(1.0f - exp2f(-5.0f - (float)h));
    f32x4 Sacc = (f32x4){0.f, 0.f, 0.f, 0.f};
    for (int i = tid0; i < 32 * 72 / 2; i += 512) ((LAS unsigned*)Stl)[i] = 0u;
    u32x2 rq1, rq2, rk1, rk2, rvv; f32x4 rcs0, rcs1;
#define RT_PREFETCH(CH) do { const int tid_ = TIDX; const int tl8_ = tid_ >> 3, c8_ = tid_ & 7; const int token_ = b * SEQ + (CH) * 64 + tl8_; const bf16_t* ur_ = u + (size_t)token_ * NU; \
        rq1 = *(const u32x2*)(ur_ + 2048 + h * 64 + c8_ * 4); rq2 = *(const u32x2*)(ur_ + 2048 + h * 64 + 32 + c8_ * 4); \
        rk1 = *(const u32x2*)(ur_ + 2304 + h * 64 + c8_ * 4); rk2 = *(const u32x2*)(ur_ + 2304 + h * 64 + 32 + c8_ * 4); \
        rvv = *(const u32x2*)(ur_ + 2560 + h * 128 + sl * 32 + c8_ * 4); \
        rcs0 = *(const f32x4*)(rtab + ((size_t)token_ * 32 + c8_ * 4) * 2); rcs1 = *(const f32x4*)(rtab + ((size_t)token_ * 32 + c8_ * 4) * 2 + 4); } while (0)
    RT_PREFETCH(0);
    for (int ch = 0; ch < 32; ++ch) {
        const int tid = TIDX, lane = tid & 63, tl8 = tid >> 3, c8 = tid & 7, r16 = lane & 15, kq = lane >> 4;
        const int token = b * SEQ + ch * 64 + tl8;
        {
            float q1f[4] = {bflo(rq1.x), bfhi(rq1.x), bflo(rq1.y), bfhi(rq1.y)}, q2f[4] = {bflo(rq2.x), bfhi(rq2.x), bflo(rq2.y), bfhi(rq2.y)};
            float k1f[4] = {bflo(rk1.x), bfhi(rk1.x), bflo(rk1.y), bfhi(rk1.y)}, k2f[4] = {bflo(rk2.x), bfhi(rk2.x), bflo(rk2.y), bfhi(rk2.y)};
            if (ch == 0 && tl8 == 0) {
                const float* u0p = (const float*)(p.ws + WS_U0); const int cb_ = 1024 + h * 64 + c8 * 4;
#pragma unroll
                for (int j = 0; j < 4; ++j) { q1f[j] = u0_read(u0p, b, cb_ + j); q2f[j] = u0_read(u0p, b, cb_ + 32 + j); k1f[j] = u0_read(u0p, b, cb_ + 256 + j); k2f[j] = u0_read(u0p, b, cb_ + 256 + 32 + j); }
            }
            float qo1[4], qo2[4], ko1[4], ko2[4]; float d00 = 0.f;
#pragma unroll
            for (int j = 0; j < 4; ++j) { const float cs = (j < 2) ? rcs0[2 * j] : rcs1[2 * (j - 2)], sn = (j < 2) ? rcs0[2 * j + 1] : rcs1[2 * (j - 2) + 1];
                qo1[j] = q1f[j] * cs - q2f[j] * sn; qo2[j] = q1f[j] * sn + q2f[j] * cs;
                ko1[j] = (k1f[j] * cs - k2f[j] * sn) * 0.125f; ko2[j] = (k1f[j] * sn + k2f[j] * cs) * 0.125f;
                d00 += qo1[j] * ko1[j] + qo2[j] * ko2[j]; }
            if (ch == 0) { d00 += __shfl_xor(d00, 1); d00 += __shfl_xor(d00, 2); d00 += __shfl_xor(d00, 4); if (tid == 0) misc[0] = d00; }
            u32x2 wq1, wq2, wk1, wk2;
            wq1.x = cvt_pk_bf16(qo1[0], qo1[1]); wq1.y = cvt_pk_bf16(qo1[2], qo1[3]); wq2.x = cvt_pk_bf16(qo2[0], qo2[1]); wq2.y = cvt_pk_bf16(qo2[2], qo2[3]);
            wk1.x = cvt_pk_bf16(ko1[0], ko1[1]); wk1.y = cvt_pk_bf16(ko1[2], ko1[3]); wk2.x = cvt_pk_bf16(ko2[0], ko2[1]); wk2.y = cvt_pk_bf16(ko2[2], ko2[3]);
            *(LAS u32x2*)(qb + tl8 * 72 + c8 * 4) = wq1; *(LAS u32x2*)(qb + tl8 * 72 + 32 + c8 * 4) = wq2;
            *(LAS u32x2*)(kb + tl8 * 72 + c8 * 4) = wk1; *(LAS u32x2*)(kb + tl8 * 72 + 32 + c8 * 4) = wk2;
            const float zeta = exp2f((float)(63 - tl8) * lg2);
#pragma unroll
            for (int j = 0; j < 4; ++j) { kzT[(c8 * 4 + j) * 72 + tl8] = (bf16_t)(cvt_pk_bf16(ko1[j] * zeta, 0.f) & 0xffffu); kzT[(32 + c8 * 4 + j) * 72 + tl8] = (bf16_t)(cvt_pk_bf16(ko2[j] * zeta, 0.f) & 0xffffu); }
            vT[(c8 * 4 + 0) * 72 + tl8] = (bf16_t)(rvv.x & 0xffffu); vT[(c8 * 4 + 1) * 72 + tl8] = (bf16_t)(rvv.x >> 16);
            vT[(c8 * 4 + 2) * 72 + tl8] = (bf16_t)(rvv.y & 0xffffu); vT[(c8 * 4 + 3) * 72 + tl8] = (bf16_t)(rvv.y >> 16);
        }
        lds_barrier();
        if (ch + 1 < 32) RT_PREFETCH(ch + 1);
        f32x4 cross = (f32x4){0.f, 0.f, 0.f, 0.f};
        const int mtE = w & 3, ntE = w >> 2;
        {
            const int mt = w & 3, ntb = (w >> 2) * 2;
            f32x4 asc[2] = {(f32x4){0.f, 0.f, 0.f, 0.f}, (f32x4){0.f, 0.f, 0.f, 0.f}};
#pragma unroll
            for (int kk = 0; kk < 2; ++kk) {
                const bf16x8 fq2 = *(const LAS bf16x8*)(qb + (mt * 16 + r16) * 72 + kk * 32 + kq * 8);
#pragma unroll
                for (int q = 0; q < 2; ++q) { const bf16x8 fb = *(const LAS bf16x8*)(kb + ((ntb + q) * 16 + r16) * 72 + kk * 32 + kq * 8); asc[q] = __builtin_amdgcn_mfma_f32_16x16x32_bf16(fq2, fb, asc[q], 0, 0, 0); }
                const bf16x8 fs = *(const LAS bf16x8*)(Stl + (ntE * 16 + r16) * 72 + kk * 32 + kq * 8);
                cross = __builtin_amdgcn_mfma_f32_16x16x32_bf16(fq2, fs, cross, 0, 0, 0);
            }
#pragma unroll
            for (int q = 0; q < 2; ++q)
#pragma unroll
                for (int j = 0; j < 4; ++j) {
                    const int c_ = mt * 16 + kq * 4 + j, s_ = (ntb + q) * 16 + r16;
                    float sc = (s_ <= c_) ? asc[q][j] * exp2f((float)(c_ - s_) * lg2) : 0.f;
                    if (ch == 0 && c_ == 0 && s_ == 0) sc = misc[0];
                    Pb[c_ * 72 + s_] = (bf16_t)(cvt_pk_bf16(sc, 0.f) & 0xffffu);
                }
#pragma unroll
            for (int j = 0; j < 4; ++j) cross[j] *= exp2f((float)(mtE * 16 + kq * 4 + j + 1) * lg2);
        }
        lds_barrier();
        {
            f32x4 inner = (f32x4){0.f, 0.f, 0.f, 0.f};
#pragma unroll
            for (int kk = 0; kk < 2; ++kk) {
                const bf16x8 fa = *(const LAS bf16x8*)(Pb + (mtE * 16 + r16) * 72 + kk * 32 + kq * 8);
                const bf16x8 fv = *(const LAS bf16x8*)(vT + (ntE * 16 + r16) * 72 + kk * 32 + kq * 8);
                inner = __builtin_amdgcn_mfma_f32_16x16x32_bf16(fa, fv, inner, 0, 0, 0);
            }
#pragma unroll
            for (int j = 0; j < 4; ++j) os[(mtE * 16 + kq * 4 + j) * 32 + ntE * 16 + r16] = cross[j] + inner[j];
            const int mtS = w & 1, ntS = w >> 1;
            Sacc *= exp2f(64.0f * lg2);
#pragma unroll
            for (int kk = 0; kk < 2; ++kk) {
                const bf16x8 fv = *(const LAS bf16x8*)(vT + (mtS * 16 + r16) * 72 + kk * 32 + kq * 8);
                const bf16x8 fk_ = *(const LAS bf16x8*)(kzT + (ntS * 16 + r16) * 72 + kk * 32 + kq * 8);
                Sacc = __builtin_amdgcn_mfma_f32_16x16x32_bf16(fv, fk_, Sacc, 0, 0, 0);
            }
        }
        lds_barrier();
#pragma unroll
        for (int j = 0; j < 4; ++j) Stl[((w & 1) * 16 + kq * 4 + j) * 72 + (w >> 1) * 16 + r16] = (bf16_t)(cvt_pk_bf16(Sacc[j], 0.f) & 0xffffu);
        {
            const f32x4 o4 = *(LAS f32x4*)(os + tl8 * 32 + c8 * 4);
            float s1 = (o4[0] + o4[1]) + (o4[2] + o4[3]), s2 = (o4[0] * o4[0] + o4[1] * o4[1]) + (o4[2] * o4[2] + o4[3] * o4[3]);
            s1 += __shfl_xor(s1, 1); s1 += __shfl_xor(s1, 2); s1 += __shfl_xor(s1, 4); s2 += __shfl_xor(s2, 1); s2 += __shfl_xor(s2, 2); s2 += __shfl_xor(s2, 4);
            if (c8 == 0) *(f32x2*)(stb + (((size_t)token * 4 + h) * 4 + sl) * 2) = (f32x2){s1, s2};
            u32x2 wv2; wv2.x = cvt_pk_bf16(o4[0], o4[1]); wv2.y = cvt_pk_bf16(o4[2], o4[3]);
            *(u32x2*)(yb + (size_t)token * 512 + h * 128 + sl * 32 + c8 * 4) = wv2;
        }
        lds_barrier();
    }
#undef RT_PREFETCH
}

__device__ void lru_item(const Params& p, int layer, int item, LAS unsigned char* Lb, const int wv_) {
    const int tid = TIDX, lane = tid & 63, w = tid >> 6;
    const int b = item >> 4, nb = (item >> 2) & 3, cs = item & 3;
    LAS bf16_t* Wt = (LAS bf16_t*)Lb;
    LAS bf16_t* xcb = (LAS bf16_t*)(Lb + 17408);
    LAS float* xcf = (LAS float*)(Lb + 34816);
    LAS float* pre = xcf + 2048;
    LAS float* aa = pre + 4096;
    LAS float* bbs = aa + 2048;
    LAS float* hs = bbs + 2048;
    const bf16_t* u = (const bf16_t*)(p.ws + WS_U); bf16_t* yc = (bf16_t*)(p.ws + WS_Y) + (size_t)2 * MTOK * 512;
    {
        const float* wa = p.lru_wa + ((size_t)layer * 4 + nb) * 128 * 128; const float* wx = p.lru_wx + ((size_t)layer * 4 + nb) * 128 * 128;
        for (int i = tid; i < 8192; i += 512) { const int k = i >> 6, j = i & 63; const float v = j < 32 ? wa[k * 128 + cs * 32 + j] : wx[k * 128 + cs * 32 + j - 32];
            Wt[j * 136 + k] = (bf16_t)(cvt_pk_bf16(v, 0.f) & 0xffffu); }
    }
    const int cp = tid & 63, tg = tid >> 6;
    const int cch = nb * 128 + 2 * cp;
    float cwa[4], cwb[4];
#pragma unroll
    for (int j = 0; j < 4; ++j) { cwa[j] = p.lru_conv_w[((size_t)layer * 4 + j) * 512 + cch]; cwb[j] = p.lru_conv_w[((size_t)layer * 4 + j) * 512 + cch + 1]; }
    const float cba = p.lru_conv_b[layer * 512 + cch], cbb = p.lru_conv_b[layer * 512 + cch + 1];
    const int ce = tid & 31, te = tid >> 5;
    const int och = nb * 128 + cs * 32 + ce;
    const float ba = p.lru_ba[layer * 512 + och], bx = p.lru_bx[layer * 512 + och], sp8 = 8.0f * softplusf_(-p.lru_lambda[layer * 512 + och]);
    const int tl8 = tid >> 3, c8 = tid & 7;
    float hcar = 0.f;
    unsigned rc[11]; u32x2 rgg;
#define LRU_PREFETCH(CH) do { const int t0_ = (CH) * 64 + tg * 8; const bf16_t* up_ = u + (size_t)(b * SEQ + t0_) * NU + 3584 + cch; \
        _Pragma("unroll") for (int i_ = 0; i_ < 11; ++i_) { rc[i_] = 0u; if (t0_ - 3 + i_ >= 0) rc[i_] = *(const unsigned*)(up_ + (ptrdiff_t)(i_ - 3) * NU); } \
        rgg = *(const u32x2*)(u + (size_t)(b * SEQ + (CH) * 64 + tl8) * NU + 4096 + nb * 128 + cs * 32 + c8 * 4); } while (0)
    LRU_PREFETCH(0);
    lds_barrier();
    for (int ch = 0; ch < 32; ++ch) {
        const u32x2 gr = rgg;
        {
            float xa[3] = {bflo(rc[0]), bflo(rc[1]), bflo(rc[2])}, xb_[3] = {bfhi(rc[0]), bfhi(rc[1]), bfhi(rc[2])};
#pragma unroll
            for (int i = 0; i < 8; ++i) {
                const float ca = bflo(rc[3 + i]), cb = bfhi(rc[3 + i]);
                const float ya_ = cwa[0] * xa[0] + cwa[1] * xa[1] + cwa[2] * xa[2] + cwa[3] * ca + cba, yb_ = cwb[0] * xb_[0] + cwb[1] * xb_[1] + cwb[2] * xb_[2] + cwb[3] * cb + cbb;
                const int tl = tg * 8 + i;
                *(LAS unsigned*)(xcb + tl * 136 + 2 * cp) = cvt_pk_bf16(ya_, yb_);
                if ((cp >> 4) == cs) *(LAS f32x2*)(xcf + tl * 32 + ((2 * cp) & 31)) = (f32x2){ya_, yb_};
                xa[0] = xa[1]; xa[1] = xa[2]; xa[2] = ca; xb_[0] = xb_[1]; xb_[1] = xb_[2]; xb_[2] = cb;
            }
        }
        if (ch + 1 < 32) LRU_PREFETCH(ch + 1);
        lds_barrier();
        {
            const int mt = w & 3, ntb = (w >> 2) * 2, r16 = lane & 15, kq = lane >> 4;
#pragma unroll
            for (int q = 0; q < 2; ++q) {
                const int ntile = ntb + q; f32x4 acc = (f32x4){0.f, 0.f, 0.f, 0.f};
#pragma unroll
                for (int kk = 0; kk < 4; ++kk) {
                    const bf16x8 af = *(const LAS bf16x8*)(xcb + (mt * 16 + r16) * 136 + kk * 32 + kq * 8);
                    const bf16x8 bf = *(const LAS bf16x8*)(Wt + (ntile * 16 + r16) * 136 + kk * 32 + kq * 8);
                    acc = __builtin_amdgcn_mfma_f32_16x16x32_bf16(af, bf, acc, 0, 0, 0);
                }
#pragma unroll
                for (int j = 0; j < 4; ++j) pre[(mt * 16 + kq * 4 + j) * 64 + ntile * 16 + r16] = acc[j];
            }
        }
        lds_barrier();
#pragma unroll
        for (int i = 0; i < 4; ++i) {
            const int tl = te * 4 + i;
            const float r = sigmoidf_(pre[tl * 64 + ce] + ba), ig = sigmoidf_(pre[tl * 64 + 32 + ce] + bx);
            const float la = -r * sp8; const float a = __expf(la); const float mult = sqrtf(fmaxf(-expm1f(2.0f * la), 0.f));
            aa[tl * 32 + ce] = a; bbs[tl * 32 + ce] = mult * ig * xcf[tl * 32 + ce];
        }
        lds_barrier();
        if (tid < 32) {
#pragma unroll 8
            for (int tl = 0; tl < 64; ++tl) { hcar = aa[tl * 32 + tid] * hcar + bbs[tl * 32 + tid]; hs[tl * 32 + tid] = hcar; }
        }
        lds_barrier();
        {
            const int token = b * SEQ + ch * 64 + tl8;
            const f32x4 h4 = *(LAS f32x4*)(hs + tl8 * 32 + c8 * 4);
            u32x2 wv_; wv_.x = cvt_pk_bf16(h4[0] * gelu_tanh(bflo(gr.x)), h4[1] * gelu_tanh(bfhi(gr.x))); wv_.y = cvt_pk_bf16(h4[2] * gelu_tanh(bflo(gr.y)), h4[3] * gelu_tanh(bfhi(gr.y)));
            *(u32x2*)(yc + (size_t)token * 512 + nb * 128 + cs * 32 + c8 * 4) = wv_;
        }
    }
    lds_barrier();
}

__device__ void finalize_y(const Params& p, const int wv_) {
    const bf16_t* u = (const bf16_t*)(p.ws + WS_U); const float* sta = (const float*)(p.ws + WS_STA); const float* stb = (const float*)(p.ws + WS_STB);
    bf16_t* ya = (bf16_t*)(p.ws + WS_Y); bf16_t* yb = ya + (size_t)MTOK * 512;
    const int t_ = TIDX;
    for (int i0 = blockIdx.x * 512; i0 < MTOK * 128; i0 += gridDim.x * 512) {
        const int i = i0 + t_; const int token = i >> 7, v = i & 127;
        if (v < 64) {
            const int chn = v * 8, h = chn >> 7;
            const f32x4 s = *(const f32x4*)(sta + ((size_t)token * 4 + h) * 4);
            const float sc = rsqrtf(((s[0] + s[1]) + (s[2] + s[3])) * (1.0f / 128.0f) + EPS);
            u32x4* yp = (u32x4*)(ya + (size_t)token * 512 + chn); const u32x4 r = *yp; u32x4 o;
            o.x = cvt_pk_bf16(bflo(r.x) * sc, bfhi(r.x) * sc); o.y = cvt_pk_bf16(bflo(r.y) * sc, bfhi(r.y) * sc); o.z = cvt_pk_bf16(bflo(r.z) * sc, bfhi(r.z) * sc); o.w = cvt_pk_bf16(bflo(r.w) * sc, bfhi(r.w) * sc);
            *yp = o;
        } else {
            const int chn = (v - 64) * 8, h = chn >> 7;
            const f32x4 sA = *(const f32x4*)(stb + ((size_t)token * 4 + h) * 8), sB = *(const f32x4*)(stb + ((size_t)token * 4 + h) * 8 + 4);
            const float mu = ((sA[0] + sA[2]) + (sB[0] + sB[2])) * (1.0f / 128.0f), ex2 = ((sA[1] + sA[3]) + (sB[1] + sB[3])) * (1.0f / 128.0f);
            const float rstd = rsqrtf(fmaxf(ex2 - mu * mu, 0.f) + EPS);
            u32x4* yp = (u32x4*)(yb + (size_t)token * 512 + chn); const u32x4 r = *yp; const u32x4 g = *(const u32x4*)(u + (size_t)token * NU + 3072 + chn); u32x4 o;
            o.x = cvt_pk_bf16((bflo(r.x) - mu) * rstd * siluf_(bflo(g.x)), (bfhi(r.x) - mu) * rstd * siluf_(bfhi(g.x)));
            o.y = cvt_pk_bf16((bflo(r.y) - mu) * rstd * siluf_(bflo(g.y)), (bfhi(r.y) - mu) * rstd * siluf_(bfhi(g.y)));
            o.z = cvt_pk_bf16((bflo(r.z) - mu) * rstd * siluf_(bflo(g.z)), (bfhi(r.z) - mu) * rstd * siluf_(bfhi(g.z)));
            o.w = cvt_pk_bf16((bflo(r.w) - mu) * rstd * siluf_(bflo(g.w)), (bfhi(r.w) - mu) * rstd * siluf_(bfhi(g.w)));
            *yp = o;
        }
    }
}
__device__ void ffn_fixup(const Params& p, int layer, const int wv_) {
    const float* side = (const float*)(p.ws + WS_Y); bf16_t* act = (bf16_t*)(p.ws + WS_U);
    const float* cw = p.ffn_conv_w + (size_t)layer * 3 * NUP; const float* cb = p.ffn_conv_b + (size_t)layer * NUP;
    const int t_ = TIDX;
    for (int i0 = blockIdx.x * 512; i0 < 512 * DFF; i0 += gridDim.x * 512) {
        const int i = i0 + t_; const int blk = i / DFF, chn = i - blk * DFF;
        if ((blk & 31) == 0) continue;
        const float* s0 = side + (size_t)blk * 4 * NUP; const float* sm = side + (size_t)(blk - 1) * 4 * NUP;
        const float g0 = s0[chn], g1 = s0[NUP + chn], gm2 = sm[2 * NUP + chn], gm1 = sm[3 * NUP + chn];
        const float v0 = s0[DFF + chn], v1 = s0[NUP + DFF + chn], vm2 = sm[2 * NUP + DFF + chn], vm1 = sm[3 * NUP + DFF + chn];
        const float wg0 = cw[chn], wg1 = cw[NUP + chn], wg2 = cw[2 * NUP + chn], bg = cb[chn];
        const float wv0 = cw[DFF + chn], wv1 = cw[NUP + DFF + chn], wv2 = cw[2 * NUP + DFF + chn], bv = cb[DFF + chn];
        const float pg0 = wg2 * g0 + wg1 * gm1 + wg0 * gm2 + bg, pg1 = wg2 * g1 + wg1 * g0 + wg0 * gm1 + bg;
        const float pv0 = wv2 * v0 + wv1 * vm1 + wv0 * vm2 + bv, pv1 = wv2 * v1 + wv1 * v0 + wv0 * vm1 + bv;
        act[(size_t)(blk * 64) * DFF + chn] = (bf16_t)(cvt_pk_bf16(siluf_(pg0) * pv0, 0.f) & 0xffffu);
        act[(size_t)(blk * 64 + 1) * DFF + chn] = (bf16_t)(cvt_pk_bf16(siluf_(pg1) * pv1, 0.f) & 0xffffu);
    }
}
__device__ void final_norm(const Params& p, const int wv_) {
    const float* rowsq = (const float*)(p.ws + WS_ROWSQ + MiB);
    const int t_ = TIDX;
    for (int i0 = blockIdx.x * 512; i0 < MTOK * 256; i0 += gridDim.x * 512) {
        const int i = i0 + t_; const int row = i >> 8, c = (i & 255) * 4; const float rs = row_rs(rowsq, row);
        const f32x4 g = *(const f32x4*)(p.final_norm + c); f32x4* xp = (f32x4*)(p.out + (size_t)row * DM + c);
        *xp = *xp * rs * g;
    }
}


__device__ __forceinline__ void grid_bar(unsigned* cnt, unsigned target, const int wv_) {
    asm volatile("s_waitcnt vmcnt(0) lgkmcnt(0)" ::: "memory");
    __syncthreads();
    if (wv_ == 0) {
        __builtin_amdgcn_fence(__ATOMIC_RELEASE, "agent");
        asm volatile("s_waitcnt vmcnt(0)" ::: "memory");
        if (lane_fresh() == 0) __hip_atomic_fetch_add(cnt, 1u, __ATOMIC_RELAXED, __HIP_MEMORY_SCOPE_AGENT);
        while ((unsigned)__builtin_amdgcn_readfirstlane((int)__hip_atomic_load(cnt, __ATOMIC_RELAXED, __HIP_MEMORY_SCOPE_AGENT)) < target) __builtin_amdgcn_s_sleep(1);
        __builtin_amdgcn_fence(__ATOMIC_ACQUIRE, "agent");
        asm volatile("s_waitcnt vmcnt(0)" ::: "memory");
    }
    __syncthreads();
}

#ifndef TIMING_DUP
#define TIMING_DUP 0
#endif
#ifndef STOP_AT
#define STOP_AT 0
#endif
#define STOP_L 0
__device__ void dump_bf16(const Params& p, const bf16_t* src, int ld, int col0, const int wv_) {
    const int t_ = TIDX;
    for (int i0 = blockIdx.x * 512; i0 < MTOK * 128; i0 += gridDim.x * 512) {
        const int i = i0 + t_; const int row = i >> 7, c = (i & 127) * 8;
        const u32x4 r = *(const u32x4*)(src + (size_t)row * ld + col0 + (c % ld));
        float* o = p.out + (size_t)row * DM + c;
        *(f32x4*)o = (f32x4){bflo(r.x), bfhi(r.x), bflo(r.y), bfhi(r.y)}; *(f32x4*)(o + 4) = (f32x4){bflo(r.z), bfhi(r.z), bflo(r.w), bfhi(r.w)};
    }
}
__global__ void __launch_bounds__(512, 2) mega(Params kp) {
    extern __shared__ __attribute__((aligned(16))) unsigned char smem[];
    LAS unsigned char* lds = (LAS unsigned char*)smem;
    cg::grid_group grid = cg::this_grid();
    const int G = gridDim.x, c = blockIdx.x;
    const int wv_ = __builtin_amdgcn_readfirstlane((int)threadIdx.x >> 6);
    if (threadIdx.x == 0) stp(lds, kp);
    if (c == 0 && threadIdx.x == 0) __hip_atomic_store((unsigned*)(kp.ws + WS_BAR), 0u, __ATOMIC_RELAXED, __HIP_MEMORY_SCOPE_AGENT);
    __syncthreads();
    grid.sync();
    int nbar = 0;
#define WSP(p_, off) ((p_).ws + (off))
    {
        const Params p = ldp(lds);
        rownorm(p, p.x, (float*)WSP(p, WS_ROWSQ + MiB), wv_);
        rot_table(p, wv_);
        prep_layer_main(p, 0, (LAS float*)lds, wv_);
        prep_layer_down(p, 0, (LAS float*)lds, wv_);
    }
    { const Params p = ldp(lds); grid_bar((unsigned*)WSP(p, WS_BAR), (unsigned)(++nbar) * (unsigned)G, wv_); if (TIMING_DUP == 6) grid_bar((unsigned*)WSP(p, WS_BAR), (unsigned)(++nbar) * (unsigned)G, wv_); }

    for (int l = 0; l < DEPTH; ++l) {
        {
            const Params p = ldp(lds);
            StaticOrder S; S.init(WSP(p, WS_XB), (bf16_t*)WSP(p, WS_W) + W_IN, MTOK, NU, 1024, G, c);
            EpiScale<0> E; E.O = (bf16_t*)WSP(p, WS_U); E.ldc = NU; E.rowsq = (const float*)WSP(p, WS_ROWSQ + MiB);
            for (int rep = 0; rep < ((TIMING_DUP == 5) ? 2 + __builtin_amdgcn_readfirstlane(opaque0()) : 1); ++rep)
            gemm_phase(lds, 1024, S, E, wv_);
        }
        { const Params p = ldp(lds); ab_tail(p, wv_); u0_tail(p, l, (LAS float*)lds, wv_); if (l > 0) prep_layer_down(p, l, (LAS float*)lds, wv_); }
        { const Params p = ldp(lds); grid_bar((unsigned*)WSP(p, WS_BAR), (unsigned)(++nbar) * (unsigned)G, wv_); if (TIMING_DUP == 6) grid_bar((unsigned*)WSP(p, WS_BAR), (unsigned)(++nbar) * (unsigned)G, wv_); }
        if (STOP_AT == 1 && l == STOP_L) { const Params p = ldp(lds); dump_bf16(p, (const bf16_t*)WSP(p, WS_U), NU, 0, wv_); return; }
        {
            const int Gh = G >> 1;
            if (c < Gh) { const Params p = ldp(lds); for (int it = c; it < 128; it += Gh) deltanet_item(p, l, it, lds, wv_); }
            else {
                { const Params p = ldp(lds); for (int it = c - Gh; it < 256; it += G - Gh) retention_item(p, it, lds, wv_); }
                { const Params p = ldp(lds); for (int it = c - Gh; it < 256; it += G - Gh) lru_item(p, l, it, lds, wv_); }
            }
        }
        { const Params p = ldp(lds); grid_bar((unsigned*)WSP(p, WS_BAR), (unsigned)(++nbar) * (unsigned)G, wv_); if (TIMING_DUP == 6) grid_bar((unsigned*)WSP(p, WS_BAR), (unsigned)(++nbar) * (unsigned)G, wv_); }
        if (STOP_AT == 2 && l == STOP_L) { const Params p = ldp(lds); dump_bf16(p, (const bf16_t*)WSP(p, WS_Y) + (size_t)2 * MTOK * 512, 512, 0, wv_); return; }
        if (STOP_AT == 12 && l == STOP_L) { const Params p = ldp(lds); dump_bf16(p, (const bf16_t*)WSP(p, WS_Y), 512, 0, wv_); return; }
        if (STOP_AT == 13 && l == STOP_L) { const Params p = ldp(lds); dump_bf16(p, (const bf16_t*)WSP(p, WS_Y) + (size_t)MTOK * 512, 512, 0, wv_); return; }
        {
            const Params p = ldp(lds);
            finalize_y(p, wv_);
        }
        { const Params p = ldp(lds); grid_bar((unsigned*)WSP(p, WS_BAR), (unsigned)(++nbar) * (unsigned)G, wv_); if (TIMING_DUP == 6) grid_bar((unsigned*)WSP(p, WS_BAR), (unsigned)(++nbar) * (unsigned)G, wv_); }
        if (STOP_AT == 3 && l == STOP_L) { const Params p = ldp(lds); dump_bf16(p, (const bf16_t*)WSP(p, WS_Y), 512, 0, wv_); return; }
        {
            const Params p = ldp(lds);
            StaticOrder S; S.init(WSP(p, WS_XB), (bf16_t*)WSP(p, WS_W) + W_G, MTOK, NG, 1024, G, c);
            EpiScale<1> E; E.O = (bf16_t*)WSP(p, WS_U); E.ldc = NG; E.rowsq = (const float*)WSP(p, WS_ROWSQ + MiB);
            for (int rep = 0; rep < ((TIMING_DUP == 5) ? 2 + __builtin_amdgcn_readfirstlane(opaque0()) : 1); ++rep)
            gemm_phase(lds, 1024, S, E, wv_);
        }
        { const Params p = ldp(lds); grid_bar((unsigned*)WSP(p, WS_BAR), (unsigned)(++nbar) * (unsigned)G, wv_); if (TIMING_DUP == 6) grid_bar((unsigned*)WSP(p, WS_BAR), (unsigned)(++nbar) * (unsigned)G, wv_); }
        if (STOP_AT == 4 && l == STOP_L) { const Params p = ldp(lds); dump_bf16(p, (const bf16_t*)WSP(p, WS_U), NG, 0, wv_); return; }
        {
            const Params p = ldp(lds);
            BranchOrder S; S.Y = (const char*)WSP(p, WS_Y); S.Wb = (const char*)((bf16_t*)WSP(p, WS_W) + W_B); S.G = G; S.c = c;
            EpiMerge E; E.gates = (const bf16_t*)WSP(p, WS_U); E.scratch = (float*)WSP(p, WS_XB) + (size_t)c * 65536; E.merged = (bf16_t*)WSP(p, WS_U + 192 * MiB);
            gemm_phase(lds, 512, S, E, wv_);
        }
        { const Params p = ldp(lds); grid_bar((unsigned*)WSP(p, WS_BAR), (unsigned)(++nbar) * (unsigned)G, wv_); if (TIMING_DUP == 6) grid_bar((unsigned*)WSP(p, WS_BAR), (unsigned)(++nbar) * (unsigned)G, wv_); }
        if (STOP_AT == 5 && l == STOP_L) { const Params p = ldp(lds); dump_bf16(p, (const bf16_t*)WSP(p, WS_U + 192 * MiB), DM, 0, wv_); return; }
        {
            const Params p = ldp(lds);
            StaticOrder S; S.init(WSP(p, WS_U + 192 * MiB), (bf16_t*)WSP(p, WS_W) + W_O, MTOK, DM, 1024, G, c);
            EpiResid E; E.xin = (l == 0) ? p.x : p.out; E.xout = p.out; E.xb = (bf16_t*)WSP(p, WS_XB); E.rowsq = (float*)WSP(p, WS_ROWSQ); E.ex = (LAS float*)(lds + 131072);
            gemm_phase(lds, 1024, S, E, wv_);
        }
        { const Params p = ldp(lds); grid_bar((unsigned*)WSP(p, WS_BAR), (unsigned)(++nbar) * (unsigned)G, wv_); if (TIMING_DUP == 6) grid_bar((unsigned*)WSP(p, WS_BAR), (unsigned)(++nbar) * (unsigned)G, wv_); }
        if (STOP_AT == 6 && l == STOP_L) return;
        {
            const Params p = ldp(lds);
            StaticOrder S; S.init(WSP(p, WS_XB), (bf16_t*)WSP(p, WS_W) + W_UP, MTOK, NUP, 1024, G, c);
            EpiFfn E; E.act = (bf16_t*)WSP(p, WS_U); E.rowsq = (const float*)WSP(p, WS_ROWSQ); E.cw = p.ffn_conv_w + (size_t)l * 3 * NUP; E.cb = p.ffn_conv_b + (size_t)l * NUP; E.side = (float*)WSP(p, WS_Y);
            for (int rep = 0; rep < ((TIMING_DUP == 5) ? 2 + __builtin_amdgcn_readfirstlane(opaque0()) : 1); ++rep)
            gemm_phase(lds, 1024, S, E, wv_);
        }
        { const Params p = ldp(lds); grid_bar((unsigned*)WSP(p, WS_BAR), (unsigned)(++nbar) * (unsigned)G, wv_); if (TIMING_DUP == 6) grid_bar((unsigned*)WSP(p, WS_BAR), (unsigned)(++nbar) * (unsigned)G, wv_); }
        {
            const Params p = ldp(lds);
            ffn_fixup(p, l, wv_);
        }
        if (l + 1 < DEPTH) { const Params p = ldp(lds); prep_layer_main(p, l + 1, (LAS float*)lds, wv_); }
        { const Params p = ldp(lds); grid_bar((unsigned*)WSP(p, WS_BAR), (unsigned)(++nbar) * (unsigned)G, wv_); if (TIMING_DUP == 6) grid_bar((unsigned*)WSP(p, WS_BAR), (unsigned)(++nbar) * (unsigned)G, wv_); }
        if (STOP_AT == 7 && l == STOP_L) { const Params p = ldp(lds); dump_bf16(p, (const bf16_t*)WSP(p, WS_U), DFF, 0, wv_); return; }
        {
            const Params p = ldp(lds);
            StaticOrder S; S.init(WSP(p, WS_U), (bf16_t*)WSP(p, WS_W) + W_DN, MTOK, DM, DFF, G, c);
            EpiResid E; E.xin = p.out; E.xout = p.out; E.xb = (bf16_t*)WSP(p, WS_XB); E.rowsq = (float*)WSP(p, WS_ROWSQ + MiB); E.ex = (LAS float*)(lds + 131072);
            gemm_phase(lds, DFF, S, E, wv_);
        }
        { const Params p = ldp(lds); grid_bar((unsigned*)WSP(p, WS_BAR), (unsigned)(++nbar) * (unsigned)G, wv_); if (TIMING_DUP == 6) grid_bar((unsigned*)WSP(p, WS_BAR), (unsigned)(++nbar) * (unsigned)G, wv_); }
        if (STOP_AT == 8 && l == STOP_L) return;
        if (STOP_AT == 10 && l == STOP_L) { const Params p = ldp(lds); dump_bf16(p, (const bf16_t*)WSP(p, WS_XB), DM, 0, wv_); return; }
        if (STOP_AT == 11 && l == STOP_L) { const Params p = ldp(lds); dump_bf16(p, (const bf16_t*)WSP(p, WS_W) + W_IN, 1024, 0, wv_); return; }
        if (STOP_AT == 9 && l == STOP_L) { const Params p = ldp(lds); const float* rq = (const float*)WSP(p, WS_ROWSQ + MiB); const int t_ = TIDX; for (int i0 = c * 512; i0 < MTOK * 256; i0 += G * 512) { const int i = i0 + t_; const float v = rq[i >> 8]; *(f32x4*)(p.out + (size_t)i * 4) = (f32x4){v, v, v, v}; } return; }
    }
    { const Params p = ldp(lds); final_norm(p, wv_); }
}

constexpr int LDS_BYTES = 163328 + 256;
extern "C" void kernel_launch(void* const* d_in, const int* in_sizes, int n_in, void* d_out, int out_size, void* d_ws, size_t ws_size, hipStream_t stream) {
    static int grid = 0;
    if (grid == 0) {
        int dev = 0, cus = 0, per_cu = 0;
        hipGetDevice(&dev);
        hipDeviceGetAttribute(&cus, hipDeviceAttributeMultiprocessorCount, dev);
        if (hipFuncSetAttribute((const void*)mega, hipFuncAttributeMaxDynamicSharedMemorySize, LDS_BYTES) != hipSuccess) fprintf(stderr, "kernel_launch: hipFuncSetAttribute failed\n");
        hipOccupancyMaxActiveBlocksPerMultiprocessor(&per_cu, (const void*)mega, 512, LDS_BYTES);
        (void)hipGetLastError();
        if (per_cu < 1) per_cu = 1;
        grid = cus * 1;
        if (grid > 256) grid = 256;
        if (ws_size < 496 * MiB) fprintf(stderr, "kernel_launch: workspace too small: %zu\n", ws_size);
    }
    Params p{};
    p.x = (const float*)d_in[0]; p.pos = (const int*)d_in[1]; p.attn_norm = (const float*)d_in[2]; p.w_in = (const float*)d_in[3]; p.dn_conv_w = (const float*)d_in[4];
    p.dn_a_log = (const float*)d_in[5]; p.dn_dt_bias = (const float*)d_in[6]; p.dn_norm_w = (const float*)d_in[7]; p.lru_conv_w = (const float*)d_in[8]; p.lru_conv_b = (const float*)d_in[9];
    p.lru_wa = (const float*)d_in[10]; p.lru_ba = (const float*)d_in[11]; p.lru_wx = (const float*)d_in[12]; p.lru_bx = (const float*)d_in[13]; p.lru_lambda = (const float*)d_in[14];
    p.w_branch = (const float*)d_in[15]; p.w_out = (const float*)d_in[16]; p.ffn_norm = (const float*)d_in[17]; p.w_up = (const float*)d_in[18]; p.ffn_conv_w = (const float*)d_in[19];
    p.ffn_conv_b = (const float*)d_in[20]; p.w_down = (const float*)d_in[21]; p.final_norm = (const float*)d_in[22];
    p.out = (float*)d_out; p.ws = (unsigned char*)d_ws;
    (void)hipMemsetAsync((unsigned char*)d_ws + WS_BAR, 0, 256, stream);
    void* args[] = {&p};
    hipError_t e = hipLaunchCooperativeKernel((const void*)mega, dim3(grid), dim3(512), args, LDS_BYTES, stream);
    if (e != hipSuccess) fprintf(stderr, "cooperative launch failed: %s (grid %d)\n", hipGetErrorString(e), grid);
}
```

```cpp
#include <hip/hip_runtime.h>
#include <hip/hip_cooperative_groups.h>
#include <cstdio>
#include <cstdint>
namespace cg = cooperative_groups;

#define LAS __attribute__((address_space(3)))
typedef unsigned short bf16_t;
typedef short bf16x8 __attribute__((ext_vector_type(8)));
typedef float f32x4 __attribute__((ext_vector_type(4)));
typedef float f32x2 __attribute__((ext_vector_type(2)));
typedef unsigned u32x4 __attribute__((ext_vector_type(4)));
typedef unsigned u32x2 __attribute__((ext_vector_type(2)));

constexpr int MTOK = 32768, DM = 1024, SEQ = 2048, NU = 4608, NG = 3072, NIN = 7688, DFF = 2816, NUP = 5632, DEPTH = 4;
constexpr float EPS = 1e-6f;
constexpr size_t MiB = 1u << 20;
constexpr size_t WS_ROWSQ = 0;
constexpr size_t WS_AB = 2 * MiB;
constexpr size_t WS_STA = 3 * MiB;
constexpr size_t WS_STB = 5 * MiB;
constexpr size_t WS_WAB = 9 * MiB;
constexpr size_t WS_BAR = 9 * MiB + 65536;
constexpr size_t WS_U0 = 9 * MiB + 131072;
constexpr size_t WS_XB = 10 * MiB;
constexpr size_t WS_W = 74 * MiB;
constexpr size_t WS_U = 112 * MiB;
constexpr size_t WS_ROT = 496 * MiB;
constexpr size_t WS_Y = 400 * MiB;
constexpr size_t W_IN = 0, W_G = W_IN + (size_t)NU * 1024, W_B = W_G + (size_t)NG * 1024, W_O = W_B + (size_t)3 * 1024 * 512,
                 W_UP = W_O + (size_t)1024 * 1024, W_DN = W_UP + (size_t)NUP * 1024;

struct Params {
    const float* x; const int* pos; const float* attn_norm; const float* w_in; const float* dn_conv_w; const float* dn_a_log; const float* dn_dt_bias; const float* dn_norm_w;
    const float* lru_conv_w; const float* lru_conv_b; const float* lru_wa; const float* lru_ba; const float* lru_wx; const float* lru_bx; const float* lru_lambda;
    const float* w_branch; const float* w_out; const float* ffn_norm; const float* w_up; const float* ffn_conv_w; const float* ffn_conv_b; const float* w_down; const float* final_norm;
    float* out; unsigned char* ws;
};


__device__ __forceinline__ int opaque0() { int z; asm volatile("v_mov_b32 %0, 0" : "=v"(z)); return z; }
constexpr int LDS_PARAMS = 163328;
__device__ __forceinline__ const void* ldptr(LAS const unsigned* lp, int i) {
    const unsigned lo = __builtin_amdgcn_readfirstlane(lp[2 * i]), hi = __builtin_amdgcn_readfirstlane(lp[2 * i + 1]);
    typedef const __attribute__((address_space(1))) unsigned char* gptr_t;
    return (const void*)(gptr_t)(((unsigned long long)hi << 32) | lo);
}
__device__ __forceinline__ Params ldp(LAS const unsigned char* ldsbase) {
    LAS const unsigned* lp = (LAS const unsigned*)(ldsbase + LDS_PARAMS + opaque0());
    Params p;
    p.x = (const float*)ldptr(lp, 0); p.pos = (const int*)ldptr(lp, 1); p.attn_norm = (const float*)ldptr(lp, 2); p.w_in = (const float*)ldptr(lp, 3); p.dn_conv_w = (const float*)ldptr(lp, 4);
    p.dn_a_log = (const float*)ldptr(lp, 5); p.dn_dt_bias = (const float*)ldptr(lp, 6); p.dn_norm_w = (const float*)ldptr(lp, 7); p.lru_conv_w = (const float*)ldptr(lp, 8); p.lru_conv_b = (const float*)ldptr(lp, 9);
    p.lru_wa = (const float*)ldptr(lp, 10); p.lru_ba = (const float*)ldptr(lp, 11); p.lru_wx = (const float*)ldptr(lp, 12); p.lru_bx = (const float*)ldptr(lp, 13); p.lru_lambda = (const float*)ldptr(lp, 14);
    p.w_branch = (const float*)ldptr(lp, 15); p.w_out = (const float*)ldptr(lp, 16); p.ffn_norm = (const float*)ldptr(lp, 17); p.w_up = (const float*)ldptr(lp, 18); p.ffn_conv_w = (const float*)ldptr(lp, 19);
    p.ffn_conv_b = (const float*)ldptr(lp, 20); p.w_down = (const float*)ldptr(lp, 21); p.final_norm = (const float*)ldptr(lp, 22); p.out = (float*)ldptr(lp, 23); p.ws = (unsigned char*)ldptr(lp, 24);
    return p;
}
__device__ __forceinline__ void stp(LAS unsigned char* ldsbase, const Params& p) {
    LAS unsigned long long* lp = (LAS unsigned long long*)(ldsbase + LDS_PARAMS);
    lp[0] = (unsigned long long)p.x; lp[1] = (unsigned long long)p.pos; lp[2] = (unsigned long long)p.attn_norm; lp[3] = (unsigned long long)p.w_in; lp[4] = (unsigned long long)p.dn_conv_w;
    lp[5] = (unsigned long long)p.dn_a_log; lp[6] = (unsigned long long)p.dn_dt_bias; lp[7] = (unsigned long long)p.dn_norm_w; lp[8] = (unsigned long long)p.lru_conv_w; lp[9] = (unsigned long long)p.lru_conv_b;
    lp[10] = (unsigned long long)p.lru_wa; lp[11] = (unsigned long long)p.lru_ba; lp[12] = (unsigned long long)p.lru_wx; lp[13] = (unsigned long long)p.lru_bx; lp[14] = (unsigned long long)p.lru_lambda;
    lp[15] = (unsigned long long)p.w_branch; lp[16] = (unsigned long long)p.w_out; lp[17] = (unsigned long long)p.ffn_norm; lp[18] = (unsigned long long)p.w_up; lp[19] = (unsigned long long)p.ffn_conv_w;
    lp[20] = (unsigned long long)p.ffn_conv_b; lp[21] = (unsigned long long)p.w_down; lp[22] = (unsigned long long)p.final_norm; lp[23] = (unsigned long long)p.out; lp[24] = (unsigned long long)p.ws;
}
__device__ __forceinline__ int lane_fresh() { int l; asm volatile("v_mbcnt_lo_u32_b32 %0, -1, 0\n\tv_mbcnt_hi_u32_b32 %0, -1, %0" : "=&v"(l)); return l; }
#define TIDX ((wv_ << 6) + lane_fresh())
__device__ __forceinline__ float opaque0_after(float dep) { float z; asm volatile("v_mov_b32 %0, 0" : "=v"(z) : "v"(dep)); return z; }
__device__ __forceinline__ float bflo(unsigned u) { return __uint_as_float(u << 16); }
__device__ __forceinline__ float bfhi(unsigned u) { return __uint_as_float(u & 0xffff0000u); }
typedef __bf16 bf16x2_t __attribute__((ext_vector_type(2)));
__device__ __forceinline__ unsigned cvt_pk_bf16(float lo, float hi) { const f32x2 v = {lo, hi}; return __builtin_bit_cast(unsigned, __builtin_convertvector(v, bf16x2_t)); }
__device__ __forceinline__ float sigmoidf_(float x) { return __builtin_amdgcn_rcpf(1.f + __expf(-x)); }
__device__ __forceinline__ float siluf_(float x) { return x * __builtin_amdgcn_rcpf(1.f + __expf(-x)); }
__device__ __forceinline__ float softplusf_(float x) { return fmaxf(x, 0.f) + log1pf(__expf(-fabsf(x))); }
__device__ __forceinline__ float gelu_tanh(float x) { const float u = 0.7978845608028654f * (x + 0.044715f * x * x * x); return x * __builtin_amdgcn_rcpf(1.f + __expf(-2.f * u)); }
template <int CTRL> __device__ __forceinline__ float dppmov(float v) { return __int_as_float(__builtin_amdgcn_update_dpp(0, __float_as_int(v), CTRL, 0xf, 0xf, true)); }
__device__ __forceinline__ float allreduce16(float x) {
    x += dppmov<0xB1>(x); x += dppmov<0x4E>(x); x += dppmov<0x141>(x); x += dppmov<0x140>(x); return x;
}
__device__ __forceinline__ float row_rs(const float* rowsq, int row) { const f32x4 q = *(const f32x4*)(rowsq + (size_t)row * 4); return rsqrtf(((q[0] + q[1]) + (q[2] + q[3])) * (1.0f / 1024.0f) + EPS); }

constexpr int BM = 256, BK = 64, HALF = 128, HTB = HALF * BK * 2, STAGE_BYTES = 8 * HTB, NXCD = 8, WGM = 8;
__device__ __forceinline__ int lds_byte(int r, int c) { const int st = (r >> 4) * 2 + (c >> 5), rr = r & 15, cc = c & 31, ob = rr * 64 + cc * 2; return st * 1024 + (ob ^ (((ob >> 9) & 1) << 5)); }
__device__ __forceinline__ void stage_rc(int b, int& R, int& C) { const int st = b / 1024, sb = b % 1024, swz = sb ^ (((sb >> 9) & 1) << 5); R = (st >> 1) * 16 + swz / 64; C = (st & 1) * 32 + (swz % 64) / 2; }
__device__ __forceinline__ int perm32(int rho) { const int n = rho >> 4, i = rho & 15; return 8 * (i >> 2) + 4 * n + (i & 3); }
struct Unit { int pm, pn, aux; };

struct StaticOrder {
    const char* A; const char* B; int nM, nN, nwg, G, c; size_t tstep;
    __device__ void init(const void* A_, const void* B_, int M, int N, int K, int G_, int c_) { A = (const char*)A_; B = (const char*)B_; nM = M / BM; nN = N / BM; nwg = nM * nN; G = G_; c = c_; tstep = (size_t)BM * K * 2; }
    __device__ __forceinline__ bool next(int i, Unit& u) const {
        const long L = (long)i * G + c; if (L >= nwg) return false;
        int wgid = (int)L; { const int q = nwg / NXCD, r = nwg % NXCD, xcd = wgid % NXCD, off = wgid / NXCD; wgid = (xcd < r ? xcd * (q + 1) : r * (q + 1) + (xcd - r) * q) + off; }
        const int nig = WGM * nN, gid = wgid / nig, fm = gid * WGM, gsz = (nM - fm) < WGM ? (nM - fm) : WGM;
        u.pm = fm + ((wgid % nig) % gsz); u.pn = (wgid % nig) / gsz; u.aux = 0; return true;
    }
    __device__ __forceinline__ void ptrs(const Unit& u, const char*& a, const char*& b) const { a = A + (size_t)u.pm * tstep; b = B + (size_t)u.pn * tstep; }
};
struct BranchOrder {
    const char* Y; const char* Wb; int G, c;
    __device__ __forceinline__ bool next(int i, Unit& u) const {
        const int tile = c + G * (i / 3); if (tile >= 512) return false;
        u.pm = tile >> 2; u.pn = tile & 3; u.aux = i % 3; return true;
    }
    __device__ __forceinline__ void ptrs(const Unit& u, const char*& a, const char*& b) const {
        a = Y + (size_t)u.aux * ((size_t)MTOK * 512 * 2) + (size_t)u.pm * (256 * 512 * 2);
        b = Wb + (size_t)u.aux * ((size_t)1024 * 512 * 2) + (size_t)u.pn * (256 * 512 * 2);
    }
};

template <class Epi, class Sched>
__device__ __forceinline__ void gemm_phase(LAS unsigned char* lds, const int K, const Sched& S, const Epi& E, const int wv_) {
    const int tid = TIDX, wid = __builtin_amdgcn_readfirstlane(tid >> 6), lane = tid & 63, wr = wid >> 2, wc = wid & 3, fr = lane & 15, fq = lane >> 4;
    const int nt = K / BK;
    unsigned voffA[2], voffB[2];
#pragma unroll
    for (int i = 0; i < 2; ++i) { int R, C; stage_rc(tid * 16 + i * 8192, R, C); const int Rb = Epi::PERM ? ((R & ~31) + perm32(R & 31)) : R;
        voffA[i] = (unsigned)(R * K + C) * 2u; voffB[i] = (unsigned)(Rb * K + C) * 2u; }
    const size_t kstep = (size_t)(BK * 2);
    const size_t hstep = (size_t)HALF * K * 2;
    const unsigned ldsw = (unsigned)wid * 1024u;
    const int aoff = lds_byte(wr * 64 + fr, fq * 8), boff = lds_byte(wc * 32 + fr, fq * 8);
#define PG8_SA(b, h) (((b) * 2 + (h)) * HTB)
#define PG8_SB(b, h) ((4 + (b) * 2 + (h)) * HTB)
#define PG8_STAGE(bufoff, gbase, voff) do { _Pragma("unroll") for (int _i = 0; _i < 2; ++_i) \
        __builtin_amdgcn_global_load_lds((const unsigned*)((const char*)(gbase) + (voff)[_i]), (LAS unsigned*)(lds + (bufoff) + ldsw + _i * 8192), 16, 0, 0); } while (0)
#define PG8_LDA(dst, b, h) do { _Pragma("unroll") for (int m = 0; m < 4; ++m) _Pragma("unroll") for (int k = 0; k < 2; ++k) dst[m][k] = *(const LAS bf16x8*)(lds + PG8_SA(b, h) + aoff + m * 2048 + k * 1024); } while (0)
#define PG8_LDB(dst, b, h) do { _Pragma("unroll") for (int n = 0; n < 2; ++n) _Pragma("unroll") for (int k = 0; k < 2; ++k) dst[n][k] = *(const LAS bf16x8*)(lds + PG8_SB(b, h) + boff + n * 2048 + k * 1024); } while (0)
#define PG8_MMA(ai, bj, At, Bt) do { __builtin_amdgcn_s_setprio(1); _Pragma("unroll") for (int m = 0; m < 4; ++m) _Pragma("unroll") for (int n = 0; n < 2; ++n) _Pragma("unroll") for (int k = 0; k < 2; ++k) \
        acc[ai][bj][m][n] = __builtin_amdgcn_mfma_f32_16x16x32_bf16(Bt[n][k], At[m][k], acc[ai][bj][m][n], 0, 0, 0); __builtin_amdgcn_s_setprio(0); } while (0)
#define PG8_WAIT_V(n) asm volatile("s_waitcnt vmcnt(" #n ")" ::: "memory")
#define PG8_WAIT_L(n) asm volatile("s_waitcnt lgkmcnt(" #n ")" ::: "memory")
#define PG8_BAR __builtin_amdgcn_s_barrier()
#define PG8_SCHED __builtin_amdgcn_sched_barrier(0)
    Unit cur, nxt; int ui = 0;
    if (!S.next(0, cur)) return;
    f32x4 acc[2][2][4][2];
#pragma unroll
    for (int a = 0; a < 2; ++a)
#pragma unroll
        for (int b = 0; b < 2; ++b)
#pragma unroll
            for (int m = 0; m < 4; ++m)
#pragma unroll
                for (int n = 0; n < 2; ++n) acc[a][b][m][n] = (f32x4){0.f, 0.f, 0.f, 0.f};
    bf16x8 At[4][2], B0[2][2], B1[2][2];
    const char* cA; const char* cB; S.ptrs(cur, cA, cB);
    PG8_STAGE(PG8_SB(0, 0), cB, voffB); PG8_STAGE(PG8_SB(0, 1), cB + hstep, voffB); PG8_STAGE(PG8_SA(0, 0), cA, voffA); PG8_STAGE(PG8_SA(0, 1), cA + hstep, voffA);
    if (wr == 1) PG8_BAR;
    PG8_WAIT_V(2); PG8_BAR;
    PG8_STAGE(PG8_SB(1, 0), cB + kstep, voffB); PG8_STAGE(PG8_SA(1, 0), cA + kstep, voffA); PG8_STAGE(PG8_SB(1, 1), cB + hstep + kstep, voffB);
    PG8_WAIT_V(6); PG8_BAR;
    for (;;) {
        const bool has_next = S.next(ui + 1, nxt);
        const char* nA = cA; const char* nB = cB; if (has_next) S.ptrs(nxt, nA, nB);
        for (int t = 0; t < nt; t += 2) {
            const bool last = (t == nt - 2);
            const char* a1 = cA + (size_t)(t + 1) * kstep;
            const char* a2 = last ? nA : cA + (size_t)(t + 2) * kstep; const char* b2 = last ? nB : cB + (size_t)(t + 2) * kstep;
            const char* a3 = a2 + kstep; const char* b3 = b2 + kstep;
            PG8_LDB(B0, 0, 0); PG8_LDB(B1, 0, 1); PG8_SCHED; PG8_LDA(At, 0, 0); PG8_STAGE(PG8_SA(1, 1), a1 + hstep, voffA);
            PG8_WAIT_V(8); PG8_WAIT_L(0); PG8_BAR; PG8_MMA(0, 0, At, B0); PG8_MMA(0, 1, At, B1); PG8_BAR; PG8_SCHED;
            PG8_LDA(At, 0, 1); PG8_STAGE(PG8_SB(0, 0), b2, voffB); PG8_STAGE(PG8_SB(0, 1), b2 + hstep, voffB); PG8_STAGE(PG8_SA(0, 0), a2, voffA);
            PG8_WAIT_V(8); PG8_WAIT_L(0); PG8_BAR; PG8_MMA(1, 0, At, B0); PG8_MMA(1, 1, At, B1); PG8_BAR; PG8_SCHED;
            PG8_LDB(B0, 1, 0); PG8_LDB(B1, 1, 1); PG8_SCHED; PG8_LDA(At, 1, 0); PG8_STAGE(PG8_SA(0, 1), a2 + hstep, voffA);
            PG8_WAIT_V(8); PG8_WAIT_L(0); PG8_BAR; PG8_MMA(0, 0, At, B0); PG8_MMA(0, 1, At, B1); PG8_BAR; PG8_SCHED;
            PG8_LDA(At, 1, 1); PG8_STAGE(PG8_SB(1, 0), b3, voffB); PG8_STAGE(PG8_SB(1, 1), b3 + hstep, voffB); PG8_STAGE(PG8_SA(1, 0), a3, voffA);
            PG8_WAIT_V(8); PG8_WAIT_L(0); PG8_BAR; PG8_MMA(1, 0, At, B0); PG8_MMA(1, 1, At, B1); PG8_BAR; PG8_SCHED;
        }
        if (wr == 0) PG8_BAR;
        E(acc, cur, wv_);
        if (!has_next) break;
#pragma unroll
        for (int a = 0; a < 2; ++a)
#pragma unroll
            for (int b = 0; b < 2; ++b)
#pragma unroll
                for (int m = 0; m < 4; ++m)
#pragma unroll
                    for (int n = 0; n < 2; ++n) acc[a][b][m][n] = (f32x4){0.f, 0.f, 0.f, 0.f};
        cur = nxt; cA = nA; cB = nB; ++ui;
        if (wr == 1) PG8_BAR;
    }
    PG8_WAIT_V(0);
    PG8_BAR;
#undef PG8_SA
#undef PG8_SB
#undef PG8_STAGE
#undef PG8_LDA
#undef PG8_LDB
#undef PG8_MMA
#undef PG8_WAIT_V
#undef PG8_WAIT_L
#undef PG8_BAR
#undef PG8_SCHED
}

#define EPI_FENCE __builtin_amdgcn_sched_barrier(0)
template <int ACT> struct EpiScale {
    static constexpr bool PERM = true;
    bf16_t* O; int ldc; const float* rowsq;
    __device__ __forceinline__ void operator()(f32x4 (&acc)[2][2][4][2], const Unit& u, const int wv_) const {
        const int lane_ = TIDX & 63, wr = wv_ >> 2, wc = wv_ & 3, fr = lane_ & 15, fq = lane_ >> 4;
        const int row0 = u.pm * BM + wr * 64 + fr + opaque0(), col0 = u.pn * BM + wc * 32 + 8 * fq;
#pragma unroll
        for (int ai = 0; ai < 2; ++ai) {
            float rs[4];
#pragma unroll
            for (int m = 0; m < 4; ++m) rs[m] = row_rs(rowsq, row0 + ai * HALF + m * 16);
            EPI_FENCE;
#pragma unroll
            for (int m = 0; m < 4; ++m) {
                const int row = row0 + ai * HALF + m * 16;
                bf16_t* rowp = O + (size_t)row * ldc + col0;
#pragma unroll
                for (int bj = 0; bj < 2; ++bj) {
                    f32x4 v0 = acc[ai][bj][m][0] * rs[m], v1 = acc[ai][bj][m][1] * rs[m];
                    if (ACT == 1) {
#pragma unroll
                        for (int j = 0; j < 4; ++j) { v0[j] = sigmoidf_(v0[j]); v1[j] = sigmoidf_(v1[j]); } }
                    u32x4 w; w.x = cvt_pk_bf16(v0[0], v0[1]); w.y = cvt_pk_bf16(v0[2], v0[3]); w.z = cvt_pk_bf16(v1[0], v1[1]); w.w = cvt_pk_bf16(v1[2], v1[3]);
                    *(u32x4*)(rowp + bj * HALF) = w; }
            }
            EPI_FENCE;
        }
    }
};
struct EpiMerge {
    static constexpr bool PERM = true;
    const bf16_t* gates; float* scratch; bf16_t* merged;
    __device__ __forceinline__ void operator()(f32x4 (&acc)[2][2][4][2], const Unit& u, const int wv_) const {
        const int tid_ = TIDX, lane_ = tid_ & 63, wr = wv_ >> 2, wc = wv_ & 3, fr = lane_ & 15, fq = lane_ >> 4;
        const int n = u.aux; const int row0 = u.pm * BM + wr * 64 + fr + opaque0(), col0 = u.pn * BM + wc * 32 + 8 * fq;
        char* sb = (char*)scratch; const unsigned so = (unsigned)tid_ * 16u;
#pragma unroll
        for (int ai = 0; ai < 2; ++ai)
#pragma unroll
            for (int m = 0; m < 4; ++m) {
                const int row = row0 + ai * HALF + m * 16;
#pragma unroll
                for (int bj = 0; bj < 2; ++bj) {
                    const u32x4 g = *(const u32x4*)(gates + (size_t)row * NG + n * 1024 + col0 + bj * HALF);
                    f32x4 p0 = acc[ai][bj][m][0], p1 = acc[ai][bj][m][1];
                    p0[0] *= bflo(g.x); p0[1] *= bfhi(g.x); p0[2] *= bflo(g.y); p0[3] *= bfhi(g.y);
                    p1[0] *= bflo(g.z); p1[1] *= bfhi(g.z); p1[2] *= bflo(g.w); p1[3] *= bfhi(g.w);
                    const unsigned o0 = so + (unsigned)((ai * 2 + bj) * 4 + m) * 8192u;
                    if (n > 0) { const u32x4 t = *(const u32x4*)(sb + o0);
                        p0[0] += bflo(t.x); p0[1] += bfhi(t.x); p0[2] += bflo(t.y); p0[3] += bfhi(t.y); p1[0] += bflo(t.z); p1[1] += bfhi(t.z); p1[2] += bflo(t.w); p1[3] += bfhi(t.w); }
                    if (n < 2) { u32x4 t; t.x = cvt_pk_bf16(p0[0], p0[1]); t.y = cvt_pk_bf16(p0[2], p0[3]); t.z = cvt_pk_bf16(p1[0], p1[1]); t.w = cvt_pk_bf16(p1[2], p1[3]); *(u32x4*)(sb + o0) = t; }
                    else { u32x4 w; w.x = cvt_pk_bf16(p0[0], p0[1]); w.y = cvt_pk_bf16(p0[2], p0[3]); w.z = cvt_pk_bf16(p1[0], p1[1]); w.w = cvt_pk_bf16(p1[2], p1[3]);
                        *(u32x4*)(merged + (size_t)row * DM + col0 + bj * HALF) = w; }
                }
                EPI_FENCE;
            }
    }
};
struct EpiResid {
    static constexpr bool PERM = false;
    const float* xin; float* xout; bf16_t* xb; float* rowsq; LAS float* ex;
    __device__ __forceinline__ void operator()(f32x4 (&acc)[2][2][4][2], const Unit& u, const int wv_) const {
        const int tid_ = TIDX, lane_ = tid_ & 63, wr = wv_ >> 2, wc = wv_ & 3, fr = lane_ & 15, fq = lane_ >> 4;
        const int row0 = u.pm * BM + wr * 64 + fr + opaque0(), col0 = u.pn * BM + wc * 32 + 4 * fq;
#pragma unroll
        for (int ai = 0; ai < 2; ++ai)
#pragma unroll
            for (int m = 0; m < 4; ++m) {
                const int row = row0 + ai * HALF + m * 16; float ss = 0.f;
#pragma unroll
                for (int bj = 0; bj < 2; ++bj)
#pragma unroll
                    for (int n = 0; n < 2; ++n) {
                        const size_t o = (size_t)row * DM + col0 + bj * HALF + n * 16;
                        const f32x4 xn = *(const f32x4*)(xin + o) + acc[ai][bj][m][n];
                        *(f32x4*)(xout + o) = xn;
                        ss += (xn[0] * xn[0] + xn[1] * xn[1]) + (xn[2] * xn[2] + xn[3] * xn[3]);
                        u32x2 w; w.x = cvt_pk_bf16(xn[0], xn[1]); w.y = cvt_pk_bf16(xn[2], xn[3]); *(u32x2*)(xb + o) = w;
                    }
                ss += __shfl_xor(ss, 16); ss += __shfl_xor(ss, 32);
                if (fq == 0) ex[(ai * HALF + wr * 64 + m * 16 + fr) * 4 + wc] = ss;
                if (m & 1) EPI_FENCE;
            }
        asm volatile("s_waitcnt lgkmcnt(0)" ::: "memory"); __builtin_amdgcn_s_barrier(); asm volatile("" ::: "memory");
        if (tid_ < 256) { const f32x4 q = *(LAS f32x4*)(ex + tid_ * 4); rowsq[(size_t)(u.pm * BM + tid_) * 4 + u.pn] = (q[0] + q[1]) + (q[2] + q[3]); }
    }
};
struct EpiFfn {
    static constexpr bool PERM = false;
    bf16_t* act; const float* rowsq; const float* cw; const float* cb; float* side;
    __device__ __forceinline__ void operator()(f32x4 (&acc)[2][2][4][2], const Unit& u, const int wv_) const {
        const int lane_ = TIDX & 63, wr = wv_ >> 2, wc = wv_ & 3, fr = lane_ & 15, fq = lane_ >> 4;
        const int row0 = u.pm * BM + wr * 64 + fr + opaque0();
        float rs[2][4];
#pragma unroll
        for (int ai = 0; ai < 2; ++ai)
#pragma unroll
            for (int m = 0; m < 4; ++m) rs[ai][m] = row_rs(rowsq, row0 + ai * HALF + m * 16);
        EPI_FENCE;
        float chain = rs[0][0];
#pragma unroll
        for (int nn = 0; nn < 2; ++nn) {
#pragma unroll
            for (int hf = 0; hf < 2; ++hf) {
                const int ch0 = hf * DFF + u.pn * 128 + wc * 32 + 16 * nn + 4 * fq + __float_as_int(opaque0_after(chain));
                const f32x4 w0 = *(const f32x4*)(cw + ch0), w1 = *(const f32x4*)(cw + NUP + ch0), w2 = *(const f32x4*)(cw + 2 * NUP + ch0), wb = *(const f32x4*)(cb + ch0);
                const int fr2 = fr + __float_as_int(opaque0_after(chain));
                if (fr2 < 2 || fr2 >= 14) {
                    const int slot = fr2 < 2 ? fr2 : fr2 - 12;
#pragma unroll
                    for (int ai = 0; ai < 2; ++ai) {
                        const int blk = u.pm * 4 + ai * 2 + wr;
                        const f32x4 xe = fr2 < 2 ? acc[ai][hf][0][nn] * rs[ai][0] : acc[ai][hf][3][nn] * rs[ai][3];
                        *(f32x4*)((char*)side + (unsigned)(((blk * 4 + slot) * NUP + ch0) * 4)) = xe;
                    }
                }
                EPI_FENCE;
#pragma unroll
                for (int ai = 0; ai < 2; ++ai) {
                    f32x4 p1 = (f32x4){0.f, 0.f, 0.f, 0.f}, p2 = p1;
#pragma unroll
                    for (int m = 0; m < 4; ++m) {
                        const float rsm = rs[ai][m] + ((m & 1) ? 0.f : opaque0_after(chain));
                        f32x4 r1, r2, res;
#pragma unroll
                        for (int j = 0; j < 4; ++j) {
                            const float x = acc[ai][hf][m][nn][j] * rsm;
                            r1[j] = dppmov<0x121>(x); r2[j] = dppmov<0x122>(x);
                            const float q1 = fr >= 1 ? r1[j] : p1[j], q2 = fr >= 2 ? r2[j] : p2[j];
                            const float pre = w2[j] * x + w1[j] * q1 + w0[j] * q2 + wb[j];
                            res[j] = (hf == 0) ? siluf_(pre) : acc[ai][0][m][nn][j] * pre;
                        }
                        chain = res[3];
                        if (hf == 0) acc[ai][0][m][nn] = res;
                        else {
                            u32x2 w; w.x = cvt_pk_bf16(res[0], res[1]); w.y = cvt_pk_bf16(res[2], res[3]);
                            *(u32x2*)((char*)act + (unsigned)(((row0 + ai * HALF + m * 16) * DFF + (ch0 - DFF)) * 2)) = w;
                        }
                        p1 = r1; p2 = r2;
                    }
                }
            }
        }
    }
};

__device__ __forceinline__ int srccol(int map, int s0, int n) {
    if (map == 1) return n < 1536 ? n : n + 8;
    if (map == 2) return ((n >> 7) & 1) * DFF + (n >> 8) * 128 + (n & 127);
    return s0 + n;
}
__device__ void prep_w(LAS float* L, bf16_t* dst, const float* src, int K, int N, int ld, int s0, int map, const float* g, int& off, const int wv_, int Gp = 0, int cp = 0) {
    const int G = Gp > 0 ? Gp : (int)gridDim.x, c = Gp > 0 ? cp : (int)blockIdx.x, tid = TIDX;
    const int nkt = K >> 6, ntiles = (N >> 6) * nkt;
    const int i0 = tid >> 6, j = tid & 63, nn = tid >> 3, kc = tid & 7;
    float r[8];
#define PREP_LOAD(T) do { const int n0_ = ((T) / nkt) << 6, k0_ = ((T) % nkt) << 6; const int col_ = srccol(map, s0, n0_) + j; \
        _Pragma("unroll") for (int pp = 0; pp < 8; ++pp) { const int k_ = k0_ + i0 + 8 * pp; float v_ = src[(size_t)k_ * ld + col_]; if (g) v_ *= g[k_]; r[pp] = v_; } } while (0)
    int t = (c + G - off % G) % G;
    if (t < ntiles) PREP_LOAD(t);
    for (; t < ntiles; t += G) {
        const int n0 = (t / nkt) << 6, k0 = (t % nkt) << 6;
#pragma unroll
        for (int pp = 0; pp < 8; ++pp) L[(i0 + 8 * pp) * 65 + j] = r[pp];
        __syncthreads();
        if (t + G < ntiles) PREP_LOAD(t + G);
        u32x4 w;
        w.x = cvt_pk_bf16(L[(kc * 8 + 0) * 65 + nn], L[(kc * 8 + 1) * 65 + nn]); w.y = cvt_pk_bf16(L[(kc * 8 + 2) * 65 + nn], L[(kc * 8 + 3) * 65 + nn]);
        w.z = cvt_pk_bf16(L[(kc * 8 + 4) * 65 + nn], L[(kc * 8 + 5) * 65 + nn]); w.w = cvt_pk_bf16(L[(kc * 8 + 6) * 65 + nn], L[(kc * 8 + 7) * 65 + nn]);
        *(u32x4*)(dst + (size_t)(n0 + nn) * K + k0 + kc * 8) = w;
        __syncthreads();
    }
#undef PREP_LOAD
    off += ntiles;
}
__device__ void prep_layer_main(const Params& p, int l, LAS float* L, const int wv_, int part = 3, int Gp = 0, int cp = 0) {
    bf16_t* W = (bf16_t*)(p.ws + WS_W); int off = 0;
    const int G = Gp > 0 ? Gp : (int)gridDim.x, c = Gp > 0 ? cp : (int)blockIdx.x;
    const float* win = p.w_in + (size_t)l * 1024 * NIN; const float* gn = p.attn_norm + l * 1024;
    if (part & 1) {
        prep_w(L, W + W_IN, win, 1024, NU, NIN, 0, 1, gn, off, wv_, Gp, cp);
        bf16_t* wab = (bf16_t*)(p.ws + WS_WAB);
        for (int i0 = c * 512; i0 < 8192; i0 += G * 512) { const int i = i0 + TIDX; const int jj = i >> 10, k = i & 1023; const float wv = win[(size_t)k * NIN + 1536 + jj] * gn[k];
            const unsigned hi = cvt_pk_bf16(wv, 0.f) & 0xffffu; const float lo = wv - bflo(hi); wab[jj * 1024 + k] = (bf16_t)hi; wab[(8 + jj) * 1024 + k] = (bf16_t)(cvt_pk_bf16(lo, 0.f) & 0xffffu); }
    }
    if (part & 2) {
        prep_w(L, W + W_G, win, 1024, NG, NIN, 4616, 0, gn, off, wv_, Gp, cp);
        for (int n = 0; n < 3; ++n) prep_w(L, W + W_B + (size_t)n * 1024 * 512, p.w_branch + ((size_t)l * 3 + n) * 512 * 1024, 512, 1024, 1024, 0, 0, nullptr, off, wv_, Gp, cp);
        prep_w(L, W + W_O, p.w_out + (size_t)l * 1024 * 1024, 1024, 1024, 1024, 0, 0, nullptr, off, wv_, Gp, cp);
        prep_w(L, W + W_UP, p.w_up + (size_t)l * 1024 * NUP, 1024, NUP, NUP, 0, 2, p.ffn_norm + l * 1024, off, wv_, Gp, cp);
    }
}
__device__ void prep_layer_down(const Params& p, int l, LAS float* L, const int wv_, int Gp = 0, int cp = 0) {
    bf16_t* W = (bf16_t*)(p.ws + WS_W); int off = 0;
    prep_w(L, W + W_DN, p.w_down + (size_t)l * DFF * 1024, DFF, 1024, 1024, 0, 0, nullptr, off, wv_, Gp, cp);
}

__device__ void rownorm(const Params& p, const float* src, float* rowsq, const int wv_) {
    const int tid = TIDX, lane = tid & 63, gw = blockIdx.x * 8 + (tid >> 6), nw = gridDim.x * 8;
    bf16_t* xb = (bf16_t*)(p.ws + WS_XB);
    for (int row = gw; row < MTOK; row += nw) {
        float ss = 0.f;
#pragma unroll
        for (int i = 0; i < 4; ++i) { const size_t o = (size_t)row * DM + i * 256 + lane * 4; const f32x4 v = *(const f32x4*)(src + o);
            ss += (v[0] * v[0] + v[1] * v[1]) + (v[2] * v[2] + v[3] * v[3]); u32x2 w; w.x = cvt_pk_bf16(v[0], v[1]); w.y = cvt_pk_bf16(v[2], v[3]); *(u32x2*)(xb + o) = w; }
#pragma unroll
        for (int s = 32; s >= 1; s >>= 1) ss += __shfl_xor(ss, s);
        if (lane == 0) *(f32x4*)(rowsq + (size_t)row * 4) = (f32x4){ss, 0.f, 0.f, 0.f};
    }
}

__device__ void rot_table(const Params& p, const int wv_) {
    const int t_ = TIDX; float* tab = (float*)(p.ws + WS_ROT);
    for (int i0 = blockIdx.x * 512; i0 < MTOK * 32; i0 += gridDim.x * 512) {
        const int i = i0 + t_, token = i >> 5, j = i & 31;
        const float inv = (float)pow(10000.0, -(double)j / 32.0); float sn, cs; sincosf((float)p.pos[token] * inv, &sn, &cs);
        *(f32x2*)(tab + (size_t)i * 2) = (f32x2){cs, sn};
    }
}
__device__ void ab_tail(const Params& p, const int wv_) {
    const int tid = TIDX, lane = tid & 63, gw = blockIdx.x * 8 + (tid >> 6), nw = gridDim.x * 8, r16 = lane & 15, kq = lane >> 4;
    const bf16_t* xb = (const bf16_t*)(p.ws + WS_XB); const float* rowsq = (const float*)(p.ws + WS_ROWSQ + MiB); const bf16_t* wab = (const bf16_t*)(p.ws + WS_WAB); float* ab = (float*)(p.ws + WS_AB);
    for (int rb = gw; rb < MTOK / 16; rb += nw) {
        const bf16_t* ap = xb + (size_t)(rb * 16 + r16) * DM + kq * 8; const bf16_t* bp = wab + r16 * 1024 + kq * 8;
        f32x4 acc = (f32x4){0.f, 0.f, 0.f, 0.f};
#pragma unroll 8
        for (int kk = 0; kk < 32; ++kk) acc = __builtin_amdgcn_mfma_f32_16x16x32_bf16(*(const bf16x8*)(ap + kk * 32), *(const bf16x8*)(bp + kk * 32), acc, 0, 0, 0);
#pragma unroll
        for (int j = 0; j < 4; ++j) { const float v = acc[j] + __shfl_xor(acc[j], 8); const int row = rb * 16 + kq * 4 + j; if (r16 < 8) ab[(size_t)row * 8 + r16] = v * row_rs(rowsq, row); }
    }
}

__device__ void u0_tail(const Params& p, int layer, LAS float* L, const int wv_) {
    const int tid = TIDX;
    if ((int)blockIdx.x >= 192) return;
    const int cgp = (int)blockIdx.x % 24, ksl = (int)blockIdx.x / 24, kb0 = ksl * 128;
    const float* xs = (layer == 0) ? p.x : p.out; const float* rowsq = (const float*)(p.ws + WS_ROWSQ + MiB); const float* gn = p.attn_norm + layer * 1024;
    const float* win = p.w_in + (size_t)layer * 1024 * NIN; float* u0 = (float*)(p.ws + WS_U0) + (size_t)ksl * 16 * 1536;
    for (int i = tid; i < 16 * 128; i += 512) { const int r = i >> 7, k = kb0 + (i & 127); L[i] = xs[(size_t)(r * SEQ) * DM + k] * row_rs(rowsq, r * SEQ) * gn[k]; }
    __syncthreads();
    const int c = cgp * 64 + (tid & 63), rg = tid >> 6;
    const int sc = c < 1024 ? c : 2056 + (c - 1024);
    const float* wp = win + (size_t)kb0 * NIN + sc;
    float a0 = 0.f, a1 = 0.f;
#pragma unroll 32
    for (int k = 0; k < 128; ++k) { const float w = wp[(size_t)k * NIN]; a0 += L[(2 * rg) * 128 + k] * w; a1 += L[(2 * rg + 1) * 128 + k] * w; }
    u0[(2 * rg) * 1536 + c] = a0; u0[(2 * rg + 1) * 1536 + c] = a1;
    __syncthreads();
}
__device__ __forceinline__ float u0_read(const float* u0, int b, int col) {
    float s = 0.f;
#pragma unroll
    for (int ks = 0; ks < 8; ++ks) s += u0[((size_t)ks * 16 + b) * 1536 + col];
    return s;
}

__device__ __forceinline__ void lds_barrier() { asm volatile("s_waitcnt lgkmcnt(0)" ::: "memory"); __builtin_amdgcn_s_barrier(); asm volatile("" ::: "memory"); }
constexpr int DN_QF = 0, DN_KF = 32768, DN_LM = 0, DN_OS = 16384, DN_QB = 65536, DN_KB = 82944, DN_KT = 100352, DN_AB = 118784, DN_ST = 128000, DN_U = 145408, DN_VT = 32768, DN_VTS = 41984, DN_MISC = 162048;
__device__ void deltanet_item(const Params& p, int layer, int item, LAS unsigned char* Lb, const int wv_) {
    const int tid0 = TIDX, w = wv_;
    const int b = item >> 3, h = (item >> 1) & 3, sl = item & 1;
    LAS float* qs = (LAS float*)(Lb + DN_QF); LAS float* ks = (LAS float*)(Lb + DN_KF);
    LAS bf16_t* XT = (LAS bf16_t*)(Lb + DN_OS); LAS bf16_t* LB21 = (LAS bf16_t*)(Lb + DN_OS + 12288);
    LAS float* Lm = (LAS float*)(Lb + DN_LM); LAS float* os = (LAS float*)(Lb + DN_OS);
    LAS bf16_t* qb = (LAS bf16_t*)(Lb + DN_QB); LAS bf16_t* kb = (LAS bf16_t*)(Lb + DN_KB);
    LAS bf16_t* kT = (LAS bf16_t*)(Lb + DN_KT);
    LAS bf16_t* Ab = (LAS bf16_t*)(Lb + DN_AB);
    LAS bf16_t* Stl = (LAS bf16_t*)(Lb + DN_ST);
    LAS float* U = (LAS float*)(Lb + DN_U);
    LAS bf16_t* vT = (LAS bf16_t*)(Lb + DN_VT); LAS bf16_t* vTs = (LAS bf16_t*)(Lb + DN_VTS);
    LAS float* gcs = (LAS float*)(Lb + DN_MISC); LAS float* bes = gcs + 64; LAS float* egs = gcs + 128; LAS float* egl = gcs + 192;
    const bf16_t* u = (const bf16_t*)(p.ws + WS_U); const float* ab = (const float*)(p.ws + WS_AB);
    float* sta = (float*)(p.ws + WS_STA); bf16_t* ya = (bf16_t*)(p.ws + WS_Y);
    const float* cw = p.dn_conv_w + (size_t)layer * 4 * 1536;
    const int cp0 = tid0 & 127;
    const int colq = (cp0 < 64) ? (h * 128 + 2 * cp0) : (512 + h * 128 + 2 * (cp0 - 64));
    float cwa[4], cwb[4];
#pragma unroll
    for (int j = 0; j < 4; ++j) { cwa[j] = cw[j * 1536 + colq]; cwb[j] = cw[j * 1536 + colq + 1]; }
    const int c80 = tid0 & 7;
    const int colv = 1024 + h * 128 + sl * 64 + c80 * 8;
    const float Aexp = __expf(p.dn_a_log[layer * 4 + h]), dtb = p.dn_dt_bias[layer * 4 + h];
    f32x4 Sacc[4] = {(f32x4){0.f, 0.f, 0.f, 0.f}, (f32x4){0.f, 0.f, 0.f, 0.f}, (f32x4){0.f, 0.f, 0.f, 0.f}, (f32x4){0.f, 0.f, 0.f, 0.f}};
    for (int i = tid0; i < 64 * 136 / 2; i += 512) ((LAS unsigned*)Stl)[i] = 0u;
    unsigned rq[19]; u32x4 rv[4]; float ralpha = 0.f, rbeta = 0.f;
#define DN_PREFETCH(CH) do { const int tid_ = TIDX; const int tq_ = tid_ >> 7, tl8_ = tid_ >> 3, ln_ = tid_ & 63; \
        const int t0_ = (CH) * 64 + tq_ * 16; const bf16_t* up_ = u + (size_t)(b * SEQ + t0_) * NU + colq; \
        _Pragma("unroll") for (int i_ = 0; i_ < 19; ++i_) { rq[i_] = 0u; if (t0_ - 3 + i_ >= 0) rq[i_] = *(const unsigned*)(up_ + (ptrdiff_t)(i_ - 3) * NU); } \
        const int t_ = (CH) * 64 + tl8_; \
        _Pragma("unroll") for (int j_ = 0; j_ < 4; ++j_) { rv[j_] = (u32x4){0u, 0u, 0u, 0u}; if (t_ - 3 + j_ >= 0) rv[j_] = *(const u32x4*)(u + (size_t)(b * SEQ + t_ - 3 + j_) * NU + colv); } \
        if (w == 0) { const float* abp_ = ab + (size_t)(b * SEQ + (CH) * 64 + ln_) * 8; ralpha = abp_[h]; rbeta = abp_[4 + h]; } } while (0)
    DN_PREFETCH(0);
    for (int ch = 0; ch < 32; ++ch) {
        const int tbase = b * SEQ + ch * 64;
        const int tid = TIDX, lane = tid & 63, cp = tid & 127, tq = tid >> 7, tl8 = tid >> 3, c8 = tid & 7, r16 = lane & 15, kq = lane >> 4;
        LAS float* dstq = (cp < 64) ? (qs + 2 * cp) : (ks + 2 * (cp - 64));
        {
            const int t0 = ch * 64 + tq * 16;
            float xa[3] = {bflo(rq[0]), bflo(rq[1]), bflo(rq[2])}, xb_[3] = {bfhi(rq[0]), bfhi(rq[1]), bfhi(rq[2])};
#pragma unroll
            for (int i = 0; i < 16; ++i) {
                float ca = bflo(rq[3 + i]), cb = bfhi(rq[3 + i]);
                if (i == 0 && t0 == 0) { const float* u0p = (const float*)(p.ws + WS_U0); ca = u0_read(u0p, b, colq); cb = u0_read(u0p, b, colq + 1); }
                const float ya_ = cwa[0] * xa[0] + cwa[1] * xa[1] + cwa[2] * xa[2] + cwa[3] * ca, yb_ = cwb[0] * xb_[0] + cwb[1] * xb_[1] + cwb[2] * xb_[2] + cwb[3] * cb;
                *(LAS f32x2*)(dstq + (tq * 16 + i) * 128) = (f32x2){siluf_(ya_), siluf_(yb_)};
                xa[0] = xa[1]; xa[1] = xa[2]; xa[2] = ca; xb_[0] = xb_[1]; xb_[1] = xb_[2]; xb_[2] = cb;
            }
        }
        {
            f32x4 cwv[4][2]; { const float* cwp = cw + colv + opaque0();
#pragma unroll
                for (int j = 0; j < 4; ++j) { cwv[j][0] = *(const f32x4*)(cwp + j * 1536); cwv[j][1] = *(const f32x4*)(cwp + j * 1536 + 4); } }
            f32x4 accv0 = (f32x4){0.f, 0.f, 0.f, 0.f}, accv1 = accv0;
#pragma unroll
            for (int j = 0; j < 4; ++j) { accv0 += cwv[j][0] * (f32x4){bflo(rv[j].x), bfhi(rv[j].x), bflo(rv[j].y), bfhi(rv[j].y)}; accv1 += cwv[j][1] * (f32x4){bflo(rv[j].z), bfhi(rv[j].z), bflo(rv[j].w), bfhi(rv[j].w)}; }
#pragma unroll
            for (int j = 0; j < 4; ++j) { U[tl8 * 65 + c8 * 8 + j] = siluf_(accv0[j]); U[tl8 * 65 + c8 * 8 + 4 + j] = siluf_(accv1[j]); }
        }
        if (w == 0) {
            float g = -Aexp * softplusf_(ralpha + dtb);
#pragma unroll
            for (int sft = 1; sft < 64; sft <<= 1) { const float o = __shfl_up(g, sft); if (lane >= sft) g += o; }
            const float gl = __shfl(g, 63);
            gcs[lane] = g; bes[lane] = sigmoidf_(rbeta); egs[lane] = __expf(g); egl[lane] = __expf(gl - g);
        }
        lds_barrier();
        {
            LAS f32x4* qp = (LAS f32x4*)(qs + tl8 * 128 + c8 * 16); LAS f32x4* kp = (LAS f32x4*)(ks + tl8 * 128 + c8 * 16);
            f32x4 q0 = qp[0], q1 = qp[1], q2 = qp[2], q3 = qp[3], k0 = kp[0], k1 = kp[1], k2 = kp[2], k3 = kp[3];
            float sq = 0.f, sk = 0.f;
#pragma unroll
            for (int j = 0; j < 4; ++j) { sq += q0[j] * q0[j] + q1[j] * q1[j] + q2[j] * q2[j] + q3[j] * q3[j]; sk += k0[j] * k0[j] + k1[j] * k1[j] + k2[j] * k2[j] + k3[j] * k3[j]; }
            sq += __shfl_xor(sq, 1); sq += __shfl_xor(sq, 2); sq += __shfl_xor(sq, 4); sk += __shfl_xor(sk, 1); sk += __shfl_xor(sk, 2); sk += __shfl_xor(sk, 4);
            const float fq_ = rsqrtf(sq + EPS) * 0.08838834764831845f, fk = rsqrtf(sk + EPS);
            q0 *= fq_; q1 *= fq_; q2 *= fq_; q3 *= fq_; k0 *= fk; k1 *= fk; k2 *= fk; k3 *= fk;
            if (ch == 0) {
                float d = 0.f;
#pragma unroll
                for (int j = 0; j < 4; ++j) d += q0[j] * k0[j] + q1[j] * k1[j] + q2[j] * k2[j] + q3[j] * k3[j];
                d += __shfl_xor(d, 1); d += __shfl_xor(d, 2); d += __shfl_xor(d, 4);
                if (tid == 0) gcs[256] = d;
            }
            u32x4 wq0, wq1, wk0, wk1;
            wq0.x = cvt_pk_bf16(q0[0], q0[1]); wq0.y = cvt_pk_bf16(q0[2], q0[3]); wq0.z = cvt_pk_bf16(q1[0], q1[1]); wq0.w = cvt_pk_bf16(q1[2], q1[3]);
            wq1.x = cvt_pk_bf16(q2[0], q2[1]); wq1.y = cvt_pk_bf16(q2[2], q2[3]); wq1.z = cvt_pk_bf16(q3[0], q3[1]); wq1.w = cvt_pk_bf16(q3[2], q3[3]);
            wk0.x = cvt_pk_bf16(k0[0], k0[1]); wk0.y = cvt_pk_bf16(k0[2], k0[3]); wk0.z = cvt_pk_bf16(k1[0], k1[1]); wk0.w = cvt_pk_bf16(k1[2], k1[3]);
            wk1.x = cvt_pk_bf16(k2[0], k2[1]); wk1.y = cvt_pk_bf16(k2[2], k2[3]); wk1.z = cvt_pk_bf16(k3[0], k3[1]); wk1.w = cvt_pk_bf16(k3[2], k3[3]);
            *(LAS u32x4*)(qb + tl8 * 136 + c8 * 16) = wq0; *(LAS u32x4*)(qb + tl8 * 136 + c8 * 16 + 8) = wq1;
            *(LAS u32x4*)(kb + tl8 * 136 + c8 * 16) = wk0; *(LAS u32x4*)(kb + tl8 * 136 + c8 * 16 + 8) = wk1;
            const unsigned kw[8] = {wk0.x, wk0.y, wk0.z, wk0.w, wk1.x, wk1.y, wk1.z, wk1.w};
#pragma unroll
            for (int j = 0; j < 8; ++j) { kT[(c8 * 16 + 2 * j) * 72 + tl8] = (bf16_t)(kw[j] & 0xffffu); kT[(c8 * 16 + 2 * j + 1) * 72 + tl8] = (bf16_t)(kw[j] >> 16); }
            const float be = bes[tl8], bg = be * egs[tl8];
            kp[0] = k0 * bg; kp[1] = k1 * bg; kp[2] = k2 * bg; kp[3] = k3 * bg;
#pragma unroll
            for (int j = 0; j < 8; ++j) U[tl8 * 65 + c8 * 8 + j] *= be;
        }
        lds_barrier();
        if (ch + 1 < 32) DN_PREFETCH(ch + 1);
        {
            const int mt = w & 3, ntb = (w >> 2) * 2;
            f32x4 akk[2] = {(f32x4){0.f, 0.f, 0.f, 0.f}, (f32x4){0.f, 0.f, 0.f, 0.f}}, aqk[2] = {akk[0], akk[0]};
#pragma unroll
            for (int kk = 0; kk < 4; ++kk) {
                const bf16x8 fk_ = *(const LAS bf16x8*)(kb + (mt * 16 + r16) * 136 + kk * 32 + kq * 8);
                const bf16x8 fq2 = *(const LAS bf16x8*)(qb + (mt * 16 + r16) * 136 + kk * 32 + kq * 8);
#pragma unroll
                for (int q = 0; q < 2; ++q) {
                    const bf16x8 fb = *(const LAS bf16x8*)(kb + ((ntb + q) * 16 + r16) * 136 + kk * 32 + kq * 8);
                    akk[q] = __builtin_amdgcn_mfma_f32_16x16x32_bf16(fk_, fb, akk[q], 0, 0, 0);
                    aqk[q] = __builtin_amdgcn_mfma_f32_16x16x32_bf16(fq2, fb, aqk[q], 0, 0, 0);
                }
            }
#pragma unroll
            for (int q = 0; q < 2; ++q)
#pragma unroll
                for (int j = 0; j < 4; ++j) {
                    const int c_ = mt * 16 + kq * 4 + j, s_ = (ntb + q) * 16 + r16;
                    const float dec = __expf(s_ <= c_ ? gcs[c_] - gcs[s_] : 0.f);
                    const float lv = (s_ < c_) ? bes[c_] * akk[q][j] * dec : 0.f;
                    Lm[c_ * 64 + s_] = lv;
                    if (c_ >= 32 && s_ < 32) LB21[(c_ - 32) * 40 + s_] = (bf16_t)(cvt_pk_bf16(lv, 0.f) & 0xffffu);
                    float av = (s_ <= c_) ? aqk[q][j] * dec : 0.f; if (ch == 0 && c_ == 0 && s_ == 0) av = gcs[256];
                    Ab[c_ * 72 + s_] = (bf16_t)(cvt_pk_bf16(av, 0.f) & 0xffffu);
                }
        }
        lds_barrier();
        {
            LAS float* bp = (tid < 64) ? (U + tid) : (ks + (tid - 64)); const int bstr = (tid < 64) ? 65 : 128;
            if (tid < 192) {
                float x[32];
#pragma unroll
                for (int i = 0; i < 32; ++i) x[i] = 0.f;
#pragma unroll
                for (int i = 0; i < 32; ++i) {
                    float a0 = bp[i * bstr], a1 = 0.f;
#pragma unroll
                    for (int m4 = 0; m4 < (i + 3) / 4; ++m4) { const f32x4 l = *(LAS f32x4*)(Lm + i * 64 + m4 * 4);
                        a0 -= l[0] * x[m4 * 4 + 0]; a1 -= l[1] * x[m4 * 4 + 1]; a0 -= l[2] * x[m4 * 4 + 2]; a1 -= l[3] * x[m4 * 4 + 3]; }
                    x[i] = a0 + a1;
                }
                if (tid < 64) {
#pragma unroll
                    for (int i = 0; i < 32; ++i) U[i * 65 + tid] = x[i];
                } else {
#pragma unroll
                    for (int i = 0; i < 32; ++i) kb[i * 136 + (tid - 64)] = (bf16_t)(cvt_pk_bf16(x[i], 0.f) & 0xffffu);
                }
#pragma unroll
                for (int i8 = 0; i8 < 4; ++i8) { u32x4 t; t.x = cvt_pk_bf16(x[i8 * 8 + 0], x[i8 * 8 + 1]); t.y = cvt_pk_bf16(x[i8 * 8 + 2], x[i8 * 8 + 3]); t.z = cvt_pk_bf16(x[i8 * 8 + 4], x[i8 * 8 + 5]); t.w = cvt_pk_bf16(x[i8 * 8 + 6], x[i8 * 8 + 7]);
                    *(LAS u32x4*)(XT + tid * 32 + i8 * 8) = t; }
            }
            lds_barrier();
#pragma unroll
            for (int q = 0; q < 3; ++q) {
                const int t_ = w * 3 + q, mt = t_ & 1, nt = t_ >> 1;
                const bf16x8 fa = *(const LAS bf16x8*)(LB21 + (mt * 16 + r16) * 40 + kq * 8);
                const bf16x8 fb = *(const LAS bf16x8*)(XT + (nt * 16 + r16) * 32 + kq * 8);
                const f32x4 cacc = __builtin_amdgcn_mfma_f32_16x16x32_bf16(fa, fb, (f32x4){0.f, 0.f, 0.f, 0.f}, 0, 0, 0);
                const int col_ = nt * 16 + r16;
                LAS float* cp_ = (col_ < 64) ? (U + col_) : (ks + (col_ - 64)); const int cstr = (col_ < 64) ? 65 : 128;
#pragma unroll
                for (int j = 0; j < 4; ++j) cp_[(32 + mt * 16 + kq * 4 + j) * cstr] -= cacc[j];
            }
            lds_barrier();
            if (tid < 192) {
                float x[32];
#pragma unroll
                for (int i = 0; i < 32; ++i) x[i] = 0.f;
#pragma unroll
                for (int i = 0; i < 32; ++i) {
                    float a0 = bp[(32 + i) * bstr], a1 = 0.f;
#pragma unroll
                    for (int m4 = 0; m4 < (i + 3) / 4; ++m4) { const f32x4 l = *(LAS f32x4*)(Lm + (32 + i) * 64 + 32 + m4 * 4);
                        a0 -= l[0] * x[m4 * 4 + 0]; a1 -= l[1] * x[m4 * 4 + 1]; a0 -= l[2] * x[m4 * 4 + 2]; a1 -= l[3] * x[m4 * 4 + 3]; }
                    x[i] = a0 + a1;
                }
                if (tid < 64) {
#pragma unroll
                    for (int i = 0; i < 32; ++i) U[(32 + i) * 65 + tid] = x[i];
                } else {
#pragma unroll
                    for (int i = 0; i < 32; ++i) kb[(32 + i) * 136 + (tid - 64)] = (bf16_t)(cvt_pk_bf16(x[i], 0.f) & 0xffffu);
                }
            }
        }
        lds_barrier();
        const u32x4 zr = *(const u32x4*)(u + (size_t)(tbase + tl8) * NU + 1536 + h * 128 + sl * 64 + c8 * 8);
        const float* nwp = p.dn_norm_w + layer * 128 + sl * 64 + c8 * 8 + opaque0(); const f32x4 nw0 = *(const f32x4*)nwp, nw1 = *(const f32x4*)(nwp + 4);
        f32x4 qsv[2];
        const int mtE = w & 3, ntE = (w >> 2) * 2;
        {
            f32x4 aws[2] = {(f32x4){0.f, 0.f, 0.f, 0.f}, (f32x4){0.f, 0.f, 0.f, 0.f}}, aqs[2] = {aws[0], aws[0]};
#pragma unroll
            for (int kk = 0; kk < 4; ++kk) {
                const bf16x8 fw = *(const LAS bf16x8*)(kb + (mtE * 16 + r16) * 136 + kk * 32 + kq * 8);
                const bf16x8 fq2 = *(const LAS bf16x8*)(qb + (mtE * 16 + r16) * 136 + kk * 32 + kq * 8);
#pragma unroll
                for (int q = 0; q < 2; ++q) {
                    const bf16x8 fs = *(const LAS bf16x8*)(Stl + ((ntE + q) * 16 + r16) * 136 + kk * 32 + kq * 8);
                    aws[q] = __builtin_amdgcn_mfma_f32_16x16x32_bf16(fw, fs, aws[q], 0, 0, 0);
                    aqs[q] = __builtin_amdgcn_mfma_f32_16x16x32_bf16(fq2, fs, aqs[q], 0, 0, 0);
                }
            }
#pragma unroll
            for (int q = 0; q < 2; ++q)
#pragma unroll
                for (int j = 0; j < 4; ++j) {
                    const int c_ = mtE * 16 + kq * 4 + j, v_ = (ntE + q) * 16 + r16;
                    const float vn = U[c_ * 65 + v_] - aws[q][j];
                    qsv[q][j] = aqs[q][j] * egs[c_];
                    vT[v_ * 72 + c_] = (bf16_t)(cvt_pk_bf16(vn, 0.f) & 0xffffu);
                    vTs[v_ * 72 + c_] = (bf16_t)(cvt_pk_bf16(vn * egl[c_], 0.f) & 0xffffu);
                }
        }
        lds_barrier();
        {
            f32x4 aav[2] = {(f32x4){0.f, 0.f, 0.f, 0.f}, (f32x4){0.f, 0.f, 0.f, 0.f}};
#pragma unroll
            for (int kk = 0; kk < 2; ++kk) {
                const bf16x8 fa = *(const LAS bf16x8*)(Ab + (mtE * 16 + r16) * 72 + kk * 32 + kq * 8);
#pragma unroll
                for (int q = 0; q < 2; ++q) { const bf16x8 fv = *(const LAS bf16x8*)(vT + ((ntE + q) * 16 + r16) * 72 + kk * 32 + kq * 8); aav[q] = __builtin_amdgcn_mfma_f32_16x16x32_bf16(fa, fv, aav[q], 0, 0, 0); }
            }
#pragma unroll
            for (int q = 0; q < 2; ++q)
#pragma unroll
                for (int j = 0; j < 4; ++j) os[(mtE * 16 + kq * 4 + j) * 64 + (ntE + q) * 16 + r16] = qsv[q][j] + aav[q][j];
            const float ge = __expf(gcs[63]);
            const int mtS = w & 3, ntS = (w >> 2) * 4;
#pragma unroll
            for (int q = 0; q < 4; ++q) {
                Sacc[q] *= ge;
#pragma unroll
                for (int kk = 0; kk < 2; ++kk) {
                    const bf16x8 fv = *(const LAS bf16x8*)(vTs + (mtS * 16 + r16) * 72 + kk * 32 + kq * 8);
                    const bf16x8 fk_ = *(const LAS bf16x8*)(kT + ((ntS + q) * 16 + r16) * 72 + kk * 32 + kq * 8);
                    Sacc[q] = __builtin_amdgcn_mfma_f32_16x16x32_bf16(fv, fk_, Sacc[q], 0, 0, 0);
                }
            }
        }
        lds_barrier();
#pragma unroll
        for (int q = 0; q < 4; ++q)
#pragma unroll
            for (int j = 0; j < 4; ++j) Stl[((w & 3) * 16 + kq * 4 + j) * 136 + ((w >> 2) * 4 + q) * 16 + r16] = (bf16_t)(cvt_pk_bf16(Sacc[q][j], 0.f) & 0xffffu);
        {
            const int token = tbase + tl8;
            const f32x4 o4 = *(LAS f32x4*)(os + tl8 * 64 + c8 * 8), o5 = *(LAS f32x4*)(os + tl8 * 64 + c8 * 8 + 4);
            float ss = ((o4[0] * o4[0] + o4[1] * o4[1]) + (o4[2] * o4[2] + o4[3] * o4[3])) + ((o5[0] * o5[0] + o5[1] * o5[1]) + (o5[2] * o5[2] + o5[3] * o5[3]));
            ss += __shfl_xor(ss, 1); ss += __shfl_xor(ss, 2); ss += __shfl_xor(ss, 4);
            if (c8 == 0) { sta[((size_t)token * 4 + h) * 4 + sl] = ss; sta[((size_t)token * 4 + h) * 4 + 2 + sl] = 0.f; }
            u32x4 wv2;
            wv2.x = cvt_pk_bf16(o4[0] * nw0[0] * siluf_(bflo(zr.x)), o4[1] * nw0[1] * siluf_(bfhi(zr.x))); wv2.y = cvt_pk_bf16(o4[2] * nw0[2] * siluf_(bflo(zr.y)), o4[3] * nw0[3] * siluf_(bfhi(zr.y)));
            wv2.z = cvt_pk_bf16(o5[0] * nw1[0] * siluf_(bflo(zr.z)), o5[1] * nw1[1] * siluf_(bfhi(zr.z))); wv2.w = cvt_pk_bf16(o5[2] * nw1[2] * siluf_(bflo(zr.w)), o5[3] * nw1[3] * siluf_(bfhi(zr.w)));
            *(u32x4*)(ya + (size_t)token * 512 + h * 128 + sl * 64 + c8 * 8) = wv2;
        }
        lds_barrier();
    }
#undef DN_PREFETCH
}

constexpr int RT_QB = 0, RT_KB = 9216, RT_KZT = 18432, RT_VT = 27648, RT_PB = 32256, RT_ST = 41472, RT_OS = 46080, RT_MISC = 54272;
__device__ void retention_item(const Params& p, int item, LAS unsigned char* Lb, const int wv_) {
    const int tid0 = TIDX, w = wv_;
    const int b = item >> 4, h = (item >> 2) & 3, sl = item & 3;
    LAS bf16_t* qb = (LAS bf16_t*)(Lb + RT_QB); LAS bf16_t* kb = (LAS bf16_t*)(Lb + RT_KB);
    LAS bf16_t* kzT = (LAS bf16_t*)(Lb + RT_KZT);
    LAS bf16_t* vT = (LAS bf16_t*)(Lb + RT_VT);
    LAS bf16_t* Pb = (LAS bf16_t*)(Lb + RT_PB);
    LAS bf16_t* Stl = (LAS bf16_t*)(Lb + RT_ST);
    LAS float* os = (LAS float*)(Lb + RT_OS); LAS float* misc = (LAS float*)(Lb + RT_MISC);
    const bf16_t* u = (const bf16_t*)(p.ws + WS_U);
    float* stb = (float*)(p.ws + WS_STB); bf16_t* yb = (bf16_t*)(p.ws + WS_Y) + (size_t)MTOK * 512;
    const float* rtab = (const float*)(p.ws + WS_ROT);
    const float lg2 = log2f(1.0f - exp2f(-5.0f - (float)h));
    f32x4 Sacc = (f32x4){0.f, 0.f, 0.f, 0.f};
    for (int i = tid0; i < 32 * 72 / 2; i += 512) ((LAS unsigned*)Stl)[i] = 0u;
    u32x2 rq1, rq2, rk1, rk2, rvv; f32x4 rcs0, rcs1;
#define RT_PREFETCH(CH) do { const int tid_ = TIDX; const int tl8_ = tid_ >> 3, c8_ = tid_ & 7; const int token_ = b * SEQ + (CH) * 64 + tl8_; const bf16_t* ur_ = u + (size_t)token_ * NU; \
        rq1 = *(const u32x2*)(ur_ + 2048 + h * 64 + c8_ * 4); rq2 = *(const u32x2*)(ur_ + 2048 + h * 64 + 32 + c8_ * 4); \
        rk1 = *(const u32x2*)(ur_ + 2304 + h * 64 + c8_ * 4); rk2 = *(const u32x2*)(ur_ + 2304 + h * 64 + 32 + c8_ * 4); \
        rvv = *(const u32x2*)(ur_ + 2560 + h * 128 + sl * 32 + c8_ * 4); \
        rcs0 = *(const f32x4*)(rtab + ((size_t)token_ * 32 + c8_ * 4) * 2); rcs1 = *(const f32x4*)(rtab + ((size_t)token_ * 32 + c8_ * 4) * 2 + 4); } while (0)
    RT_PREFETCH(0);
    for (int ch = 0; ch < 32; ++ch) {
        const int tid = TIDX, lane = tid & 63, tl8 = tid >> 3, c8 = tid & 7, r16 = lane & 15, kq = lane >> 4;
        const int token = b * SEQ + ch * 64 + tl8;
        {
            float q1f[4] = {bflo(rq1.x), bfhi(rq1.x), bflo(rq1.y), bfhi(rq1.y)}, q2f[4] = {bflo(rq2.x), bfhi(rq2.x), bflo(rq2.y), bfhi(rq2.y)};
            float k1f[4] = {bflo(rk1.x), bfhi(rk1.x), bflo(rk1.y), bfhi(rk1.y)}, k2f[4] = {bflo(rk2.x), bfhi(rk2.x), bflo(rk2.y), bfhi(rk2.y)};
            if (ch == 0 && tl8 == 0) {
                const float* u0p = (const float*)(p.ws + WS_U0); const int cb_ = 1024 + h * 64 + c8 * 4;
#pragma unroll
                for (int j = 0; j < 4; ++j) { q1f[j] = u0_read(u0p, b, cb_ + j); q2f[j] = u0_read(u0p, b, cb_ + 32 + j); k1f[j] = u0_read(u0p, b, cb_ + 256 + j); k2f[j] = u0_read(u0p, b, cb_ + 256 + 32 + j); }
            }
            float qo1[4], qo2[4], ko1[4], ko2[4]; float d00 = 0.f;
#pragma unroll
            for (int j = 0; j < 4; ++j) { const float cs = (j < 2) ? rcs0[2 * j] : rcs1[2 * (j - 2)], sn = (j < 2) ? rcs0[2 * j + 1] : rcs1[2 * (j - 2) + 1];
                qo1[j] = q1f[j] * cs - q2f[j] * sn; qo2[j] = q1f[j] * sn + q2f[j] * cs;
                ko1[j] = (k1f[j] * cs - k2f[j] * sn) * 0.125f; ko2[j] = (k1f[j] * sn + k2f[j] * cs) * 0.125f;
                d00 += qo1[j] * ko1[j] + qo2[j] * ko2[j]; }
            if (ch == 0) { d00 += __shfl_xor(d00, 1); d00 += __shfl_xor(d00, 2); d00 += __shfl_xor(d00, 4); if (tid == 0) misc[0] = d00; }
            u32x2 wq1, wq2, wk1, wk2;
            wq1.x = cvt_pk_bf16(qo1[0], qo1[1]); wq1.y = cvt_pk_bf16(qo1[2], qo1[3]); wq2.x = cvt_pk_bf16(qo2[0], qo2[1]); wq2.y = cvt_pk_bf16(qo2[2], qo2[3]);
            wk1.x = cvt_pk_bf16(ko1[0], ko1[1]); wk1.y = cvt_pk_bf16(ko1[2], ko1[3]); wk2.x = cvt_pk_bf16(ko2[0], ko2[1]); wk2.y = cvt_pk_bf16(ko2[2], ko2[3]);
            *(LAS u32x2*)(qb + tl8 * 72 + c8 * 4) = wq1; *(LAS u32x2*)(qb + tl8 * 72 + 32 + c8 * 4) = wq2;
            *(LAS u32x2*)(kb + tl8 * 72 + c8 * 4) = wk1; *(LAS u32x2*)(kb + tl8 * 72 + 32 + c8 * 4) = wk2;
            const float zeta = exp2f((float)(63 - tl8) * lg2);
#pragma unroll
            for (int j = 0; j < 4; ++j) { kzT[(c8 * 4 + j) * 72 + tl8] = (bf16_t)(cvt_pk_bf16(ko1[j] * zeta, 0.f) & 0xffffu); kzT[(32 + c8 * 4 + j) * 72 + tl8] = (bf16_t)(cvt_pk_bf16(ko2[j] * zeta, 0.f) & 0xffffu); }
            vT[(c8 * 4 + 0) * 72 + tl8] = (bf16_t)(rvv.x & 0xffffu); vT[(c8 * 4 + 1) * 72 + tl8] = (bf16_t)(rvv.x >> 16);
            vT[(c8 * 4 + 2) * 72 + tl8] = (bf16_t)(rvv.y & 0xffffu); vT[(c8 * 4 + 3) * 72 + tl8] = (bf16_t)(rvv.y >> 16);
        }
        lds_barrier();
        if (ch + 1 < 32) RT_PREFETCH(ch + 1);
        f32x4 cross = (f32x4){0.f, 0.f, 0.f, 0.f};
        const int mtE = w & 3, ntE = w >> 2;
        {
            const int mt = w & 3, ntb = (w >> 2) * 2;
            f32x4 asc[2] = {(f32x4){0.f, 0.f, 0.f, 0.f}, (f32x4){0.f, 0.f, 0.f, 0.f}};
#pragma unroll
            for (int kk = 0; kk < 2; ++kk) {
                const bf16x8 fq2 = *(const LAS bf16x8*)(qb + (mt * 16 + r16) * 72 + kk * 32 + kq * 8);
#pragma unroll
                for (int q = 0; q < 2; ++q) { const bf16x8 fb = *(const LAS bf16x8*)(kb + ((ntb + q) * 16 + r16) * 72 + kk * 32 + kq * 8); asc[q] = __builtin_amdgcn_mfma_f32_16x16x32_bf16(fq2, fb, asc[q], 0, 0, 0); }
                const bf16x8 fs = *(const LAS bf16x8*)(Stl + (ntE * 16 + r16) * 72 + kk * 32 + kq * 8);
                cross = __builtin_amdgcn_mfma_f32_16x16x32_bf16(fq2, fs, cross, 0, 0, 0);
            }
#pragma unroll
            for (int q = 0; q < 2; ++q)
#pragma unroll
                for (int j = 0; j < 4; ++j) {
                    const int c_ = mt * 16 + kq * 4 + j, s_ = (ntb + q) * 16 + r16;
                    float sc = (s_ <= c_) ? asc[q][j] * exp2f((float)(c_ - s_) * lg2) : 0.f;
                    if (ch == 0 && c_ == 0 && s_ == 0) sc = misc[0];
                    Pb[c_ * 72 + s_] = (bf16_t)(cvt_pk_bf16(sc, 0.f) & 0xffffu);
                }
#pragma unroll
            for (int j = 0; j < 4; ++j) cross[j] *= exp2f((float)(mtE * 16 + kq * 4 + j + 1) * lg2);
        }
        lds_barrier();
        {
            f32x4 inner = (f32x4){0.f, 0.f, 0.f, 0.f};
#pragma unroll
            for (int kk = 0; kk < 2; ++kk) {
                const bf16x8 fa = *(const LAS bf16x8*)(Pb + (mtE * 16 + r16) * 72 + kk * 32 + kq * 8);
                const bf16x8 fv = *(const LAS bf16x8*)(vT + (ntE * 16 + r16) * 72 + kk * 32 + kq * 8);
                inner = __builtin_amdgcn_mfma_f32_16x16x32_bf16(fa, fv, inner, 0, 0, 0);
            }
#pragma unroll
            for (int j = 0; j < 4; ++j) os[(mtE * 16 + kq * 4 + j) * 32 + ntE * 16 + r16] = cross[j] + inner[j];
            const int mtS = w & 1, ntS = w >> 1;
            Sacc *= exp2f(64.0f * lg2);
#pragma unroll
            for (int kk = 0; kk < 2; ++kk) {
                const bf16x8 fv = *(const LAS bf16x8*)(vT + (mtS * 16 + r16) * 72 + kk * 32 + kq * 8);
                const bf16x8 fk_ = *(const LAS bf16x8*)(kzT + (ntS * 16 + r16) * 72 + kk * 32 + kq * 8);
                Sacc = __builtin_amdgcn_mfma_f32_16x16x32_bf16(fv, fk_, Sacc, 0, 0, 0);
            }
        }
        lds_barrier();
#pragma unroll
        for (int j = 0; j < 4; ++j) Stl[((w & 1) * 16 + kq * 4 + j) * 72 + (w >> 1) * 16 + r16] = (bf16_t)(cvt_pk_bf16(Sacc[j], 0.f) & 0xffffu);
        {
            const f32x4 o4 = *(LAS f32x4*)(os + tl8 * 32 + c8 * 4);
            float s1 = (o4[0] + o4[1]) + (o4[2] + o4[3]), s2 = (o4[0] * o4[0] + o4[1] * o4[1]) + (o4[2] * o4[2] + o4[3] * o4[3]);
            s1 += __shfl_xor(s1, 1); s1 += __shfl_xor(s1, 2); s1 += __shfl_xor(s1, 4); s2 += __shfl_xor(s2, 1); s2 += __shfl_xor(s2, 2); s2 += __shfl_xor(s2, 4);
            if (c8 == 0) *(f32x2*)(stb + (((size_t)token * 4 + h) * 4 + sl) * 2) = (f32x2){s1, s2};
            u32x2 wv2; wv2.x = cvt_pk_bf16(o4[0], o4[1]); wv2.y = cvt_pk_bf16(o4[2], o4[3]);
            *(u32x2*)(yb + (size_t)token * 512 + h * 128 + sl * 32 + c8 * 4) = wv2;
        }
        lds_barrier();
    }
#undef RT_PREFETCH
}

__device__ void lru_item(const Params& p, int layer, int item, LAS unsigned char* Lb, const int wv_) {
    const int tid = TIDX, lane = tid & 63, w = tid >> 6;
    const int b = item >> 4, nb = (item >> 2) & 3, cs = item & 3;
    LAS bf16_t* Wt = (LAS bf16_t*)Lb;
    LAS bf16_t* xcb = (LAS bf16_t*)(Lb + 17408);
    LAS float* xcf = (LAS float*)(Lb + 34816);
    LAS float* pre = xcf + 2048;
    LAS float* aa = pre + 4096;
    LAS float* bbs = aa + 2048;
    LAS float* hs = bbs + 2048;
    const bf16_t* u = (const bf16_t*)(p.ws + WS_U); bf16_t* yc = (bf16_t*)(p.ws + WS_Y) + (size_t)2 * MTOK * 512;
    {
        const float* wa = p.lru_wa + ((size_t)layer * 4 + nb) * 128 * 128; const float* wx = p.lru_wx + ((size_t)layer * 4 + nb) * 128 * 128;
        for (int i = tid; i < 8192; i += 512) { const int k = i >> 6, j = i & 63; const float v = j < 32 ? wa[k * 128 + cs * 32 + j] : wx[k * 128 + cs * 32 + j - 32];
            Wt[j * 136 + k] = (bf16_t)(cvt_pk_bf16(v, 0.f) & 0xffffu); }
    }
    const int cp = tid & 63, tg = tid >> 6;
    const int cch = nb * 128 + 2 * cp;
    float cwa[4], cwb[4];
#pragma unroll
    for (int j = 0; j < 4; ++j) { cwa[j] = p.lru_conv_w[((size_t)layer * 4 + j) * 512 + cch]; cwb[j] = p.lru_conv_w[((size_t)layer * 4 + j) * 512 + cch + 1]; }
    const float cba = p.lru_conv_b[layer * 512 + cch], cbb = p.lru_conv_b[layer * 512 + cch + 1];
    const int ce = tid & 31, te = tid >> 5;
    const int och = nb * 128 + cs * 32 + ce;
    const float ba = p.lru_ba[layer * 512 + och], bx = p.lru_bx[layer * 512 + och], sp8 = 8.0f * softplusf_(-p.lru_lambda[layer * 512 + och]);
    const int tl8 = tid >> 3, c8 = tid & 7;
    float hcar = 0.f;
    unsigned rc[11]; u32x2 rgg;
#define LRU_PREFETCH(CH) do { const int t0_ = (CH) * 64 + tg * 8; const bf16_t* up_ = u + (size_t)(b * SEQ + t0_) * NU + 3584 + cch; \
        _Pragma("unroll") for (int i_ = 0; i_ < 11; ++i_) { rc[i_] = 0u; if (t0_ - 3 + i_ >= 0) rc[i_] = *(const unsigned*)(up_ + (ptrdiff_t)(i_ - 3) * NU); } \
        rgg = *(const u32x2*)(u + (size_t)(b * SEQ + (CH) * 64 + tl8) * NU + 4096 + nb * 128 + cs * 32 + c8 * 4); } while (0)
    LRU_PREFETCH(0);
    lds_barrier();
    for (int ch = 0; ch < 32; ++ch) {
        const u32x2 gr = rgg;
        {
            float xa[3] = {bflo(rc[0]), bflo(rc[1]), bflo(rc[2])}, xb_[3] = {bfhi(rc[0]), bfhi(rc[1]), bfhi(rc[2])};
#pragma unroll
            for (int i = 0; i < 8; ++i) {
                const float ca = bflo(rc[3 + i]), cb = bfhi(rc[3 + i]);
                const float ya_ = cwa[0] * xa[0] + cwa[1] * xa[1] + cwa[2] * xa[2] + cwa[3] * ca + cba, yb_ = cwb[0] * xb_[0] + cwb[1] * xb_[1] + cwb[2] * xb_[2] + cwb[3] * cb + cbb;
                const int tl = tg * 8 + i;
                *(LAS unsigned*)(xcb + tl * 136 + 2 * cp) = cvt_pk_bf16(ya_, yb_);
                if ((cp >> 4) == cs) *(LAS f32x2*)(xcf + tl * 32 + ((2 * cp) & 31)) = (f32x2){ya_, yb_};
                xa[0] = xa[1]; xa[1] = xa[2]; xa[2] = ca; xb_[0] = xb_[1]; xb_[1] = xb_[2]; xb_[2] = cb;
            }
        }
        if (ch + 1 < 32) LRU_PREFETCH(ch + 1);
        lds_barrier();
        {
            const int mt = w & 3, ntb = (w >> 2) * 2, r16 = lane & 15, kq = lane >> 4;
#pragma unroll
            for (int q = 0; q < 2; ++q) {
                const int ntile = ntb + q; f32x4 acc = (f32x4){0.f, 0.f, 0.f, 0.f};
#pragma unroll
                for (int kk = 0; kk < 4; ++kk) {
                    const bf16x8 af = *(const LAS bf16x8*)(xcb + (mt * 16 + r16) * 136 + kk * 32 + kq * 8);
                    const bf16x8 bf = *(const LAS bf16x8*)(Wt + (ntile * 16 + r16) * 136 + kk * 32 + kq * 8);
                    acc = __builtin_amdgcn_mfma_f32_16x16x32_bf16(af, bf, acc, 0, 0, 0);
                }
#pragma unroll
                for (int j = 0; j < 4; ++j) pre[(mt * 16 + kq * 4 + j) * 64 + ntile * 16 + r16] = acc[j];
            }
        }
        lds_barrier();
#pragma unroll
        for (int i = 0; i < 4; ++i) {
            const int tl = te * 4 + i;
            const float r = sigmoidf_(pre[tl * 64 + ce] + ba), ig = sigmoidf_(pre[tl * 64 + 32 + ce] + bx);
            const float la = -r * sp8; const float a = __expf(la); const float mult = sqrtf(fmaxf(-expm1f(2.0f * la), 0.f));
            aa[tl * 32 + ce] = a; bbs[tl * 32 + ce] = mult * ig * xcf[tl * 32 + ce];
        }
        lds_barrier();
        if (tid < 32) {
#pragma unroll 8
            for (int tl = 0; tl < 64; ++tl) { hcar = aa[tl * 32 + tid] * hcar + bbs[tl * 32 + tid]; hs[tl * 32 + tid] = hcar; }
        }
        lds_barrier();
        {
            const int token = b * SEQ + ch * 64 + tl8;
            const f32x4 h4 = *(LAS f32x4*)(hs + tl8 * 32 + c8 * 4);
            u32x2 wv_; wv_.x = cvt_pk_bf16(h4[0] * gelu_tanh(bflo(gr.x)), h4[1] * gelu_tanh(bfhi(gr.x))); wv_.y = cvt_pk_bf16(h4[2] * gelu_tanh(bflo(gr.y)), h4[3] * gelu_tanh(bfhi(gr.y)));
            *(u32x2*)(yc + (size_t)token * 512 + nb * 128 + cs * 32 + c8 * 4) = wv_;
        }
    }
    lds_barrier();
}

__device__ void finalize_y(const Params& p, const int wv_) {
    const bf16_t* u = (const bf16_t*)(p.ws + WS_U); const float* sta = (const float*)(p.ws + WS_STA); const float* stb = (const float*)(p.ws + WS_STB);
    bf16_t* ya = (bf16_t*)(p.ws + WS_Y); bf16_t* yb = ya + (size_t)MTOK * 512;
    const int t_ = TIDX;
    for (int i0 = blockIdx.x * 512; i0 < MTOK * 128; i0 += gridDim.x * 512) {
        const int i = i0 + t_; const int token = i >> 7, v = i & 127;
        if (v < 64) {
            const int chn = v * 8, h = chn >> 7;
            const f32x4 s = *(const f32x4*)(sta + ((size_t)token * 4 + h) * 4);
            const float sc = rsqrtf(((s[0] + s[1]) + (s[2] + s[3])) * (1.0f / 128.0f) + EPS);
            u32x4* yp = (u32x4*)(ya + (size_t)token * 512 + chn); const u32x4 r = *yp; u32x4 o;
            o.x = cvt_pk_bf16(bflo(r.x) * sc, bfhi(r.x) * sc); o.y = cvt_pk_bf16(bflo(r.y) * sc, bfhi(r.y) * sc); o.z = cvt_pk_bf16(bflo(r.z) * sc, bfhi(r.z) * sc); o.w = cvt_pk_bf16(bflo(r.w) * sc, bfhi(r.w) * sc);
            *yp = o;
        } else {
            const int chn = (v - 64) * 8, h = chn >> 7;
            const f32x4 sA = *(const f32x4*)(stb + ((size_t)token * 4 + h) * 8), sB = *(const f32x4*)(stb + ((size_t)token * 4 + h) * 8 + 4);
            const float mu = ((sA[0] + sA[2]) + (sB[0] + sB[2])) * (1.0f / 128.0f), ex2 = ((sA[1] + sA[3]) + (sB[1] + sB[3])) * (1.0f / 128.0f);
            const float rstd = rsqrtf(fmaxf(ex2 - mu * mu, 0.f) + EPS);
            u32x4* yp = (u32x4*)(yb + (size_t)token * 512 + chn); const u32x4 r = *yp; const u32x4 g = *(const u32x4*)(u + (size_t)token * NU + 3072 + chn); u32x4 o;
            o.x = cvt_pk_bf16((bflo(r.x) - mu) * rstd * siluf_(bflo(g.x)), (bfhi(r.x) - mu) * rstd * siluf_(bfhi(g.x)));
            o.y = cvt_pk_bf16((bflo(r.y) - mu) * rstd * siluf_(bflo(g.y)), (bfhi(r.y) - mu) * rstd * siluf_(bfhi(g.y)));
            o.z = cvt_pk_bf16((bflo(r.z) - mu) * rstd * siluf_(bflo(g.z)), (bfhi(r.z) - mu) * rstd * siluf_(bfhi(g.z)));
            o.w = cvt_pk_bf16((bflo(r.w) - mu) * rstd * siluf_(bflo(g.w)), (bfhi(r.w) - mu) * rstd * siluf_(bfhi(g.w)));
            *yp = o;
        }
    }
}
__device__ void ffn_fixup(const Params& p, int layer, const int wv_) {
    const float* side = (const float*)(p.ws + WS_Y); bf16_t* act = (bf16_t*)(p.ws + WS_U);
    const float* cw = p.ffn_conv_w + (size_t)layer * 3 * NUP; const float* cb = p.ffn_conv_b + (size_t)layer * NUP;
    const int t_ = TIDX;
    for (int i0 = blockIdx.x * 512; i0 < 512 * DFF; i0 += gridDim.x * 512) {
        const int i = i0 + t_; const int blk = i / DFF, chn = i - blk * DFF;
        if ((blk & 31) == 0) continue;
        const float* s0 = side + (size_t)blk * 4 * NUP; const float* sm = side + (size_t)(blk - 1) * 4 * NUP;
        const float g0 = s0[chn], g1 = s0[NUP + chn], gm2 = sm[2 * NUP + chn], gm1 = sm[3 * NUP + chn];
        const float v0 = s0[DFF + chn], v1 = s0[NUP + DFF + chn], vm2 = sm[2 * NUP + DFF + chn], vm1 = sm[3 * NUP + DFF + chn];
        const float wg0 = cw[chn], wg1 = cw[NUP + chn], wg2 = cw[2 * NUP + chn], bg = cb[chn];
        const float wv0 = cw[DFF + chn], wv1 = cw[NUP + DFF + chn], wv2 = cw[2 * NUP + DFF + chn], bv = cb[DFF + chn];
        const float pg0 = wg2 * g0 + wg1 * gm1 + wg0 * gm2 + bg, pg1 = wg2 * g1 + wg1 * g0 + wg0 * gm1 + bg;
        const float pv0 = wv2 * v0 + wv1 * vm1 + wv0 * vm2 + bv, pv1 = wv2 * v1 + wv1 * v0 + wv0 * vm1 + bv;
        act[(size_t)(blk * 64) * DFF + chn] = (bf16_t)(cvt_pk_bf16(siluf_(pg0) * pv0, 0.f) & 0xffffu);
        act[(size_t)(blk * 64 + 1) * DFF + chn] = (bf16_t)(cvt_pk_bf16(siluf_(pg1) * pv1, 0.f) & 0xffffu);
    }
}
__device__ void final_norm(const Params& p, const int wv_) {
    const float* rowsq = (const float*)(p.ws + WS_ROWSQ + MiB);
    const int t_ = TIDX;
    for (int i0 = blockIdx.x * 512; i0 < MTOK * 256; i0 += gridDim.x * 512) {
        const int i = i0 + t_; const int row = i >> 8, c = (i & 255) * 4; const float rs = row_rs(rowsq, row);
        const f32x4 g = *(const f32x4*)(p.final_norm + c); f32x4* xp = (f32x4*)(p.out + (size_t)row * DM + c);
        *xp = *xp * rs * g;
    }
}


__device__ __forceinline__ void grid_bar(unsigned* cnt, unsigned target, const int wv_) {
    asm volatile("s_waitcnt vmcnt(0) lgkmcnt(0)" ::: "memory");
    __syncthreads();
    if (wv_ == 0) {
        __builtin_amdgcn_fence(__ATOMIC_RELEASE, "agent");
        asm volatile("s_waitcnt vmcnt(0)" ::: "memory");
        if (lane_fresh() == 0) __hip_atomic_fetch_add(cnt, 1u, __ATOMIC_RELAXED, __HIP_MEMORY_SCOPE_AGENT);
        while ((unsigned)__builtin_amdgcn_readfirstlane((int)__hip_atomic_load(cnt, __ATOMIC_RELAXED, __HIP_MEMORY_SCOPE_AGENT)) < target) __builtin_amdgcn_s_sleep(1);
        __builtin_amdgcn_fence(__ATOMIC_ACQUIRE, "agent");
        asm volatile("s_waitcnt vmcnt(0)" ::: "memory");
    }
    __syncthreads();
}

#ifndef TIMING_DUP
#define TIMING_DUP 0
#endif
#ifndef STOP_AT
#define STOP_AT 0
#endif
#define STOP_L 0
__device__ void dump_bf16(const Params& p, const bf16_t* src, int ld, int col0, const int wv_) {
    const int t_ = TIDX;
    for (int i0 = blockIdx.x * 512; i0 < MTOK * 128; i0 += gridDim.x * 512) {
        const int i = i0 + t_; const int row = i >> 7, c = (i & 127) * 8;
        const u32x4 r = *(const u32x4*)(src + (size_t)row * ld + col0 + (c % ld));
        float* o = p.out + (size_t)row * DM + c;
        *(f32x4*)o = (f32x4){bflo(r.x), bfhi(r.x), bflo(r.y), bfhi(r.y)}; *(f32x4*)(o + 4) = (f32x4){bflo(r.z), bfhi(r.z), bflo(r.w), bfhi(r.w)};
    }
}
__global__ void __launch_bounds__(512, 2) mega(Params kp) {
    extern __shared__ __attribute__((aligned(16))) unsigned char smem[];
    LAS unsigned char* lds = (LAS unsigned char*)smem;
    cg::grid_group grid = cg::this_grid();
    const int G = gridDim.x, c = blockIdx.x;
    const int wv_ = __builtin_amdgcn_readfirstlane((int)threadIdx.x >> 6);
    if (threadIdx.x == 0) stp(lds, kp);
    if (c == 0 && threadIdx.x == 0) __hip_atomic_store((unsigned*)(kp.ws + WS_BAR), 0u, __ATOMIC_RELAXED, __HIP_MEMORY_SCOPE_AGENT);
    __syncthreads();
    grid.sync();
    int nbar = 0;
#define WSP(p_, off) ((p_).ws + (off))
    {
        const Params p = ldp(lds);
        rownorm(p, p.x, (float*)WSP(p, WS_ROWSQ + MiB), wv_);
        rot_table(p, wv_);
        prep_layer_main(p, 0, (LAS float*)lds, wv_);
        prep_layer_down(p, 0, (LAS float*)lds, wv_);
    }
    { const Params p = ldp(lds); grid_bar((unsigned*)WSP(p, WS_BAR), (unsigned)(++nbar) * (unsigned)G, wv_); if (TIMING_DUP == 6) grid_bar((unsigned*)WSP(p, WS_BAR), (unsigned)(++nbar) * (unsigned)G, wv_); }

    for (int l = 0; l < DEPTH; ++l) {
        {
            const Params p = ldp(lds);
            StaticOrder S; S.init(WSP(p, WS_XB), (bf16_t*)WSP(p, WS_W) + W_IN, MTOK, NU, 1024, G, c);
            EpiScale<0> E; E.O = (bf16_t*)WSP(p, WS_U); E.ldc = NU; E.rowsq = (const float*)WSP(p, WS_ROWSQ + MiB);
            for (int rep = 0; rep < ((TIMING_DUP == 5) ? 2 + __builtin_amdgcn_readfirstlane(opaque0()) : 1); ++rep)
            gemm_phase(lds, 1024, S, E, wv_);
        }
        { const Params p = ldp(lds); ab_tail(p, wv_); u0_tail(p, l, (LAS float*)lds, wv_); }
        { const Params p = ldp(lds); grid_bar((unsigned*)WSP(p, WS_BAR), (unsigned)(++nbar) * (unsigned)G, wv_); if (TIMING_DUP == 6) grid_bar((unsigned*)WSP(p, WS_BAR), (unsigned)(++nbar) * (unsigned)G, wv_); }
        if (STOP_AT == 1 && l == STOP_L) { const Params p = ldp(lds); dump_bf16(p, (const bf16_t*)WSP(p, WS_U), NU, 0, wv_); return; }
        {
            const int Gh = G >> 1;
            if (c < Gh) { const Params p = ldp(lds); for (int it = c; it < 128; it += Gh) deltanet_item(p, l, it, lds, wv_); }
            else {
                { const Params p = ldp(lds); for (int it = c - Gh; it < 256; it += G - Gh) retention_item(p, it, lds, wv_); }
                { const Params p = ldp(lds); for (int it = c - Gh; it < 256; it += G - Gh) lru_item(p, l, it, lds, wv_); }
                if (l > 0) { const Params p = ldp(lds); prep_layer_down(p, l, (LAS float*)lds, wv_, G - Gh, c - Gh); }
                if (l + 1 < DEPTH) { const Params p = ldp(lds); prep_layer_main(p, l + 1, (LAS float*)lds, wv_, 1, G - Gh, c - Gh); }
            }
        }
        { const Params p = ldp(lds); grid_bar((unsigned*)WSP(p, WS_BAR), (unsigned)(++nbar) * (unsigned)G, wv_); if (TIMING_DUP == 6) grid_bar((unsigned*)WSP(p, WS_BAR), (unsigned)(++nbar) * (unsigned)G, wv_); }
        if (STOP_AT == 2 && l == STOP_L) { const Params p = ldp(lds); dump_bf16(p, (const bf16_t*)WSP(p, WS_Y) + (size_t)2 * MTOK * 512, 512, 0, wv_); return; }
        if (STOP_AT == 12 && l == STOP_L) { const Params p = ldp(lds); dump_bf16(p, (const bf16_t*)WSP(p, WS_Y), 512, 0, wv_); return; }
        if (STOP_AT == 13 && l == STOP_L) { const Params p = ldp(lds); dump_bf16(p, (const bf16_t*)WSP(p, WS_Y) + (size_t)MTOK * 512, 512, 0, wv_); return; }
        {
            const Params p = ldp(lds);
            finalize_y(p, wv_);
        }
        { const Params p = ldp(lds); grid_bar((unsigned*)WSP(p, WS_BAR), (unsigned)(++nbar) * (unsigned)G, wv_); if (TIMING_DUP == 6) grid_bar((unsigned*)WSP(p, WS_BAR), (unsigned)(++nbar) * (unsigned)G, wv_); }
        if (STOP_AT == 3 && l == STOP_L) { const Params p = ldp(lds); dump_bf16(p, (const bf16_t*)WSP(p, WS_Y), 512, 0, wv_); return; }
        {
            const Params p = ldp(lds);
            StaticOrder S; S.init(WSP(p, WS_XB), (bf16_t*)WSP(p, WS_W) + W_G, MTOK, NG, 1024, G, c);
            EpiScale<1> E; E.O = (bf16_t*)WSP(p, WS_U); E.ldc = NG; E.rowsq = (const float*)WSP(p, WS_ROWSQ + MiB);
            for (int rep = 0; rep < ((TIMING_DUP == 5) ? 2 + __builtin_amdgcn_readfirstlane(opaque0()) : 1); ++rep)
            gemm_phase(lds, 1024, S, E, wv_);
        }
        { const Params p = ldp(lds); grid_bar((unsigned*)WSP(p, WS_BAR), (unsigned)(++nbar) * (unsigned)G, wv_); if (TIMING_DUP == 6) grid_bar((unsigned*)WSP(p, WS_BAR), (unsigned)(++nbar) * (unsigned)G, wv_); }
        if (STOP_AT == 4 && l == STOP_L) { const Params p = ldp(lds); dump_bf16(p, (const bf16_t*)WSP(p, WS_U), NG, 0, wv_); return; }
        {
            const Params p = ldp(lds);
            BranchOrder S; S.Y = (const char*)WSP(p, WS_Y); S.Wb = (const char*)((bf16_t*)WSP(p, WS_W) + W_B); S.G = G; S.c = c;
            EpiMerge E; E.gates = (const bf16_t*)WSP(p, WS_U); E.scratch = (float*)WSP(p, WS_XB) + (size_t)c * 65536; E.merged = (bf16_t*)WSP(p, WS_U + 192 * MiB);
            gemm_phase(lds, 512, S, E, wv_);
        }
        { const Params p = ldp(lds); grid_bar((unsigned*)WSP(p, WS_BAR), (unsigned)(++nbar) * (unsigned)G, wv_); if (TIMING_DUP == 6) grid_bar((unsigned*)WSP(p, WS_BAR), (unsigned)(++nbar) * (unsigned)G, wv_); }
        if (STOP_AT == 5 && l == STOP_L) { const Params p = ldp(lds); dump_bf16(p, (const bf16_t*)WSP(p, WS_U + 192 * MiB), DM, 0, wv_); return; }
        {
            const Params p = ldp(lds);
            StaticOrder S; S.init(WSP(p, WS_U + 192 * MiB), (bf16_t*)WSP(p, WS_W) + W_O, MTOK, DM, 1024, G, c);
            EpiResid E; E.xin = (l == 0) ? p.x : p.out; E.xout = p.out; E.xb = (bf16_t*)WSP(p, WS_XB); E.rowsq = (float*)WSP(p, WS_ROWSQ); E.ex = (LAS float*)(lds + 131072);
            gemm_phase(lds, 1024, S, E, wv_);
        }
        { const Params p = ldp(lds); grid_bar((unsigned*)WSP(p, WS_BAR), (unsigned)(++nbar) * (unsigned)G, wv_); if (TIMING_DUP == 6) grid_bar((unsigned*)WSP(p, WS_BAR), (unsigned)(++nbar) * (unsigned)G, wv_); }
        if (STOP_AT == 6 && l == STOP_L) return;
        {
            const Params p = ldp(lds);
            StaticOrder S; S.init(WSP(p, WS_XB), (bf16_t*)WSP(p, WS_W) + W_UP, MTOK, NUP, 1024, G, c);
            EpiFfn E; E.act = (bf16_t*)WSP(p, WS_U); E.rowsq = (const float*)WSP(p, WS_ROWSQ); E.cw = p.ffn_conv_w + (size_t)l * 3 * NUP; E.cb = p.ffn_conv_b + (size_t)l * NUP; E.side = (float*)WSP(p, WS_Y);
            for (int rep = 0; rep < ((TIMING_DUP == 5) ? 2 + __builtin_amdgcn_readfirstlane(opaque0()) : 1); ++rep)
            gemm_phase(lds, 1024, S, E, wv_);
        }
        { const Params p = ldp(lds); grid_bar((unsigned*)WSP(p, WS_BAR), (unsigned)(++nbar) * (unsigned)G, wv_); if (TIMING_DUP == 6) grid_bar((unsigned*)WSP(p, WS_BAR), (unsigned)(++nbar) * (unsigned)G, wv_); }
        {
            const Params p = ldp(lds);
            ffn_fixup(p, l, wv_);
        }
        if (l + 1 < DEPTH) { const Params p = ldp(lds); prep_layer_main(p, l + 1, (LAS float*)lds, wv_, 2); }
        { const Params p = ldp(lds); grid_bar((unsigned*)WSP(p, WS_BAR), (unsigned)(++nbar) * (unsigned)G, wv_); if (TIMING_DUP == 6) grid_bar((unsigned*)WSP(p, WS_BAR), (unsigned)(++nbar) * (unsigned)G, wv_); }
        if (STOP_AT == 7 && l == STOP_L) { const Params p = ldp(lds); dump_bf16(p, (const bf16_t*)WSP(p, WS_U), DFF, 0, wv_); return; }
        {
            const Params p = ldp(lds);
            StaticOrder S; S.init(WSP(p, WS_U), (bf16_t*)WSP(p, WS_W) + W_DN, MTOK, DM, DFF, G, c);
            EpiResid E; E.xin = p.out; E.xout = p.out; E.xb = (bf16_t*)WSP(p, WS_XB); E.rowsq = (float*)WSP(p, WS_ROWSQ + MiB); E.ex = (LAS float*)(lds + 131072);
            gemm_phase(lds, DFF, S, E, wv_);
        }
        { const Params p = ldp(lds); grid_bar((unsigned*)WSP(p, WS_BAR), (unsigned)(++nbar) * (unsigned)G, wv_); if (TIMING_DUP == 6) grid_bar((unsigned*)WSP(p, WS_BAR), (unsigned)(++nbar) * (unsigned)G, wv_); }
        if (STOP_AT == 8 && l == STOP_L) return;
        if (STOP_AT == 10 && l == STOP_L) { const Params p = ldp(lds); dump_bf16(p, (const bf16_t*)WSP(p, WS_XB), DM, 0, wv_); return; }
        if (STOP_AT == 11 && l == STOP_L) { const Params p = ldp(lds); dump_bf16(p, (const bf16_t*)WSP(p, WS_W) + W_IN, 1024, 0, wv_); return; }
        if (STOP_AT == 9 && l == STOP_L) { const Params p = ldp(lds); const float* rq = (const float*)WSP(p, WS_ROWSQ + MiB); const int t_ = TIDX; for (int i0 = c * 512; i0 < MTOK * 256; i0 += G * 512) { const int i = i0 + t_; const float v = rq[i >> 8]; *(f32x4*)(p.out + (size_t)i * 4) = (f32x4){v, v, v, v}; } return; }
    }
    { const Params p = ldp(lds); final_norm(p, wv_); }
}

constexpr int LDS_BYTES = 163328 + 256;
extern "C" void kernel_launch(void* const* d_in, const int* in_sizes, int n_in, void* d_out, int out_size, void* d_ws, size_t ws_size, hipStream_t stream) {
    static int grid = 0;
    if (grid == 0) {
        int dev = 0, cus = 0, per_cu = 0;
        hipGetDevice(&dev);
        hipDeviceGetAttribute(&cus, hipDeviceAttributeMultiprocessorCount, dev);
        if (hipFuncSetAttribute((const void*)mega, hipFuncAttributeMaxDynamicSharedMemorySize, LDS_BYTES) != hipSuccess) fprintf(stderr, "kernel_launch: hipFuncSetAttribute failed\n");
        hipOccupancyMaxActiveBlocksPerMultiprocessor(&per_cu, (const void*)mega, 512, LDS_BYTES);
        (void)hipGetLastError();
        if (per_cu < 1) per_cu = 1;
        grid = cus * 1;
        if (grid > 256) grid = 256;
        if (ws_size < 496 * MiB) fprintf(stderr, "kernel_launch: workspace too small: %zu\n", ws_size);
    }
    Params p{};
    p.x = (const float*)d_in[0]; p.pos = (const int*)d_in[1]; p.attn_norm = (const float*)d_in[2]; p.w_in = (const float*)d_in[3]; p.dn_conv_w = (const float*)d_in[4];
    p.dn_a_log = (const float*)d_in[5]; p.dn_dt_bias = (const float*)d_in[6]; p.dn_norm_w = (const float*)d_in[7]; p.lru_conv_w = (const float*)d_in[8]; p.lru_conv_b = (const float*)d_in[9];
    p.lru_wa = (const float*)d_in[10]; p.lru_ba = (const float*)d_in[11]; p.lru_wx = (const float*)d_in[12]; p.lru_bx = (const float*)d_in[13]; p.lru_lambda = (const float*)d_in[14];
    p.w_branch = (const float*)d_in[15]; p.w_out = (const float*)d_in[16]; p.ffn_norm = (const float*)d_in[17]; p.w_up = (const float*)d_in[18]; p.ffn_conv_w = (const float*)d_in[19];
    p.ffn_conv_b = (const float*)d_in[20]; p.w_down = (const float*)d_in[21]; p.final_norm = (const float*)d_in[22];
    p.out = (float*)d_out; p.ws = (unsigned char*)d_ws;
    (void)hipMemsetAsync((unsigned char*)d_ws + WS_BAR, 0, 256, stream);
    void* args[] = {&p};
    hipError_t e = hipLaunchCooperativeKernel((const void*)mega, dim3(grid), dim3(512), args, LDS_BYTES, stream);
    if (e != hipSuccess) fprintf(stderr, "cooperative launch failed: %s (grid %d)\n", hipGetErrorString(e), grid);
}
```

```cpp
#include <hip/hip_runtime.h>
#include <hip/hip_cooperative_groups.h>
#include <cstdio>
#include <cstdint>
namespace cg = cooperative_groups;

#define LAS __attribute__((address_space(3)))
typedef unsigned short bf16_t;
typedef short bf16x8 __attribute__((ext_vector_type(8)));
typedef float f32x4 __attribute__((ext_vector_type(4)));
typedef float f32x2 __attribute__((ext_vector_type(2)));
typedef unsigned u32x4 __attribute__((ext_vector_type(4)));
typedef unsigned u32x2 __attribute__((ext_vector_type(2)));

constexpr int MTOK = 32768, DM = 1024, SEQ = 2048, NU = 4608, NG = 3072, NIN = 7688, DFF = 2816, NUP = 5632, DEPTH = 4;
constexpr float EPS = 1e-6f;
constexpr size_t MiB = 1u << 20;
constexpr size_t WS_ROWSQ = 0;
constexpr size_t WS_AB = 2 * MiB;
constexpr size_t WS_STA = 3 * MiB;
constexpr size_t WS_STB = 5 * MiB;
constexpr size_t WS_WAB = 9 * MiB;
constexpr size_t WS_BAR = 9 * MiB + 65536;
constexpr size_t WS_U0 = 9 * MiB + 131072;
constexpr size_t WS_XB = 10 * MiB;
constexpr size_t WS_W = 74 * MiB;
constexpr size_t WS_U = 112 * MiB;
constexpr size_t WS_ROT = 496 * MiB;
constexpr size_t WS_Y = 400 * MiB;
constexpr size_t W_IN = 0, W_G = W_IN + (size_t)NU * 1024, W_B = W_G + (size_t)NG * 1024, W_O = W_B + (size_t)3 * 1024 * 512,
                 W_UP = W_O + (size_t)1024 * 1024, W_DN = W_UP + (size_t)NUP * 1024;

struct Params {
    const float* x; const int* pos; const float* attn_norm; const float* w_in; const float* dn_conv_w; const float* dn_a_log; const float* dn_dt_bias; const float* dn_norm_w;
    const float* lru_conv_w; const float* lru_conv_b; const float* lru_wa; const float* lru_ba; const float* lru_wx; const float* lru_bx; const float* lru_lambda;
    const float* w_branch; const float* w_out; const float* ffn_norm; const float* w_up; const float* ffn_conv_w; const float* ffn_conv_b; const float* w_down; const float* final_norm;
    float* out; unsigned char* ws;
};


__device__ __forceinline__ int opaque0() { int z; asm volatile("v_mov_b32 %0, 0" : "=v"(z)); return z; }
constexpr int LDS_PARAMS = 163328;
__device__ __forceinline__ const void* ldptr(LAS const unsigned* lp, int i) {
    const unsigned lo = __builtin_amdgcn_readfirstlane(lp[2 * i]), hi = __builtin_amdgcn_readfirstlane(lp[2 * i + 1]);
    typedef const __attribute__((address_space(1))) unsigned char* gptr_t;
    return (const void*)(gptr_t)(((unsigned long long)hi << 32) | lo);
}
__device__ __forceinline__ Params ldp(LAS const unsigned char* ldsbase) {
    LAS const unsigned* lp = (LAS const unsigned*)(ldsbase + LDS_PARAMS + opaque0());
    Params p;
    p.x = (const float*)ldptr(lp, 0); p.pos = (const int*)ldptr(lp, 1); p.attn_norm = (const float*)ldptr(lp, 2); p.w_in = (const float*)ldptr(lp, 3); p.dn_conv_w = (const float*)ldptr(lp, 4);
    p.dn_a_log = (const float*)ldptr(lp, 5); p.dn_dt_bias = (const float*)ldptr(lp, 6); p.dn_norm_w = (const float*)ldptr(lp, 7); p.lru_conv_w = (const float*)ldptr(lp, 8); p.lru_conv_b = (const float*)ldptr(lp, 9);
    p.lru_wa = (const float*)ldptr(lp, 10); p.lru_ba = (const float*)ldptr(lp, 11); p.lru_wx = (const float*)ldptr(lp, 12); p.lru_bx = (const float*)ldptr(lp, 13); p.lru_lambda = (const float*)ldptr(lp, 14);
    p.w_branch = (const float*)ldptr(lp, 15); p.w_out = (const float*)ldptr(lp, 16); p.ffn_norm = (const float*)ldptr(lp, 17); p.w_up = (const float*)ldptr(lp, 18); p.ffn_conv_w = (const float*)ldptr(lp, 19);
    p.ffn_conv_b = (const float*)ldptr(lp, 20); p.w_down = (const float*)ldptr(lp, 21); p.final_norm = (const float*)ldptr(lp, 22); p.out = (float*)ldptr(lp, 23); p.ws = (unsigned char*)ldptr(lp, 24);
    return p;
}
__device__ __forceinline__ void stp(LAS unsigned char* ldsbase, const Params& p) {
    LAS unsigned long long* lp = (LAS unsigned long long*)(ldsbase + LDS_PARAMS);
    lp[0] = (unsigned long long)p.x; lp[1] = (unsigned long long)p.pos; lp[2] = (unsigned long long)p.attn_norm; lp[3] = (unsigned long long)p.w_in; lp[4] = (unsigned long long)p.dn_conv_w;
    lp[5] = (unsigned long long)p.dn_a_log; lp[6] = (unsigned long long)p.dn_dt_bias; lp[7] = (unsigned long long)p.dn_norm_w; lp[8] = (unsigned long long)p.lru_conv_w; lp[9] = (unsigned long long)p.lru_conv_b;
    lp[10] = (unsigned long long)p.lru_wa; lp[11] = (unsigned long long)p.lru_ba; lp[12] = (unsigned long long)p.lru_wx; lp[13] = (unsigned long long)p.lru_bx; lp[14] = (unsigned long long)p.lru_lambda;
    lp[15] = (unsigned long long)p.w_branch; lp[16] = (unsigned long long)p.w_out; lp[17] = (unsigned long long)p.ffn_norm; lp[18] = (unsigned long long)p.w_up; lp[19] = (unsigned long long)p.ffn_conv_w;
    lp[20] = (unsigned long long)p.ffn_conv_b; lp[21] = (unsigned long long)p.w_down; lp[22] = (unsigned long long)p.final_norm; lp[23] = (unsigned long long)p.out; lp[24] = (unsigned long long)p.ws;
}
__device__ __forceinline__ int lane_fresh() { int l; asm volatile("v_mbcnt_lo_u32_b32 %0, -1, 0\n\tv_mbcnt_hi_u32_b32 %0, -1, %0" : "=&v"(l)); return l; }
#define TIDX ((wv_ << 6) + lane_fresh())
__device__ __forceinline__ float opaque0_after(float dep) { float z; asm volatile("v_mov_b32 %0, 0" : "=v"(z) : "v"(dep)); return z; }
__device__ __forceinline__ float bflo(unsigned u) { return __uint_as_float(u << 16); }
__device__ __forceinline__ float bfhi(unsigned u) { return __uint_as_float(u & 0xffff0000u); }
typedef __bf16 bf16x2_t __attribute__((ext_vector_type(2)));
__device__ __forceinline__ unsigned cvt_pk_bf16(float lo, float hi) { const f32x2 v = {lo, hi}; return __builtin_bit_cast(unsigned, __builtin_convertvector(v, bf16x2_t)); }
__device__ __forceinline__ float sigmoidf_(float x) { return __builtin_amdgcn_rcpf(1.f + __expf(-x)); }
__device__ __forceinline__ float siluf_(float x) { return x * __builtin_amdgcn_rcpf(1.f + __expf(-x)); }
__device__ __forceinline__ float softplusf_(float x) { return fmaxf(x, 0.f) + log1pf(__expf(-fabsf(x))); }
__device__ __forceinline__ float gelu_tanh(float x) { const float u = 0.7978845608028654f * (x + 0.044715f * x * x * x); return x * __builtin_amdgcn_rcpf(1.f + __expf(-2.f * u)); }
template <int CTRL> __device__ __forceinline__ float dppmov(float v) { return __int_as_float(__builtin_amdgcn_update_dpp(0, __float_as_int(v), CTRL, 0xf, 0xf, true)); }
__device__ __forceinline__ float allreduce16(float x) {
    x += dppmov<0xB1>(x); x += dppmov<0x4E>(x); x += dppmov<0x141>(x); x += dppmov<0x140>(x); return x;
}
__device__ __forceinline__ float row_rs(const float* rowsq, int row) { const f32x4 q = *(const f32x4*)(rowsq + (size_t)row * 4); return rsqrtf(((q[0] + q[1]) + (q[2] + q[3])) * (1.0f / 1024.0f) + EPS); }

constexpr int BM = 256, BK = 64, HALF = 128, HTB = HALF * BK * 2, STAGE_BYTES = 8 * HTB, NXCD = 8, WGM = 8;
__device__ __forceinline__ int lds_byte(int r, int c) { const int st = (r >> 4) * 2 + (c >> 5), rr = r & 15, cc = c & 31, ob = rr * 64 + cc * 2; return st * 1024 + (ob ^ (((ob >> 9) & 1) << 5)); }
__device__ __forceinline__ void stage_rc(int b, int& R, int& C) { const int st = b / 1024, sb = b % 1024, swz = sb ^ (((sb >> 9) & 1) << 5); R = (st >> 1) * 16 + swz / 64; C = (st & 1) * 32 + (swz % 64) / 2; }
__device__ __forceinline__ int perm32(int rho) { const int n = rho >> 4, i = rho & 15; return 8 * (i >> 2) + 4 * n + (i & 3); }
struct Unit { int pm, pn, aux; };

struct StaticOrder {
    const char* A; const char* B; int nM, nN, nwg, G, c; size_t tstep;
    __device__ void init(const void* A_, const void* B_, int M, int N, int K, int G_, int c_) { A = (const char*)A_; B = (const char*)B_; nM = M / BM; nN = N / BM; nwg = nM * nN; G = G_; c = c_; tstep = (size_t)BM * K * 2; }
    __device__ __forceinline__ bool next(int i, Unit& u) const {
        const long L = (long)i * G + c; if (L >= nwg) return false;
        int wgid = (int)L; { const int q = nwg / NXCD, r = nwg % NXCD, xcd = wgid % NXCD, off = wgid / NXCD; wgid = (xcd < r ? xcd * (q + 1) : r * (q + 1) + (xcd - r) * q) + off; }
        const int nig = WGM * nN, gid = wgid / nig, fm = gid * WGM, gsz = (nM - fm) < WGM ? (nM - fm) : WGM;
        u.pm = fm + ((wgid % nig) % gsz); u.pn = (wgid % nig) / gsz; u.aux = 0; return true;
    }
    __device__ __forceinline__ void ptrs(const Unit& u, const char*& a, const char*& b) const { a = A + (size_t)u.pm * tstep; b = B + (size_t)u.pn * tstep; }
};
struct BranchOrder {
    const char* Y; const char* Wb; int G, c;
    __device__ __forceinline__ bool next(int i, Unit& u) const {
        const int tile = c + G * (i / 3); if (tile >= 512) return false;
        u.pm = tile >> 2; u.pn = tile & 3; u.aux = i % 3; return true;
    }
    __device__ __forceinline__ void ptrs(const Unit& u, const char*& a, const char*& b) const {
        a = Y + (size_t)u.aux * ((size_t)MTOK * 512 * 2) + (size_t)u.pm * (256 * 512 * 2);
        b = Wb + (size_t)u.aux * ((size_t)1024 * 512 * 2) + (size_t)u.pn * (256 * 512 * 2);
    }
};

template <class Epi, class Sched>
__device__ __forceinline__ void gemm_phase(LAS unsigned char* lds, const int K, const Sched& S, const Epi& E, const int wv_) {
    const int tid = TIDX, wid = __builtin_amdgcn_readfirstlane(tid >> 6), lane = tid & 63, wr = wid >> 2, wc = wid & 3, fr = lane & 15, fq = lane >> 4;
    const int nt = K / BK;
    unsigned voffA[2], voffB[2];
#pragma unroll
    for (int i = 0; i < 2; ++i) { int R, C; stage_rc(tid * 16 + i * 8192, R, C); const int Rb = Epi::PERM ? ((R & ~31) + perm32(R & 31)) : R;
        voffA[i] = (unsigned)(R * K + C) * 2u; voffB[i] = (unsigned)(Rb * K + C) * 2u; }
    const size_t kstep = (size_t)(BK * 2);
    const size_t hstep = (size_t)HALF * K * 2;
    const unsigned ldsw = (unsigned)wid * 1024u;
    const int aoff = lds_byte(wr * 64 + fr, fq * 8), boff = lds_byte(wc * 32 + fr, fq * 8);
#define PG8_SA(b, h) (((b) * 2 + (h)) * HTB)
#define PG8_SB(b, h) ((4 + (b) * 2 + (h)) * HTB)
#define PG8_STAGE(bufoff, gbase, voff) do { _Pragma("unroll") for (int _i = 0; _i < 2; ++_i) \
        __builtin_amdgcn_global_load_lds((const unsigned*)((const char*)(gbase) + (voff)[_i]), (LAS unsigned*)(lds + (bufoff) + ldsw + _i * 8192), 16, 0, 0); } while (0)
#define PG8_LDA(dst, b, h) do { _Pragma("unroll") for (int m = 0; m < 4; ++m) _Pragma("unroll") for (int k = 0; k < 2; ++k) dst[m][k] = *(const LAS bf16x8*)(lds + PG8_SA(b, h) + aoff + m * 2048 + k * 1024); } while (0)
#define PG8_LDB(dst, b, h) do { _Pragma("unroll") for (int n = 0; n < 2; ++n) _Pragma("unroll") for (int k = 0; k < 2; ++k) dst[n][k] = *(const LAS bf16x8*)(lds + PG8_SB(b, h) + boff + n * 2048 + k * 1024); } while (0)
#define PG8_MMA(ai, bj, At, Bt) do { __builtin_amdgcn_s_setprio(1); _Pragma("unroll") for (int m = 0; m < 4; ++m) _Pragma("unroll") for (int n = 0; n < 2; ++n) _Pragma("unroll") for (int k = 0; k < 2; ++k) \
        acc[ai][bj][m][n] = __builtin_amdgcn_mfma_f32_16x16x32_bf16(Bt[n][k], At[m][k], acc[ai][bj][m][n], 0, 0, 0); __builtin_amdgcn_s_setprio(0); } while (0)
#define PG8_WAIT_V(n) asm volatile("s_waitcnt vmcnt(" #n ")" ::: "memory")
#define PG8_WAIT_L(n) asm volatile("s_waitcnt lgkmcnt(" #n ")" ::: "memory")
#define PG8_BAR __builtin_amdgcn_s_barrier()
#define PG8_SCHED __builtin_amdgcn_sched_barrier(0)
    Unit cur, nxt; int ui = 0;
    if (!S.next(0, cur)) return;
    f32x4 acc[2][2][4][2];
#pragma unroll
    for (int a = 0; a < 2; ++a)
#pragma unroll
        for (int b = 0; b < 2; ++b)
#pragma unroll
            for (int m = 0; m < 4; ++m)
#pragma unroll
                for (int n = 0; n < 2; ++n) acc[a][b][m][n] = (f32x4){0.f, 0.f, 0.f, 0.f};
    bf16x8 At[4][2], B0[2][2], B1[2][2];
    const char* cA; const char* cB; S.ptrs(cur, cA, cB);
    PG8_STAGE(PG8_SB(0, 0), cB, voffB); PG8_STAGE(PG8_SB(0, 1), cB + hstep, voffB); PG8_STAGE(PG8_SA(0, 0), cA, voffA); PG8_STAGE(PG8_SA(0, 1), cA + hstep, voffA);
    if (wr == 1) PG8_BAR;
    PG8_WAIT_V(2); PG8_BAR;
    PG8_STAGE(PG8_SB(1, 0), cB + kstep, voffB); PG8_STAGE(PG8_SA(1, 0), cA + kstep, voffA); PG8_STAGE(PG8_SB(1, 1), cB + hstep + kstep, voffB);
    PG8_WAIT_V(6); PG8_BAR;
    for (;;) {
        const bool has_next = S.next(ui + 1, nxt);
        const char* nA = cA; const char* nB = cB; if (has_next) S.ptrs(nxt, nA, nB);
        for (int t = 0; t < nt; t += 2) {
            const bool last = (t == nt - 2);
            const char* a1 = cA + (size_t)(t + 1) * kstep;
            const char* a2 = last ? nA : cA + (size_t)(t + 2) * kstep; const char* b2 = last ? nB : cB + (size_t)(t + 2) * kstep;
            const char* a3 = a2 + kstep; const char* b3 = b2 + kstep;
            PG8_LDB(B0, 0, 0); PG8_LDB(B1, 0, 1); PG8_SCHED; PG8_LDA(At, 0, 0); PG8_STAGE(PG8_SA(1, 1), a1 + hstep, voffA);
            PG8_WAIT_V(8); PG8_WAIT_L(0); PG8_BAR; PG8_MMA(0, 0, At, B0); PG8_MMA(0, 1, At, B1); PG8_BAR; PG8_SCHED;
            PG8_LDA(At, 0, 1); PG8_STAGE(PG8_SB(0, 0), b2, voffB); PG8_STAGE(PG8_SB(0, 1), b2 + hstep, voffB); PG8_STAGE(PG8_SA(0, 0), a2, voffA);
            PG8_WAIT_V(8); PG8_WAIT_L(0); PG8_BAR; PG8_MMA(1, 0, At, B0); PG8_MMA(1, 1, At, B1); PG8_BAR; PG8_SCHED;
            PG8_LDB(B0, 1, 0); PG8_LDB(B1, 1, 1); PG8_SCHED; PG8_LDA(At, 1, 0); PG8_STAGE(PG8_SA(0, 1), a2 + hstep, voffA);
            PG8_WAIT_V(8); PG8_WAIT_L(0); PG8_BAR; PG8_MMA(0, 0, At, B0); PG8_MMA(0, 1, At, B1); PG8_BAR; PG8_SCHED;
            PG8_LDA(At, 1, 1); PG8_STAGE(PG8_SB(1, 0), b3, voffB); PG8_STAGE(PG8_SB(1, 1), b3 + hstep, voffB); PG8_STAGE(PG8_SA(1, 0), a3, voffA);
            PG8_WAIT_V(8); PG8_WAIT_L(0); PG8_BAR; PG8_MMA(1, 0, At, B0); PG8_MMA(1, 1, At, B1); PG8_BAR; PG8_SCHED;
        }
        if (wr == 0) PG8_BAR;
        E(acc, cur, wv_);
        if (!has_next) break;
        if (!(Epi::KEEP_ACC && cur.aux < 2)) {
#pragma unroll
        for (int a = 0; a < 2; ++a)
#pragma unroll
            for (int b = 0; b < 2; ++b)
#pragma unroll
                for (int m = 0; m < 4; ++m)
#pragma unroll
                    for (int n = 0; n < 2; ++n) acc[a][b][m][n] = (f32x4){0.f, 0.f, 0.f, 0.f};
        }
        cur = nxt; cA = nA; cB = nB; ++ui;
        if (wr == 1) PG8_BAR;
    }
    PG8_WAIT_V(0);
    PG8_BAR;
#undef PG8_SA
#undef PG8_SB
#undef PG8_STAGE
#undef PG8_LDA
#undef PG8_LDB
#undef PG8_MMA
#undef PG8_WAIT_V
#undef PG8_WAIT_L
#undef PG8_BAR
#undef PG8_SCHED
}

#define EPI_FENCE __builtin_amdgcn_sched_barrier(0)
template <int ACT> struct EpiScale {
    static constexpr bool PERM = true, KEEP_ACC = false;
    bf16_t* O; int ldc; const float* rowsq;
    __device__ __forceinline__ void operator()(f32x4 (&acc)[2][2][4][2], const Unit& u, const int wv_) const {
        const int lane_ = TIDX & 63, wr = wv_ >> 2, wc = wv_ & 3, fr = lane_ & 15, fq = lane_ >> 4;
        const int row0 = u.pm * BM + wr * 64 + fr + opaque0(), col0 = u.pn * BM + wc * 32 + 8 * fq;
#pragma unroll
        for (int ai = 0; ai < 2; ++ai) {
            float rs[4];
#pragma unroll
            for (int m = 0; m < 4; ++m) rs[m] = row_rs(rowsq, row0 + ai * HALF + m * 16);
            EPI_FENCE;
#pragma unroll
            for (int m = 0; m < 4; ++m) {
                const int row = row0 + ai * HALF + m * 16;
                bf16_t* rowp = O + (size_t)row * ldc + col0;
#pragma unroll
                for (int bj = 0; bj < 2; ++bj) {
                    f32x4 v0 = acc[ai][bj][m][0] * rs[m], v1 = acc[ai][bj][m][1] * rs[m];
                    if (ACT == 1) {
#pragma unroll
                        for (int j = 0; j < 4; ++j) { v0[j] = sigmoidf_(v0[j]); v1[j] = sigmoidf_(v1[j]); } }
                    u32x4 w; w.x = cvt_pk_bf16(v0[0], v0[1]); w.y = cvt_pk_bf16(v0[2], v0[3]); w.z = cvt_pk_bf16(v1[0], v1[1]); w.w = cvt_pk_bf16(v1[2], v1[3]);
                    *(u32x4*)(rowp + bj * HALF) = w; }
            }
            EPI_FENCE;
        }
    }
};
struct EpiMerge {
    static constexpr bool PERM = true, KEEP_ACC = true;
    const bf16_t* gates; float* scratch; bf16_t* merged;
    __device__ __forceinline__ void operator()(f32x4 (&acc)[2][2][4][2], const Unit& u, const int wv_) const {
        const int tid_ = TIDX, lane_ = tid_ & 63, wr = wv_ >> 2, wc = wv_ & 3, fr = lane_ & 15, fq = lane_ >> 4;
        const int n = u.aux; const int row0 = u.pm * BM + wr * 64 + fr + opaque0(), col0 = u.pn * BM + wc * 32 + 8 * fq;
#pragma unroll
        for (int ai = 0; ai < 2; ++ai)
#pragma unroll
            for (int m = 0; m < 4; ++m) {
                const int row = row0 + ai * HALF + m * 16;
#pragma unroll
                for (int bj = 0; bj < 2; ++bj) {
                    const bf16_t* gp = gates + (size_t)row * NG + n * 1024 + col0 + bj * HALF;
                    const u32x4 g = *(const u32x4*)gp;
                    float f[8] = {bflo(g.x), bfhi(g.x), bflo(g.y), bfhi(g.y), bflo(g.z), bfhi(g.z), bflo(g.w), bfhi(g.w)};
                    if (n < 2) { const u32x4 d = *(const u32x4*)(gp + 1024);
                        const float dn[8] = {bflo(d.x), bfhi(d.x), bflo(d.y), bfhi(d.y), bflo(d.z), bfhi(d.z), bflo(d.w), bfhi(d.w)};
#pragma unroll
                        for (int j = 0; j < 8; ++j) f[j] *= __builtin_amdgcn_rcpf(fmaxf(dn[j], 1e-30f)); }
                    f32x4 p0 = acc[ai][bj][m][0], p1 = acc[ai][bj][m][1];
                    p0[0] *= f[0]; p0[1] *= f[1]; p0[2] *= f[2]; p0[3] *= f[3]; p1[0] *= f[4]; p1[1] *= f[5]; p1[2] *= f[6]; p1[3] *= f[7];
                    if (n < 2) { acc[ai][bj][m][0] = p0; acc[ai][bj][m][1] = p1; }
                    else { u32x4 w; w.x = cvt_pk_bf16(p0[0], p0[1]); w.y = cvt_pk_bf16(p0[2], p0[3]); w.z = cvt_pk_bf16(p1[0], p1[1]); w.w = cvt_pk_bf16(p1[2], p1[3]);
                        *(u32x4*)(merged + (size_t)row * DM + col0 + bj * HALF) = w; }
                }
                if (m & 1) EPI_FENCE;
            }
    }
};
struct EpiResid {
    static constexpr bool PERM = false, KEEP_ACC = false;
    const float* xin; float* xout; bf16_t* xb; float* rowsq; LAS float* ex;
    __device__ __forceinline__ void operator()(f32x4 (&acc)[2][2][4][2], const Unit& u, const int wv_) const {
        const int tid_ = TIDX, lane_ = tid_ & 63, wr = wv_ >> 2, wc = wv_ & 3, fr = lane_ & 15, fq = lane_ >> 4;
        const int row0 = u.pm * BM + wr * 64 + fr + opaque0(), col0 = u.pn * BM + wc * 32 + 4 * fq;
#pragma unroll
        for (int ai = 0; ai < 2; ++ai)
#pragma unroll
            for (int m = 0; m < 4; ++m) {
                const int row = row0 + ai * HALF + m * 16; float ss = 0.f;
#pragma unroll
                for (int bj = 0; bj < 2; ++bj)
#pragma unroll
                    for (int n = 0; n < 2; ++n) {
                        const size_t o = (size_t)row * DM + col0 + bj * HALF + n * 16;
                        const f32x4 xn = *(const f32x4*)(xin + o) + acc[ai][bj][m][n];
                        *(f32x4*)(xout + o) = xn;
                        ss += (xn[0] * xn[0] + xn[1] * xn[1]) + (xn[2] * xn[2] + xn[3] * xn[3]);
                        u32x2 w; w.x = cvt_pk_bf16(xn[0], xn[1]); w.y = cvt_pk_bf16(xn[2], xn[3]); *(u32x2*)(xb + o) = w;
                    }
                ss += __shfl_xor(ss, 16); ss += __shfl_xor(ss, 32);
                if (fq == 0) ex[(ai * HALF + wr * 64 + m * 16 + fr) * 4 + wc] = ss;
                if (m & 1) EPI_FENCE;
            }
        asm volatile("s_waitcnt lgkmcnt(0)" ::: "memory"); __builtin_amdgcn_s_barrier(); asm volatile("" ::: "memory");
        if (tid_ < 256) { const f32x4 q = *(LAS f32x4*)(ex + tid_ * 4); rowsq[(size_t)(u.pm * BM + tid_) * 4 + u.pn] = (q[0] + q[1]) + (q[2] + q[3]); }
    }
};
struct EpiFfn {
    static constexpr bool PERM = false, KEEP_ACC = false;
    bf16_t* act; const float* rowsq; const float* cw; const float* cb; float* side;
    __device__ __forceinline__ void operator()(f32x4 (&acc)[2][2][4][2], const Unit& u, const int wv_) const {
        const int lane_ = TIDX & 63, wr = wv_ >> 2, wc = wv_ & 3, fr = lane_ & 15, fq = lane_ >> 4;
        const int row0 = u.pm * BM + wr * 64 + fr + opaque0();
        float rs[2][4];
#pragma unroll
        for (int ai = 0; ai < 2; ++ai)
#pragma unroll
            for (int m = 0; m < 4; ++m) rs[ai][m] = row_rs(rowsq, row0 + ai * HALF + m * 16);
        EPI_FENCE;
        float chain = rs[0][0];
#pragma unroll
        for (int nn = 0; nn < 2; ++nn) {
#pragma unroll
            for (int hf = 0; hf < 2; ++hf) {
                const int ch0 = hf * DFF + u.pn * 128 + wc * 32 + 16 * nn + 4 * fq + __float_as_int(opaque0_after(chain));
                const f32x4 w0 = *(const f32x4*)(cw + ch0), w1 = *(const f32x4*)(cw + NUP + ch0), w2 = *(const f32x4*)(cw + 2 * NUP + ch0), wb = *(const f32x4*)(cb + ch0);
                const int fr2 = fr + __float_as_int(opaque0_after(chain));
                if (fr2 < 2 || fr2 >= 14) {
                    const int slot = fr2 < 2 ? fr2 : fr2 - 12;
#pragma unroll
                    for (int ai = 0; ai < 2; ++ai) {
                        const int blk = u.pm * 4 + ai * 2 + wr;
                        const f32x4 xe = fr2 < 2 ? acc[ai][hf][0][nn] * rs[ai][0] : acc[ai][hf][3][nn] * rs[ai][3];
                        *(f32x4*)((char*)side + (unsigned)(((blk * 4 + slot) * NUP + ch0) * 4)) = xe;
                    }
                }
                EPI_FENCE;
#pragma unroll
                for (int ai = 0; ai < 2; ++ai) {
                    f32x4 p1 = (f32x4){0.f, 0.f, 0.f, 0.f}, p2 = p1;
#pragma unroll
                    for (int m = 0; m < 4; ++m) {
                        const float rsm = rs[ai][m] + ((m & 1) ? 0.f : opaque0_after(chain));
                        f32x4 r1, r2, res;
#pragma unroll
                        for (int j = 0; j < 4; ++j) {
                            const float x = acc[ai][hf][m][nn][j] * rsm;
                            r1[j] = dppmov<0x121>(x); r2[j] = dppmov<0x122>(x);
                            const float q1 = fr >= 1 ? r1[j] : p1[j], q2 = fr >= 2 ? r2[j] : p2[j];
                            const float pre = w2[j] * x + w1[j] * q1 + w0[j] * q2 + wb[j];
                            res[j] = (hf == 0) ? siluf_(pre) : acc[ai][0][m][nn][j] * pre;
                        }
                        chain = res[3];
                        if (hf == 0) acc[ai][0][m][nn] = res;
                        else {
                            u32x2 w; w.x = cvt_pk_bf16(res[0], res[1]); w.y = cvt_pk_bf16(res[2], res[3]);
                            *(u32x2*)((char*)act + (unsigned)(((row0 + ai * HALF + m * 16) * DFF + (ch0 - DFF)) * 2)) = w;
                        }
                        p1 = r1; p2 = r2;
                    }
                }
            }
        }
    }
};

__device__ __forceinline__ int srccol(int map, int s0, int n) {
    if (map == 1) return n < 1536 ? n : n + 8;
    if (map == 2) return ((n >> 7) & 1) * DFF + (n >> 8) * 128 + (n & 127);
    return s0 + n;
}
__device__ void prep_w(LAS float* L, bf16_t* dst, const float* src, int K, int N, int ld, int s0, int map, const float* g, int& off, const int wv_, int Gp = 0, int cp = 0) {
    const int G = Gp > 0 ? Gp : (int)gridDim.x, c = Gp > 0 ? cp : (int)blockIdx.x, tid = TIDX;
    const int nkt = K >> 6, ntiles = (N >> 6) * nkt;
    const int i0 = tid >> 6, j = tid & 63, nn = tid >> 3, kc = tid & 7;
    float r[8];
#define PREP_LOAD(T) do { const int n0_ = ((T) / nkt) << 6, k0_ = ((T) % nkt) << 6; const int col_ = srccol(map, s0, n0_) + j; \
        _Pragma("unroll") for (int pp = 0; pp < 8; ++pp) { const int k_ = k0_ + i0 + 8 * pp; float v_ = src[(size_t)k_ * ld + col_]; if (g) v_ *= g[k_]; r[pp] = v_; } } while (0)
    int t = (c + G - off % G) % G;
    if (t < ntiles) PREP_LOAD(t);
    for (; t < ntiles; t += G) {
        const int n0 = (t / nkt) << 6, k0 = (t % nkt) << 6;
#pragma unroll
        for (int pp = 0; pp < 8; ++pp) L[(i0 + 8 * pp) * 65 + j] = r[pp];
        __syncthreads();
        if (t + G < ntiles) PREP_LOAD(t + G);
        u32x4 w;
        w.x = cvt_pk_bf16(L[(kc * 8 + 0) * 65 + nn], L[(kc * 8 + 1) * 65 + nn]); w.y = cvt_pk_bf16(L[(kc * 8 + 2) * 65 + nn], L[(kc * 8 + 3) * 65 + nn]);
        w.z = cvt_pk_bf16(L[(kc * 8 + 4) * 65 + nn], L[(kc * 8 + 5) * 65 + nn]); w.w = cvt_pk_bf16(L[(kc * 8 + 6) * 65 + nn], L[(kc * 8 + 7) * 65 + nn]);
        *(u32x4*)(dst + (size_t)(n0 + nn) * K + k0 + kc * 8) = w;
        __syncthreads();
    }
#undef PREP_LOAD
    off += ntiles;
}
__device__ void prep_layer_main(const Params& p, int l, LAS float* L, const int wv_, int part = 3, int Gp = 0, int cp = 0) {
    bf16_t* W = (bf16_t*)(p.ws + WS_W); int off = 0;
    const int G = Gp > 0 ? Gp : (int)gridDim.x, c = Gp > 0 ? cp : (int)blockIdx.x;
    const float* win = p.w_in + (size_t)l * 1024 * NIN; const float* gn = p.attn_norm + l * 1024;
    if (part & 1) {
        prep_w(L, W + W_IN, win, 1024, NU, NIN, 0, 1, gn, off, wv_, Gp, cp);
        bf16_t* wab = (bf16_t*)(p.ws + WS_WAB);
        for (int i0 = c * 512; i0 < 8192; i0 += G * 512) { const int i = i0 + TIDX; const int jj = i >> 10, k = i & 1023; const float wv = win[(size_t)k * NIN + 1536 + jj] * gn[k];
            const unsigned hi = cvt_pk_bf16(wv, 0.f) & 0xffffu; const float lo = wv - bflo(hi); wab[jj * 1024 + k] = (bf16_t)hi; wab[(8 + jj) * 1024 + k] = (bf16_t)(cvt_pk_bf16(lo, 0.f) & 0xffffu); }
    }
    if (part & 2) {
        prep_w(L, W + W_G, win, 1024, NG, NIN, 4616, 0, gn, off, wv_, Gp, cp);
        for (int n = 0; n < 3; ++n) prep_w(L, W + W_B + (size_t)n * 1024 * 512, p.w_branch + ((size_t)l * 3 + n) * 512 * 1024, 512, 1024, 1024, 0, 0, nullptr, off, wv_, Gp, cp);
        prep_w(L, W + W_O, p.w_out + (size_t)l * 1024 * 1024, 1024, 1024, 1024, 0, 0, nullptr, off, wv_, Gp, cp);
        prep_w(L, W + W_UP, p.w_up + (size_t)l * 1024 * NUP, 1024, NUP, NUP, 0, 2, p.ffn_norm + l * 1024, off, wv_, Gp, cp);
    }
}
__device__ void prep_layer_down(const Params& p, int l, LAS float* L, const int wv_, int Gp = 0, int cp = 0) {
    bf16_t* W = (bf16_t*)(p.ws + WS_W); int off = 0;
    prep_w(L, W + W_DN, p.w_down + (size_t)l * DFF * 1024, DFF, 1024, 1024, 0, 0, nullptr, off, wv_, Gp, cp);
}

__device__ void rownorm(const Params& p, const float* src, float* rowsq, const int wv_) {
    const int tid = TIDX, lane = tid & 63, gw = blockIdx.x * 8 + (tid >> 6), nw = gridDim.x * 8;
    bf16_t* xb = (bf16_t*)(p.ws + WS_XB);
    for (int row = gw; row < MTOK; row += nw) {
        float ss = 0.f;
#pragma unroll
        for (int i = 0; i < 4; ++i) { const size_t o = (size_t)row * DM + i * 256 + lane * 4; const f32x4 v = *(const f32x4*)(src + o);
            ss += (v[0] * v[0] + v[1] * v[1]) + (v[2] * v[2] + v[3] * v[3]); u32x2 w; w.x = cvt_pk_bf16(v[0], v[1]); w.y = cvt_pk_bf16(v[2], v[3]); *(u32x2*)(xb + o) = w; }
#pragma unroll
        for (int s = 32; s >= 1; s >>= 1) ss += __shfl_xor(ss, s);
        if (lane == 0) *(f32x4*)(rowsq + (size_t)row * 4) = (f32x4){ss, 0.f, 0.f, 0.f};
    }
}

__device__ void rot_table(const Params& p, const int wv_) {
    const int t_ = TIDX; float* tab = (float*)(p.ws + WS_ROT);
    for (int i0 = blockIdx.x * 512; i0 < MTOK * 32; i0 += gridDim.x * 512) {
        const int i = i0 + t_, token = i >> 5, j = i & 31;
        const float inv = (float)pow(10000.0, -(double)j / 32.0); float sn, cs; sincosf((float)p.pos[token] * inv, &sn, &cs);
        *(f32x2*)(tab + (size_t)i * 2) = (f32x2){cs, sn};
    }
}
__device__ void ab_tail(const Params& p, const int wv_) {
    const int tid = TIDX, lane = tid & 63, gw = blockIdx.x * 8 + (tid >> 6), nw = gridDim.x * 8, r16 = lane & 15, kq = lane >> 4;
    const bf16_t* xb = (const bf16_t*)(p.ws + WS_XB); const float* rowsq = (const float*)(p.ws + WS_ROWSQ + MiB); const bf16_t* wab = (const bf16_t*)(p.ws + WS_WAB); float* ab = (float*)(p.ws + WS_AB);
    for (int rb = gw; rb < MTOK / 16; rb += nw) {
        const bf16_t* ap = xb + (size_t)(rb * 16 + r16) * DM + kq * 8; const bf16_t* bp = wab + r16 * 1024 + kq * 8;
        f32x4 acc = (f32x4){0.f, 0.f, 0.f, 0.f};
#pragma unroll 8
        for (int kk = 0; kk < 32; ++kk) acc = __builtin_amdgcn_mfma_f32_16x16x32_bf16(*(const bf16x8*)(ap + kk * 32), *(const bf16x8*)(bp + kk * 32), acc, 0, 0, 0);
#pragma unroll
        for (int j = 0; j < 4; ++j) { const float v = acc[j] + __shfl_xor(acc[j], 8); const int row = rb * 16 + kq * 4 + j; if (r16 < 8) ab[(size_t)row * 8 + r16] = v * row_rs(rowsq, row); }
    }
}

__device__ void u0_tail(const Params& p, int layer, LAS float* L, const int wv_) {
    const int tid = TIDX;
    if ((int)blockIdx.x >= 192) return;
    const int cgp = (int)blockIdx.x % 24, ksl = (int)blockIdx.x / 24, kb0 = ksl * 128;
    const float* xs = (layer == 0) ? p.x : p.out; const float* rowsq = (const float*)(p.ws + WS_ROWSQ + MiB); const float* gn = p.attn_norm + layer * 1024;
    const float* win = p.w_in + (size_t)layer * 1024 * NIN; float* u0 = (float*)(p.ws + WS_U0) + (size_t)ksl * 16 * 1536;
    for (int i = tid; i < 16 * 128; i += 512) { const int r = i >> 7, k = kb0 + (i & 127); L[i] = xs[(size_t)(r * SEQ) * DM + k] * row_rs(rowsq, r * SEQ) * gn[k]; }
    __syncthreads();
    const int c = cgp * 64 + (tid & 63), rg = tid >> 6;
    const int sc = c < 1024 ? c : 2056 + (c - 1024);
    const float* wp = win + (size_t)kb0 * NIN + sc;
    float a0 = 0.f, a1 = 0.f;
#pragma unroll 32
    for (int k = 0; k < 128; ++k) { const float w = wp[(size_t)k * NIN]; a0 += L[(2 * rg) * 128 + k] * w; a1 += L[(2 * rg + 1) * 128 + k] * w; }
    u0[(2 * rg) * 1536 + c] = a0; u0[(2 * rg + 1) * 1536 + c] = a1;
    __syncthreads();
}
__device__ __forceinline__ float u0_read(const float* u0, int b, int col) {
    float s = 0.f;
#pragma unroll
    for (int ks = 0; ks < 8; ++ks) s += u0[((size_t)ks * 16 + b) * 1536 + col];
    return s;
}

__device__ __forceinline__ void lds_barrier() { asm volatile("s_waitcnt lgkmcnt(0)" ::: "memory"); __builtin_amdgcn_s_barrier(); asm volatile("" ::: "memory"); }
constexpr int DN_QF = 0, DN_KF = 32768, DN_LM = 0, DN_OS = 16384, DN_QB = 65536, DN_KB = 82944, DN_KT = 100352, DN_AB = 118784, DN_ST = 128000, DN_U = 145408, DN_VT = 32768, DN_VTS = 41984, DN_MISC = 162048;
__device__ void deltanet_item(const Params& p, int layer, int item, LAS unsigned char* Lb, const int wv_) {
    const int tid0 = TIDX, w = wv_;
    const int b = item >> 3, h = (item >> 1) & 3, sl = item & 1;
    LAS float* qs = (LAS float*)(Lb + DN_QF); LAS float* ks = (LAS float*)(Lb + DN_KF);
    LAS bf16_t* XT = (LAS bf16_t*)(Lb + DN_OS); LAS bf16_t* LB21 = (LAS bf16_t*)(Lb + DN_OS + 12288);
    LAS float* Lm = (LAS float*)(Lb + DN_LM); LAS float* os = (LAS float*)(Lb + DN_OS);
    LAS bf16_t* qb = (LAS bf16_t*)(Lb + DN_QB); LAS bf16_t* kb = (LAS bf16_t*)(Lb + DN_KB);
    LAS bf16_t* kT = (LAS bf16_t*)(Lb + DN_KT);
    LAS bf16_t* Ab = (LAS bf16_t*)(Lb + DN_AB);
    LAS bf16_t* Stl = (LAS bf16_t*)(Lb + DN_ST);
    LAS float* U = (LAS float*)(Lb + DN_U);
    LAS bf16_t* vT = (LAS bf16_t*)(Lb + DN_VT); LAS bf16_t* vTs = (LAS bf16_t*)(Lb + DN_VTS);
    LAS float* gcs = (LAS float*)(Lb + DN_MISC); LAS float* bes = gcs + 64; LAS float* egs = gcs + 128; LAS float* egl = gcs + 192;
    const bf16_t* u = (const bf16_t*)(p.ws + WS_U); const float* ab = (const float*)(p.ws + WS_AB);
    float* sta = (float*)(p.ws + WS_STA); bf16_t* ya = (bf16_t*)(p.ws + WS_Y);
    const float* cw = p.dn_conv_w + (size_t)layer * 4 * 1536;
    const int cp0 = tid0 & 127;
    const int colq = (cp0 < 64) ? (h * 128 + 2 * cp0) : (512 + h * 128 + 2 * (cp0 - 64));
    float cwa[4], cwb[4];
#pragma unroll
    for (int j = 0; j < 4; ++j) { cwa[j] = cw[j * 1536 + colq]; cwb[j] = cw[j * 1536 + colq + 1]; }
    const int c80 = tid0 & 7;
    const int colv = 1024 + h * 128 + sl * 64 + c80 * 8;
    const float Aexp = __expf(p.dn_a_log[layer * 4 + h]), dtb = p.dn_dt_bias[layer * 4 + h];
    f32x4 Sacc[4] = {(f32x4){0.f, 0.f, 0.f, 0.f}, (f32x4){0.f, 0.f, 0.f, 0.f}, (f32x4){0.f, 0.f, 0.f, 0.f}, (f32x4){0.f, 0.f, 0.f, 0.f}};
    for (int i = tid0; i < 64 * 136 / 2; i += 512) ((LAS unsigned*)Stl)[i] = 0u;
    unsigned rq[19]; u32x4 rv[4]; float ralpha = 0.f, rbeta = 0.f;
#define DN_PREFETCH(CH) do { const int tid_ = TIDX; const int tq_ = tid_ >> 7, tl8_ = tid_ >> 3, ln_ = tid_ & 63; \
        const int t0_ = (CH) * 64 + tq_ * 16; const bf16_t* up_ = u + (size_t)(b * SEQ + t0_) * NU + colq; \
        _Pragma("unroll") for (int i_ = 0; i_ < 19; ++i_) { rq[i_] = 0u; if (t0_ - 3 + i_ >= 0) rq[i_] = *(const unsigned*)(up_ + (ptrdiff_t)(i_ - 3) * NU); } \
        const int t_ = (CH) * 64 + tl8_; \
        _Pragma("unroll") for (int j_ = 0; j_ < 4; ++j_) { rv[j_] = (u32x4){0u, 0u, 0u, 0u}; if (t_ - 3 + j_ >= 0) rv[j_] = *(const u32x4*)(u + (size_t)(b * SEQ + t_ - 3 + j_) * NU + colv); } \
        if (w == 0) { const float* abp_ = ab + (size_t)(b * SEQ + (CH) * 64 + ln_) * 8; ralpha = abp_[h]; rbeta = abp_[4 + h]; } } while (0)
    DN_PREFETCH(0);
    for (int ch = 0; ch < 32; ++ch) {
        const int tbase = b * SEQ + ch * 64;
        const int tid = TIDX, lane = tid & 63, cp = tid & 127, tq = tid >> 7, tl8 = tid >> 3, c8 = tid & 7, r16 = lane & 15, kq = lane >> 4;
        LAS float* dstq = (cp < 64) ? (qs + 2 * cp) : (ks + 2 * (cp - 64));
        {
            const int t0 = ch * 64 + tq * 16;
            float xa[3] = {bflo(rq[0]), bflo(rq[1]), bflo(rq[2])}, xb_[3] = {bfhi(rq[0]), bfhi(rq[1]), bfhi(rq[2])};
#pragma unroll
            for (int i = 0; i < 16; ++i) {
                float ca = bflo(rq[3 + i]), cb = bfhi(rq[3 + i]);
                if (i == 0 && t0 == 0) { const float* u0p = (const float*)(p.ws + WS_U0); ca = u0_read(u0p, b, colq); cb = u0_read(u0p, b, colq + 1); }
                const float ya_ = cwa[0] * xa[0] + cwa[1] * xa[1] + cwa[2] * xa[2] + cwa[3] * ca, yb_ = cwb[0] * xb_[0] + cwb[1] * xb_[1] + cwb[2] * xb_[2] + cwb[3] * cb;
                *(LAS f32x2*)(dstq + (tq * 16 + i) * 128) = (f32x2){siluf_(ya_), siluf_(yb_)};
                xa[0] = xa[1]; xa[1] = xa[2]; xa[2] = ca; xb_[0] = xb_[1]; xb_[1] = xb_[2]; xb_[2] = cb;
            }
        }
        {
            f32x4 cwv[4][2]; { const float* cwp = cw + colv + opaque0();
#pragma unroll
                for (int j = 0; j < 4; ++j) { cwv[j][0] = *(const f32x4*)(cwp + j * 1536); cwv[j][1] = *(const f32x4*)(cwp + j * 1536 + 4); } }
            f32x4 accv0 = (f32x4){0.f, 0.f, 0.f, 0.f}, accv1 = accv0;
#pragma unroll
            for (int j = 0; j < 4; ++j) { accv0 += cwv[j][0] * (f32x4){bflo(rv[j].x), bfhi(rv[j].x), bflo(rv[j].y), bfhi(rv[j].y)}; accv1 += cwv[j][1] * (f32x4){bflo(rv[j].z), bfhi(rv[j].z), bflo(rv[j].w), bfhi(rv[j].w)}; }
#pragma unroll
            for (int j = 0; j < 4; ++j) { U[tl8 * 65 + c8 * 8 + j] = siluf_(accv0[j]); U[tl8 * 65 + c8 * 8 + 4 + j] = siluf_(accv1[j]); }
        }
        if (w == 0) {
            float g = -Aexp * softplusf_(ralpha + dtb);
#pragma unroll
            for (int sft = 1; sft < 64; sft <<= 1) { const float o = __shfl_up(g, sft); if (lane >= sft) g += o; }
            const float gl = __shfl(g, 63);
            gcs[lane] = g; bes[lane] = sigmoidf_(rbeta); egs[lane] = __expf(g); egl[lane] = __expf(gl - g);
        }
        lds_barrier();
        {
            LAS f32x4* qp = (LAS f32x4*)(qs + tl8 * 128 + c8 * 16); LAS f32x4* kp = (LAS f32x4*)(ks + tl8 * 128 + c8 * 16);
            f32x4 q0 = qp[0], q1 = qp[1], q2 = qp[2], q3 = qp[3], k0 = kp[0], k1 = kp[1], k2 = kp[2], k3 = kp[3];
            float sq = 0.f, sk = 0.f;
#pragma unroll
            for (int j = 0; j < 4; ++j) { sq += q0[j] * q0[j] + q1[j] * q1[j] + q2[j] * q2[j] + q3[j] * q3[j]; sk += k0[j] * k0[j] + k1[j] * k1[j] + k2[j] * k2[j] + k3[j] * k3[j]; }
            sq += __shfl_xor(sq, 1); sq += __shfl_xor(sq, 2); sq += __shfl_xor(sq, 4); sk += __shfl_xor(sk, 1); sk += __shfl_xor(sk, 2); sk += __shfl_xor(sk, 4);
            const float fq_ = rsqrtf(sq + EPS) * 0.08838834764831845f, fk = rsqrtf(sk + EPS);
            q0 *= fq_; q1 *= fq_; q2 *= fq_; q3 *= fq_; k0 *= fk; k1 *= fk; k2 *= fk; k3 *= fk;
            if (ch == 0) {
                float d = 0.f;
#pragma unroll
                for (int j = 0; j < 4; ++j) d += q0[j] * k0[j] + q1[j] * k1[j] + q2[j] * k2[j] + q3[j] * k3[j];
                d += __shfl_xor(d, 1); d += __shfl_xor(d, 2); d += __shfl_xor(d, 4);
                if (tid == 0) gcs[256] = d;
            }
            u32x4 wq0, wq1, wk0, wk1;
            wq0.x = cvt_pk_bf16(q0[0], q0[1]); wq0.y = cvt_pk_bf16(q0[2], q0[3]); wq0.z = cvt_pk_bf16(q1[0], q1[1]); wq0.w = cvt_pk_bf16(q1[2], q1[3]);
            wq1.x = cvt_pk_bf16(q2[0], q2[1]); wq1.y = cvt_pk_bf16(q2[2], q2[3]); wq1.z = cvt_pk_bf16(q3[0], q3[1]); wq1.w = cvt_pk_bf16(q3[2], q3[3]);
            wk0.x = cvt_pk_bf16(k0[0], k0[1]); wk0.y = cvt_pk_bf16(k0[2], k0[3]); wk0.z = cvt_pk_bf16(k1[0], k1[1]); wk0.w = cvt_pk_bf16(k1[2], k1[3]);
            wk1.x = cvt_pk_bf16(k2[0], k2[1]); wk1.y = cvt_pk_bf16(k2[2], k2[3]); wk1.z = cvt_pk_bf16(k3[0], k3[1]); wk1.w = cvt_pk_bf16(k3[2], k3[3]);
            *(LAS u32x4*)(qb + tl8 * 136 + c8 * 16) = wq0; *(LAS u32x4*)(qb + tl8 * 136 + c8 * 16 + 8) = wq1;
            *(LAS u32x4*)(kb + tl8 * 136 + c8 * 16) = wk0; *(LAS u32x4*)(kb + tl8 * 136 + c8 * 16 + 8) = wk1;
            const unsigned kw[8] = {wk0.x, wk0.y, wk0.z, wk0.w, wk1.x, wk1.y, wk1.z, wk1.w};
#pragma unroll
            for (int j = 0; j < 8; ++j) { kT[(c8 * 16 + 2 * j) * 72 + tl8] = (bf16_t)(kw[j] & 0xffffu); kT[(c8 * 16 + 2 * j + 1) * 72 + tl8] = (bf16_t)(kw[j] >> 16); }
            const float be = bes[tl8], bg = be * egs[tl8];
            kp[0] = k0 * bg; kp[1] = k1 * bg; kp[2] = k2 * bg; kp[3] = k3 * bg;
#pragma unroll
            for (int j = 0; j < 8; ++j) U[tl8 * 65 + c8 * 8 + j] *= be;
        }
        lds_barrier();
        if (ch + 1 < 32) DN_PREFETCH(ch + 1);
        {
            const int mt = w & 3, ntb = (w >> 2) * 2;
            f32x4 akk[2] = {(f32x4){0.f, 0.f, 0.f, 0.f}, (f32x4){0.f, 0.f, 0.f, 0.f}}, aqk[2] = {akk[0], akk[0]};
#pragma unroll
            for (int kk = 0; kk < 4; ++kk) {
                const bf16x8 fk_ = *(const LAS bf16x8*)(kb + (mt * 16 + r16) * 136 + kk * 32 + kq * 8);
                const bf16x8 fq2 = *(const LAS bf16x8*)(qb + (mt * 16 + r16) * 136 + kk * 32 + kq * 8);
#pragma unroll
                for (int q = 0; q < 2; ++q) {
                    const bf16x8 fb = *(const LAS bf16x8*)(kb + ((ntb + q) * 16 + r16) * 136 + kk * 32 + kq * 8);
                    akk[q] = __builtin_amdgcn_mfma_f32_16x16x32_bf16(fk_, fb, akk[q], 0, 0, 0);
                    aqk[q] = __builtin_amdgcn_mfma_f32_16x16x32_bf16(fq2, fb, aqk[q], 0, 0, 0);
                }
            }
#pragma unroll
            for (int q = 0; q < 2; ++q)
#pragma unroll
                for (int j = 0; j < 4; ++j) {
                    const int c_ = mt * 16 + kq * 4 + j, s_ = (ntb + q) * 16 + r16;
                    const float dec = __expf(s_ <= c_ ? gcs[c_] - gcs[s_] : 0.f);
                    const float lv = (s_ < c_) ? bes[c_] * akk[q][j] * dec : 0.f;
                    Lm[c_ * 64 + s_] = lv;
                    if (c_ >= 32 && s_ < 32) LB21[(c_ - 32) * 40 + s_] = (bf16_t)(cvt_pk_bf16(lv, 0.f) & 0xffffu);
                    float av = (s_ <= c_) ? aqk[q][j] * dec : 0.f; if (ch == 0 && c_ == 0 && s_ == 0) av = gcs[256];
                    Ab[c_ * 72 + s_] = (bf16_t)(cvt_pk_bf16(av, 0.f) & 0xffffu);
                }
        }
        lds_barrier();
        {
            LAS float* bp = (tid < 64) ? (U + tid) : (ks + (tid - 64)); const int bstr = (tid < 64) ? 65 : 128;
            if (tid < 192) {
                float x[32];
#pragma unroll
                for (int i = 0; i < 32; ++i) x[i] = 0.f;
#pragma unroll
                for (int i = 0; i < 32; ++i) {
                    float a0 = bp[i * bstr], a1 = 0.f;
#pragma unroll
                    for (int m4 = 0; m4 < (i + 3) / 4; ++m4) { const f32x4 l = *(LAS f32x4*)(Lm + i * 64 + m4 * 4);
                        a0 -= l[0] * x[m4 * 4 + 0]; a1 -= l[1] * x[m4 * 4 + 1]; a0 -= l[2] * x[m4 * 4 + 2]; a1 -= l[3] * x[m4 * 4 + 3]; }
                    x[i] = a0 + a1;
                }
                if (tid < 64) {
#pragma unroll
                    for (int i = 0; i < 32; ++i) U[i * 65 + tid] = x[i];
                } else {
#pragma unroll
                    for (int i = 0; i < 32; ++i) kb[i * 136 + (tid - 64)] = (bf16_t)(cvt_pk_bf16(x[i], 0.f) & 0xffffu);
                }
#pragma unroll
                for (int i8 = 0; i8 < 4; ++i8) { u32x4 t; t.x = cvt_pk_bf16(x[i8 * 8 + 0], x[i8 * 8 + 1]); t.y = cvt_pk_bf16(x[i8 * 8 + 2], x[i8 * 8 + 3]); t.z = cvt_pk_bf16(x[i8 * 8 + 4], x[i8 * 8 + 5]); t.w = cvt_pk_bf16(x[i8 * 8 + 6], x[i8 * 8 + 7]);
                    *(LAS u32x4*)(XT + tid * 32 + i8 * 8) = t; }
            }
            lds_barrier();
#pragma unroll
            for (int q = 0; q < 3; ++q) {
                const int t_ = w * 3 + q, mt = t_ & 1, nt = t_ >> 1;
                const bf16x8 fa = *(const LAS bf16x8*)(LB21 + (mt * 16 + r16) * 40 + kq * 8);
                const bf16x8 fb = *(const LAS bf16x8*)(XT + (nt * 16 + r16) * 32 + kq * 8);
                const f32x4 cacc = __builtin_amdgcn_mfma_f32_16x16x32_bf16(fa, fb, (f32x4){0.f, 0.f, 0.f, 0.f}, 0, 0, 0);
                const int col_ = nt * 16 + r16;
                LAS float* cp_ = (col_ < 64) ? (U + col_) : (ks + (col_ - 64)); const int cstr = (col_ < 64) ? 65 : 128;
#pragma unroll
                for (int j = 0; j < 4; ++j) cp_[(32 + mt * 16 + kq * 4 + j) * cstr] -= cacc[j];
            }
            lds_barrier();
            if (tid < 192) {
                float x[32];
#pragma unroll
                for (int i = 0; i < 32; ++i) x[i] = 0.f;
#pragma unroll
                for (int i = 0; i < 32; ++i) {
                    float a0 = bp[(32 + i) * bstr], a1 = 0.f;
#pragma unroll
                    for (int m4 = 0; m4 < (i + 3) / 4; ++m4) { const f32x4 l = *(LAS f32x4*)(Lm + (32 + i) * 64 + 32 + m4 * 4);
                        a0 -= l[0] * x[m4 * 4 + 0]; a1 -= l[1] * x[m4 * 4 + 1]; a0 -= l[2] * x[m4 * 4 + 2]; a1 -= l[3] * x[m4 * 4 + 3]; }
                    x[i] = a0 + a1;
                }
                if (tid < 64) {
#pragma unroll
                    for (int i = 0; i < 32; ++i) U[(32 + i) * 65 + tid] = x[i];
                } else {
#pragma unroll
                    for (int i = 0; i < 32; ++i) kb[(32 + i) * 136 + (tid - 64)] = (bf16_t)(cvt_pk_bf16(x[i], 0.f) & 0xffffu);
                }
            }
        }
        lds_barrier();
        const u32x4 zr = *(const u32x4*)(u + (size_t)(tbase + tl8) * NU + 1536 + h * 128 + sl * 64 + c8 * 8);
        const float* nwp = p.dn_norm_w + layer * 128 + sl * 64 + c8 * 8 + opaque0(); const f32x4 nw0 = *(const f32x4*)nwp, nw1 = *(const f32x4*)(nwp + 4);
        f32x4 qsv[2];
        const int mtE = w & 3, ntE = (w >> 2) * 2;
        {
            f32x4 aws[2] = {(f32x4){0.f, 0.f, 0.f, 0.f}, (f32x4){0.f, 0.f, 0.f, 0.f}}, aqs[2] = {aws[0], aws[0]};
#pragma unroll
            for (int kk = 0; kk < 4; ++kk) {
                const bf16x8 fw = *(const LAS bf16x8*)(kb + (mtE * 16 + r16) * 136 + kk * 32 + kq * 8);
                const bf16x8 fq2 = *(const LAS bf16x8*)(qb + (mtE * 16 + r16) * 136 + kk * 32 + kq * 8);
#pragma unroll
                for (int q = 0; q < 2; ++q) {
                    const bf16x8 fs = *(const LAS bf16x8*)(Stl + ((ntE + q) * 16 + r16) * 136 + kk * 32 + kq * 8);
                    aws[q] = __builtin_amdgcn_mfma_f32_16x16x32_bf16(fw, fs, aws[q], 0, 0, 0);
                    aqs[q] = __builtin_amdgcn_mfma_f32_16x16x32_bf16(fq2, fs, aqs[q], 0, 0, 0);
                }
            }
#pragma unroll
            for (int q = 0; q < 2; ++q)
#pragma unroll
                for (int j = 0; j < 4; ++j) {
                    const int c_ = mtE * 16 + kq * 4 + j, v_ = (ntE + q) * 16 + r16;
                    const float vn = U[c_ * 65 + v_] - aws[q][j];
                    qsv[q][j] = aqs[q][j] * egs[c_];
                    vT[v_ * 72 + c_] = (bf16_t)(cvt_pk_bf16(vn, 0.f) & 0xffffu);
                    vTs[v_ * 72 + c_] = (bf16_t)(cvt_pk_bf16(vn * egl[c_], 0.f) & 0xffffu);
                }
        }
        lds_barrier();
        {
            f32x4 aav[2] = {(f32x4){0.f, 0.f, 0.f, 0.f}, (f32x4){0.f, 0.f, 0.f, 0.f}};
#pragma unroll
            for (int kk = 0; kk < 2; ++kk) {
                const bf16x8 fa = *(const LAS bf16x8*)(Ab + (mtE * 16 + r16) * 72 + kk * 32 + kq * 8);
#pragma unroll
                for (int q = 0; q < 2; ++q) { const bf16x8 fv = *(const LAS bf16x8*)(vT + ((ntE + q) * 16 + r16) * 72 + kk * 32 + kq * 8); aav[q] = __builtin_amdgcn_mfma_f32_16x16x32_bf16(fa, fv, aav[q], 0, 0, 0); }
            }
#pragma unroll
            for (int q = 0; q < 2; ++q)
#pragma unroll
                for (int j = 0; j < 4; ++j) os[(mtE * 16 + kq * 4 + j) * 64 + (ntE + q) * 16 + r16] = qsv[q][j] + aav[q][j];
            const float ge = __expf(gcs[63]);
            const int mtS = w & 3, ntS = (w >> 2) * 4;
#pragma unroll
            for (int q = 0; q < 4; ++q) {
                Sacc[q] *= ge;
#pragma unroll
                for (int kk = 0; kk < 2; ++kk) {
                    const bf16x8 fv = *(const LAS bf16x8*)(vTs + (mtS * 16 + r16) * 72 + kk * 32 + kq * 8);
                    const bf16x8 fk_ = *(const LAS bf16x8*)(kT + ((ntS + q) * 16 + r16) * 72 + kk * 32 + kq * 8);
                    Sacc[q] = __builtin_amdgcn_mfma_f32_16x16x32_bf16(fv, fk_, Sacc[q], 0, 0, 0);
                }
            }
        }
        lds_barrier();
#pragma unroll
        for (int q = 0; q < 4; ++q)
#pragma unroll
            for (int j = 0; j < 4; ++j) Stl[((w & 3) * 16 + kq * 4 + j) * 136 + ((w >> 2) * 4 + q) * 16 + r16] = (bf16_t)(cvt_pk_bf16(Sacc[q][j], 0.f) & 0xffffu);
        {
            const int token = tbase + tl8;
            const f32x4 o4 = *(LAS f32x4*)(os + tl8 * 64 + c8 * 8), o5 = *(LAS f32x4*)(os + tl8 * 64 + c8 * 8 + 4);
            float ss = ((o4[0] * o4[0] + o4[1] * o4[1]) + (o4[2] * o4[2] + o4[3] * o4[3])) + ((o5[0] * o5[0] + o5[1] * o5[1]) + (o5[2] * o5[2] + o5[3] * o5[3]));
            ss += __shfl_xor(ss, 1); ss += __shfl_xor(ss, 2); ss += __shfl_xor(ss, 4);
            if (c8 == 0) { sta[((size_t)token * 4 + h) * 4 + sl] = ss; sta[((size_t)token * 4 + h) * 4 + 2 + sl] = 0.f; }
            u32x4 wv2;
            wv2.x = cvt_pk_bf16(o4[0] * nw0[0] * siluf_(bflo(zr.x)), o4[1] * nw0[1] * siluf_(bfhi(zr.x))); wv2.y = cvt_pk_bf16(o4[2] * nw0[2] * siluf_(bflo(zr.y)), o4[3] * nw0[3] * siluf_(bfhi(zr.y)));
            wv2.z = cvt_pk_bf16(o5[0] * nw1[0] * siluf_(bflo(zr.z)), o5[1] * nw1[1] * siluf_(bfhi(zr.z))); wv2.w = cvt_pk_bf16(o5[2] * nw1[2] * siluf_(bflo(zr.w)), o5[3] * nw1[3] * siluf_(bfhi(zr.w)));
            *(u32x4*)(ya + (size_t)token * 512 + h * 128 + sl * 64 + c8 * 8) = wv2;
        }
        lds_barrier();
    }
#undef DN_PREFETCH
}

constexpr int RT_QB = 0, RT_KB = 9216, RT_KZT = 18432, RT_VT = 27648, RT_PB = 32256, RT_ST = 41472, RT_OS = 46080, RT_MISC = 54272;
__device__ void retention_item(const Params& p, int item, LAS unsigned char* Lb, const int wv_) {
    const int tid0 = TIDX, w = wv_;
    const int b = item >> 4, h = (item >> 2) & 3, sl = item & 3;
    LAS bf16_t* qb = (LAS bf16_t*)(Lb + RT_QB); LAS bf16_t* kb = (LAS bf16_t*)(Lb + RT_KB);
    LAS bf16_t* kzT = (LAS bf16_t*)(Lb + RT_KZT);
    LAS bf16_t* vT = (LAS bf16_t*)(Lb + RT_VT);
    LAS bf16_t* Pb = (LAS bf16_t*)(Lb + RT_PB);
    LAS bf16_t* Stl = (LAS bf16_t*)(Lb + RT_ST);
    LAS float* os = (LAS float*)(Lb + RT_OS); LAS float* misc = (LAS float*)(Lb + RT_MISC);
    const bf16_t* u = (const bf16_t*)(p.ws + WS_U);
    float* stb = (float*)(p.ws + WS_STB); bf16_t* yb = (bf16_t*)(p.ws + WS_Y) + (size_t)MTOK * 512;
    const float* rtab = (const float*)(p.ws + WS_ROT);
    const float lg2 = log2f(1.0f - exp2f(-5.0f - (float)h));
    f32x4 Sacc = (f32x4){0.f, 0.f, 0.f, 0.f};
    for (int i = tid0; i < 32 * 72 / 2; i += 512) ((LAS unsigned*)Stl)[i] = 0u;
    u32x2 rq1, rq2, rk1, rk2, rvv; f32x4 rcs0, rcs1;
#define RT_PREFETCH(CH) do { const int tid_ = TIDX; const int tl8_ = tid_ >> 3, c8_ = tid_ & 7; const int token_ = b * SEQ + (CH) * 64 + tl8_; const bf16_t* ur_ = u + (size_t)token_ * NU; \
        rq1 = *(const u32x2*)(ur_ + 2048 + h * 64 + c8_ * 4); rq2 = *(const u32x2*)(ur_ + 2048 + h * 64 + 32 + c8_ * 4); \
        rk1 = *(const u32x2*)(ur_ + 2304 + h * 64 + c8_ * 4); rk2 = *(const u32x2*)(ur_ + 2304 + h * 64 + 32 + c8_ * 4); \
        rvv = *(const u32x2*)(ur_ + 2560 + h * 128 + sl * 32 + c8_ * 4); \
        rcs0 = *(const f32x4*)(rtab + ((size_t)token_ * 32 + c8_ * 4) * 2); rcs1 = *(const f32x4*)(rtab + ((size_t)token_ * 32 + c8_ * 4) * 2 + 4); } while (0)
    RT_PREFETCH(0);
    for (int ch = 0; ch < 32; ++ch) {
        const int tid = TIDX, lane = tid & 63, tl8 = tid >> 3, c8 = tid & 7, r16 = lane & 15, kq = lane >> 4;
        const int token = b * SEQ + ch * 64 + tl8;
        {
            float q1f[4] = {bflo(rq1.x), bfhi(rq1.x), bflo(rq1.y), bfhi(rq1.y)}, q2f[4] = {bflo(rq2.x), bfhi(rq2.x), bflo(rq2.y), bfhi(rq2.y)};
            float k1f[4] = {bflo(rk1.x), bfhi(rk1.x), bflo(rk1.y), bfhi(rk1.y)}, k2f[4] = {bflo(rk2.x), bfhi(rk2.x), bflo(rk2.y), bfhi(rk2.y)};
            if (ch == 0 && tl8 == 0) {
                const float* u0p = (const float*)(p.ws + WS_U0); const int cb_ = 1024 + h * 64 + c8 * 4;
#pragma unroll
                for (int j = 0; j < 4; ++j) { q1f[j] = u0_read(u0p, b, cb_ + j); q2f[j] = u0_read(u0p, b, cb_ + 32 + j); k1f[j] = u0_read(u0p, b, cb_ + 256 + j); k2f[j] = u0_read(u0p, b, cb_ + 256 + 32 + j); }
            }
            float qo1[4], qo2[4], ko1[4], ko2[4]; float d00 = 0.f;
#pragma unroll
            for (int j = 0; j < 4; ++j) { const float cs = (j < 2) ? rcs0[2 * j] : rcs1[2 * (j - 2)], sn = (j < 2) ? rcs0[2 * j + 1] : rcs1[2 * (j - 2) + 1];
                qo1[j] = q1f[j] * cs - q2f[j] * sn; qo2[j] = q1f[j] * sn + q2f[j] * cs;
                ko1[j] = (k1f[j] * cs - k2f[j] * sn) * 0.125f; ko2[j] = (k1f[j] * sn + k2f[j] * cs) * 0.125f;
                d00 += qo1[j] * ko1[j] + qo2[j] * ko2[j]; }
            if (ch == 0) { d00 += __shfl_xor(d00, 1); d00 += __shfl_xor(d00, 2); d00 += __shfl_xor(d00, 4); if (tid == 0) misc[0] = d00; }
            u32x2 wq1, wq2, wk1, wk2;
            wq1.x = cvt_pk_bf16(qo1[0], qo1[1]); wq1.y = cvt_pk_bf16(qo1[2], qo1[3]); wq2.x = cvt_pk_bf16(qo2[0], qo2[1]); wq2.y = cvt_pk_bf16(qo2[2], qo2[3]);
            wk1.x = cvt_pk_bf16(ko1[0], ko1[1]); wk1.y = cvt_pk_bf16(ko1[2], ko1[3]); wk2.x = cvt_pk_bf16(ko2[0], ko2[1]); wk2.y = cvt_pk_bf16(ko2[2], ko2[3]);
            *(LAS u32x2*)(qb + tl8 * 72 + c8 * 4) = wq1; *(LAS u32x2*)(qb + tl8 * 72 + 32 + c8 * 4) = wq2;
            *(LAS u32x2*)(kb + tl8 * 72 + c8 * 4) = wk1; *(LAS u32x2*)(kb + tl8 * 72 + 32 + c8 * 4) = wk2;
            const float zeta = exp2f((float)(63 - tl8) * lg2);
#pragma unroll
            for (int j = 0; j < 4; ++j) { kzT[(c8 * 4 + j) * 72 + tl8] = (bf16_t)(cvt_pk_bf16(ko1[j] * zeta, 0.f) & 0xffffu); kzT[(32 + c8 * 4 + j) * 72 + tl8] = (bf16_t)(cvt_pk_bf16(ko2[j] * zeta, 0.f) & 0xffffu); }
            vT[(c8 * 4 + 0) * 72 + tl8] = (bf16_t)(rvv.x & 0xffffu); vT[(c8 * 4 + 1) * 72 + tl8] = (bf16_t)(rvv.x >> 16);
            vT[(c8 * 4 + 2) * 72 + tl8] = (bf16_t)(rvv.y & 0xffffu); vT[(c8 * 4 + 3) * 72 + tl8] = (bf16_t)(rvv.y >> 16);
        }
        lds_barrier();
        if (ch + 1 < 32) RT_PREFETCH(ch + 1);
        f32x4 cross = (f32x4){0.f, 0.f, 0.f, 0.f};
        const int mtE = w & 3, ntE = w >> 2;
        {
            const int mt = w & 3, ntb = (w >> 2) * 2;
            f32x4 asc[2] = {(f32x4){0.f, 0.f, 0.f, 0.f}, (f32x4){0.f, 0.f, 0.f, 0.f}};
#pragma unroll
            for (int kk = 0; kk < 2; ++kk) {
                const bf16x8 fq2 = *(const LAS bf16x8*)(qb + (mt * 16 + r16) * 72 + kk * 32 + kq * 8);
#pragma unroll
                for (int q = 0; q < 2; ++q) { const bf16x8 fb = *(const LAS bf16x8*)(kb + ((ntb + q) * 16 + r16) * 72 + kk * 32 + kq * 8); asc[q] = __builtin_amdgcn_mfma_f32_16x16x32_bf16(fq2, fb, asc[q], 0, 0, 0); }
                const bf16x8 fs = *(const LAS bf16x8*)(Stl + (ntE * 16 + r16) * 72 + kk * 32 + kq * 8);
                cross = __builtin_amdgcn_mfma_f32_16x16x32_bf16(fq2, fs, cross, 0, 0, 0);
            }
#pragma unroll
            for (int q = 0; q < 2; ++q)
#pragma unroll
                for (int j = 0; j < 4; ++j) {
                    const int c_ = mt * 16 + kq * 4 + j, s_ = (ntb + q) * 16 + r16;
                    float sc = (s_ <= c_) ? asc[q][j] * exp2f((float)(c_ - s_) * lg2) : 0.f;
                    if (ch == 0 && c_ == 0 && s_ == 0) sc = misc[0];
                    Pb[c_ * 72 + s_] = (bf16_t)(cvt_pk_bf16(sc, 0.f) & 0xffffu);
                }
#pragma unroll
            for (int j = 0; j < 4; ++j) cross[j] *= exp2f((float)(mtE * 16 + kq * 4 + j + 1) * lg2);
        }
        lds_barrier();
        {
            f32x4 inner = (f32x4){0.f, 0.f, 0.f, 0.f};
#pragma unroll
            for (int kk = 0; kk < 2; ++kk) {
                const bf16x8 fa = *(const LAS bf16x8*)(Pb + (mtE * 16 + r16) * 72 + kk * 32 + kq * 8);
                const bf16x8 fv = *(const LAS bf16x8*)(vT + (ntE * 16 + r16) * 72 + kk * 32 + kq * 8);
                inner = __builtin_amdgcn_mfma_f32_16x16x32_bf16(fa, fv, inner, 0, 0, 0);
            }
#pragma unroll
            for (int j = 0; j < 4; ++j) os[(mtE * 16 + kq * 4 + j) * 32 + ntE * 16 + r16] = cross[j] + inner[j];
            const int mtS = w & 1, ntS = w >> 1;
            Sacc *= exp2f(64.0f * lg2);
#pragma unroll
            for (int kk = 0; kk < 2; ++kk) {
                const bf16x8 fv = *(const LAS bf16x8*)(vT + (mtS * 16 + r16) * 72 + kk * 32 + kq * 8);
                const bf16x8 fk_ = *(const LAS bf16x8*)(kzT + (ntS * 16 + r16) * 72 + kk * 32 + kq * 8);
                Sacc = __builtin_amdgcn_mfma_f32_16x16x32_bf16(fv, fk_, Sacc, 0, 0, 0);
            }
        }
        lds_barrier();
#pragma unroll
        for (int j = 0; j < 4; ++j) Stl[((w & 1) * 16 + kq * 4 + j) * 72 + (w >> 1) * 16 + r16] = (bf16_t)(cvt_pk_bf16(Sacc[j], 0.f) & 0xffffu);
        {
            const f32x4 o4 = *(LAS f32x4*)(os + tl8 * 32 + c8 * 4);
            float s1 = (o4[0] + o4[1]) + (o4[2] + o4[3]), s2 = (o4[0] * o4[0] + o4[1] * o4[1]) + (o4[2] * o4[2] + o4[3] * o4[3]);
            s1 += __shfl_xor(s1, 1); s1 += __shfl_xor(s1, 2); s1 += __shfl_xor(s1, 4); s2 += __shfl_xor(s2, 1); s2 += __shfl_xor(s2, 2); s2 += __shfl_xor(s2, 4);
            if (c8 == 0) *(f32x2*)(stb + (((size_t)token * 4 + h) * 4 + sl) * 2) = (f32x2){s1, s2};
            u32x2 wv2; wv2.x = cvt_pk_bf16(o4[0], o4[1]); wv2.y = cvt_pk_bf16(o4[2], o4[3]);
            *(u32x2*)(yb + (size_t)token * 512 + h * 128 + sl * 32 + c8 * 4) = wv2;
        }
        lds_barrier();
    }
#undef RT_PREFETCH
}

__device__ void lru_item(const Params& p, int layer, int item, LAS unsigned char* Lb, const int wv_) {
    const int tid = TIDX, lane = tid & 63, w = tid >> 6;
    const int b = item >> 4, nb = (item >> 2) & 3, cs = item & 3;
    LAS bf16_t* Wt = (LAS bf16_t*)Lb;
    LAS bf16_t* xcb = (LAS bf16_t*)(Lb + 17408);
    LAS float* xcf = (LAS float*)(Lb + 34816);
    LAS float* pre = xcf + 2048;
    LAS float* aa = pre + 4096;
    LAS float* bbs = aa + 2048;
    LAS float* hs = bbs + 2048;
    const bf16_t* u = (const bf16_t*)(p.ws + WS_U); bf16_t* yc = (bf16_t*)(p.ws + WS_Y) + (size_t)2 * MTOK * 512;
    {
        const float* wa = p.lru_wa + ((size_t)layer * 4 + nb) * 128 * 128; const float* wx = p.lru_wx + ((size_t)layer * 4 + nb) * 128 * 128;
        for (int i = tid; i < 8192; i += 512) { const int k = i >> 6, j = i & 63; const float v = j < 32 ? wa[k * 128 + cs * 32 + j] : wx[k * 128 + cs * 32 + j - 32];
            Wt[j * 136 + k] = (bf16_t)(cvt_pk_bf16(v, 0.f) & 0xffffu); }
    }
    const int cp = tid & 63, tg = tid >> 6;
    const int cch = nb * 128 + 2 * cp;
    float cwa[4], cwb[4];
#pragma unroll
    for (int j = 0; j < 4; ++j) { cwa[j] = p.lru_conv_w[((size_t)layer * 4 + j) * 512 + cch]; cwb[j] = p.lru_conv_w[((size_t)layer * 4 + j) * 512 + cch + 1]; }
    const float cba = p.lru_conv_b[layer * 512 + cch], cbb = p.lru_conv_b[layer * 512 + cch + 1];
    const int ce = tid & 31, te = tid >> 5;
    const int och = nb * 128 + cs * 32 + ce;
    const float ba = p.lru_ba[layer * 512 + och], bx = p.lru_bx[layer * 512 + och], sp8 = 8.0f * softplusf_(-p.lru_lambda[layer * 512 + och]);
    const int tl8 = tid >> 3, c8 = tid & 7;
    float hcar = 0.f;
    unsigned rc[11]; u32x2 rgg;
#define LRU_PREFETCH(CH) do { const int t0_ = (CH) * 64 + tg * 8; const bf16_t* up_ = u + (size_t)(b * SEQ + t0_) * NU + 3584 + cch; \
        _Pragma("unroll") for (int i_ = 0; i_ < 11; ++i_) { rc[i_] = 0u; if (t0_ - 3 + i_ >= 0) rc[i_] = *(const unsigned*)(up_ + (ptrdiff_t)(i_ - 3) * NU); } \
        rgg = *(const u32x2*)(u + (size_t)(b * SEQ + (CH) * 64 + tl8) * NU + 4096 + nb * 128 + cs * 32 + c8 * 4); } while (0)
    LRU_PREFETCH(0);
    lds_barrier();
    for (int ch = 0; ch < 32; ++ch) {
        const u32x2 gr = rgg;
        {
            float xa[3] = {bflo(rc[0]), bflo(rc[1]), bflo(rc[2])}, xb_[3] = {bfhi(rc[0]), bfhi(rc[1]), bfhi(rc[2])};
#pragma unroll
            for (int i = 0; i < 8; ++i) {
                const float ca = bflo(rc[3 + i]), cb = bfhi(rc[3 + i]);
                const float ya_ = cwa[0] * xa[0] + cwa[1] * xa[1] + cwa[2] * xa[2] + cwa[3] * ca + cba, yb_ = cwb[0] * xb_[0] + cwb[1] * xb_[1] + cwb[2] * xb_[2] + cwb[3] * cb + cbb;
                const int tl = tg * 8 + i;
                *(LAS unsigned*)(xcb + tl * 136 + 2 * cp) = cvt_pk_bf16(ya_, yb_);
                if ((cp >> 4) == cs) *(LAS f32x2*)(xcf + tl * 32 + ((2 * cp) & 31)) = (f32x2){ya_, yb_};
                xa[0] = xa[1]; xa[1] = xa[2]; xa[2] = ca; xb_[0] = xb_[1]; xb_[1] = xb_[2]; xb_[2] = cb;
            }
        }
        if (ch + 1 < 32) LRU_PREFETCH(ch + 1);
        lds_barrier();
        {
            const int mt = w & 3, ntb = (w >> 2) * 2, r16 = lane & 15, kq = lane >> 4;
#pragma unroll
            for (int q = 0; q < 2; ++q) {
                const int ntile = ntb + q; f32x4 acc = (f32x4){0.f, 0.f, 0.f, 0.f};
#pragma unroll
                for (int kk = 0; kk < 4; ++kk) {
                    const bf16x8 af = *(const LAS bf16x8*)(xcb + (mt * 16 + r16) * 136 + kk * 32 + kq * 8);
                    const bf16x8 bf = *(const LAS bf16x8*)(Wt + (ntile * 16 + r16) * 136 + kk * 32 + kq * 8);
                    acc = __builtin_amdgcn_mfma_f32_16x16x32_bf16(af, bf, acc, 0, 0, 0);
                }
#pragma unroll
                for (int j = 0; j < 4; ++j) pre[(mt * 16 + kq * 4 + j) * 64 + ntile * 16 + r16] = acc[j];
            }
        }
        lds_barrier();
#pragma unroll
        for (int i = 0; i < 4; ++i) {
            const int tl = te * 4 + i;
            const float r = sigmoidf_(pre[tl * 64 + ce] + ba), ig = sigmoidf_(pre[tl * 64 + 32 + ce] + bx);
            const float la = -r * sp8; const float a = __expf(la); const float mult = sqrtf(fmaxf(-expm1f(2.0f * la), 0.f));
            aa[tl * 32 + ce] = a; bbs[tl * 32 + ce] = mult * ig * xcf[tl * 32 + ce];
        }
        lds_barrier();
        if (tid < 32) {
#pragma unroll 8
            for (int tl = 0; tl < 64; ++tl) { hcar = aa[tl * 32 + tid] * hcar + bbs[tl * 32 + tid]; hs[tl * 32 + tid] = hcar; }
        }
        lds_barrier();
        {
            const int token = b * SEQ + ch * 64 + tl8;
            const f32x4 h4 = *(LAS f32x4*)(hs + tl8 * 32 + c8 * 4);
            u32x2 wv_; wv_.x = cvt_pk_bf16(h4[0] * gelu_tanh(bflo(gr.x)), h4[1] * gelu_tanh(bfhi(gr.x))); wv_.y = cvt_pk_bf16(h4[2] * gelu_tanh(bflo(gr.y)), h4[3] * gelu_tanh(bfhi(gr.y)));
            *(u32x2*)(yc + (size_t)token * 512 + nb * 128 + cs * 32 + c8 * 4) = wv_;
        }
    }
    lds_barrier();
}

__device__ void finalize_y(const Params& p, const int wv_) {
    const bf16_t* u = (const bf16_t*)(p.ws + WS_U); const float* sta = (const float*)(p.ws + WS_STA); const float* stb = (const float*)(p.ws + WS_STB);
    bf16_t* ya = (bf16_t*)(p.ws + WS_Y); bf16_t* yb = ya + (size_t)MTOK * 512;
    const int t_ = TIDX;
    for (int i0 = blockIdx.x * 512; i0 < MTOK * 128; i0 += gridDim.x * 512) {
        const int i = i0 + t_; const int token = i >> 7, v = i & 127;
        if (v < 64) {
            const int chn = v * 8, h = chn >> 7;
            const f32x4 s = *(const f32x4*)(sta + ((size_t)token * 4 + h) * 4);
            const float sc = rsqrtf(((s[0] + s[1]) + (s[2] + s[3])) * (1.0f / 128.0f) + EPS);
            u32x4* yp = (u32x4*)(ya + (size_t)token * 512 + chn); const u32x4 r = *yp; u32x4 o;
            o.x = cvt_pk_bf16(bflo(r.x) * sc, bfhi(r.x) * sc); o.y = cvt_pk_bf16(bflo(r.y) * sc, bfhi(r.y) * sc); o.z = cvt_pk_bf16(bflo(r.z) * sc, bfhi(r.z) * sc); o.w = cvt_pk_bf16(bflo(r.w) * sc, bfhi(r.w) * sc);
            *yp = o;
        } else {
            const int chn = (v - 64) * 8, h = chn >> 7;
            const f32x4 sA = *(const f32x4*)(stb + ((size_t)token * 4 + h) * 8), sB = *(const f32x4*)(stb + ((size_t)token * 4 + h) * 8 + 4);
            const float mu = ((sA[0] + sA[2]) + (sB[0] + sB[2])) * (1.0f / 128.0f), ex2 = ((sA[1] + sA[3]) + (sB[1] + sB[3])) * (1.0f / 128.0f);
            const float rstd = rsqrtf(fmaxf(ex2 - mu * mu, 0.f) + EPS);
            u32x4* yp = (u32x4*)(yb + (size_t)token * 512 + chn); const u32x4 r = *yp; const u32x4 g = *(const u32x4*)(u + (size_t)token * NU + 3072 + chn); u32x4 o;
            o.x = cvt_pk_bf16((bflo(r.x) - mu) * rstd * siluf_(bflo(g.x)), (bfhi(r.x) - mu) * rstd * siluf_(bfhi(g.x)));
            o.y = cvt_pk_bf16((bflo(r.y) - mu) * rstd * siluf_(bflo(g.y)), (bfhi(r.y) - mu) * rstd * siluf_(bfhi(g.y)));
            o.z = cvt_pk_bf16((bflo(r.z) - mu) * rstd * siluf_(bflo(g.z)), (bfhi(r.z) - mu) * rstd * siluf_(bfhi(g.z)));
            o.w = cvt_pk_bf16((bflo(r.w) - mu) * rstd * siluf_(bflo(g.w)), (bfhi(r.w) - mu) * rstd * siluf_(bfhi(g.w)));
            *yp = o;
        }
    }
}
__device__ void ffn_fixup(const Params& p, int layer, const int wv_) {
    const float* side = (const float*)(p.ws + WS_Y); bf16_t* act = (bf16_t*)(p.ws + WS_U);
    const float* cw = p.ffn_conv_w + (size_t)layer * 3 * NUP; const float* cb = p.ffn_conv_b + (size_t)layer * NUP;
    const int t_ = TIDX;
    for (int i0 = blockIdx.x * 512; i0 < 512 * DFF; i0 += gridDim.x * 512) {
        const int i = i0 + t_; const int blk = i / DFF, chn = i - blk * DFF;
        if ((blk & 31) == 0) continue;
        const float* s0 = side + (size_t)blk * 4 * NUP; const float* sm = side + (size_t)(blk - 1) * 4 * NUP;
        const float g0 = s0[chn], g1 = s0[NUP + chn], gm2 = sm[2 * NUP + chn], gm1 = sm[3 * NUP + chn];
        const float v0 = s0[DFF + chn], v1 = s0[NUP + DFF + chn], vm2 = sm[2 * NUP + DFF + chn], vm1 = sm[3 * NUP + DFF + chn];
        const float wg0 = cw[chn], wg1 = cw[NUP + chn], wg2 = cw[2 * NUP + chn], bg = cb[chn];
        const float wv0 = cw[DFF + chn], wv1 = cw[NUP + DFF + chn], wv2 = cw[2 * NUP + DFF + chn], bv = cb[DFF + chn];
        const float pg0 = wg2 * g0 + wg1 * gm1 + wg0 * gm2 + bg, pg1 = wg2 * g1 + wg1 * g0 + wg0 * gm1 + bg;
        const float pv0 = wv2 * v0 + wv1 * vm1 + wv0 * vm2 + bv, pv1 = wv2 * v1 + wv1 * v0 + wv0 * vm1 + bv;
        act[(size_t)(blk * 64) * DFF + chn] = (bf16_t)(cvt_pk_bf16(siluf_(pg0) * pv0, 0.f) & 0xffffu);
        act[(size_t)(blk * 64 + 1) * DFF + chn] = (bf16_t)(cvt_pk_bf16(siluf_(pg1) * pv1, 0.f) & 0xffffu);
    }
}
__device__ void final_norm(const Params& p, const int wv_) {
    const float* rowsq = (const float*)(p.ws + WS_ROWSQ + MiB);
    const int t_ = TIDX;
    for (int i0 = blockIdx.x * 512; i0 < MTOK * 256; i0 += gridDim.x * 512) {
        const int i = i0 + t_; const int row = i >> 8, c = (i & 255) * 4; const float rs = row_rs(rowsq, row);
        const f32x4 g = *(const f32x4*)(p.final_norm + c); f32x4* xp = (f32x4*)(p.out + (size_t)row * DM + c);
        *xp = *xp * rs * g;
    }
}


__device__ __forceinline__ void grid_bar(unsigned* cnt, unsigned target, const int wv_) {
    asm volatile("s_waitcnt vmcnt(0) lgkmcnt(0)" ::: "memory");
    __syncthreads();
    if (wv_ == 0) {
        __builtin_amdgcn_fence(__ATOMIC_RELEASE, "agent");
        asm volatile("s_waitcnt vmcnt(0)" ::: "memory");
        if (lane_fresh() == 0) __hip_atomic_fetch_add(cnt, 1u, __ATOMIC_RELAXED, __HIP_MEMORY_SCOPE_AGENT);
        while ((unsigned)__builtin_amdgcn_readfirstlane((int)__hip_atomic_load(cnt, __ATOMIC_RELAXED, __HIP_MEMORY_SCOPE_AGENT)) < target) __builtin_amdgcn_s_sleep(1);
        __builtin_amdgcn_fence(__ATOMIC_ACQUIRE, "agent");
        asm volatile("s_waitcnt vmcnt(0)" ::: "memory");
    }
    __syncthreads();
}

#ifndef TIMING_DUP
#define TIMING_DUP 0
#endif
#ifndef STOP_AT
#define STOP_AT 0
#endif
#define STOP_L 0
__device__ void dump_bf16(const Params& p, const bf16_t* src, int ld, int col0, const int wv_) {
    const int t_ = TIDX;
    for (int i0 = blockIdx.x * 512; i0 < MTOK * 128; i0 += gridDim.x * 512) {
        const int i = i0 + t_; const int row = i >> 7, c = (i & 127) * 8;
        const u32x4 r = *(const u32x4*)(src + (size_t)row * ld + col0 + (c % ld));
        float* o = p.out + (size_t)row * DM + c;
        *(f32x4*)o = (f32x4){bflo(r.x), bfhi(r.x), bflo(r.y), bfhi(r.y)}; *(f32x4*)(o + 4) = (f32x4){bflo(r.z), bfhi(r.z), bflo(r.w), bfhi(r.w)};
    }
}
__global__ void __launch_bounds__(512, 2) mega(Params kp) {
    extern __shared__ __attribute__((aligned(16))) unsigned char smem[];
    LAS unsigned char* lds = (LAS unsigned char*)smem;
    cg::grid_group grid = cg::this_grid();
    const int G = gridDim.x, c = blockIdx.x;
    const int wv_ = __builtin_amdgcn_readfirstlane((int)threadIdx.x >> 6);
    if (threadIdx.x == 0) stp(lds, kp);
    if (c == 0 && threadIdx.x == 0) __hip_atomic_store((unsigned*)(kp.ws + WS_BAR), 0u, __ATOMIC_RELAXED, __HIP_MEMORY_SCOPE_AGENT);
    __syncthreads();
    grid.sync();
    int nbar = 0;
#define WSP(p_, off) ((p_).ws + (off))
    {
        const Params p = ldp(lds);
        rownorm(p, p.x, (float*)WSP(p, WS_ROWSQ + MiB), wv_);
        rot_table(p, wv_);
        prep_layer_main(p, 0, (LAS float*)lds, wv_);
        prep_layer_down(p, 0, (LAS float*)lds, wv_);
    }
    { const Params p = ldp(lds); grid_bar((unsigned*)WSP(p, WS_BAR), (unsigned)(++nbar) * (unsigned)G, wv_); if (TIMING_DUP == 6) grid_bar((unsigned*)WSP(p, WS_BAR), (unsigned)(++nbar) * (unsigned)G, wv_); }

    for (int l = 0; l < DEPTH; ++l) {
        {
            const Params p = ldp(lds);
            StaticOrder S; S.init(WSP(p, WS_XB), (bf16_t*)WSP(p, WS_W) + W_IN, MTOK, NU, 1024, G, c);
            EpiScale<0> E; E.O = (bf16_t*)WSP(p, WS_U); E.ldc = NU; E.rowsq = (const float*)WSP(p, WS_ROWSQ + MiB);
            for (int rep = 0; rep < ((TIMING_DUP == 5) ? 2 + __builtin_amdgcn_readfirstlane(opaque0()) : 1); ++rep)
            gemm_phase(lds, 1024, S, E, wv_);
        }
        { const Params p = ldp(lds); ab_tail(p, wv_); u0_tail(p, l, (LAS float*)lds, wv_); }
        { const Params p = ldp(lds); grid_bar((unsigned*)WSP(p, WS_BAR), (unsigned)(++nbar) * (unsigned)G, wv_); if (TIMING_DUP == 6) grid_bar((unsigned*)WSP(p, WS_BAR), (unsigned)(++nbar) * (unsigned)G, wv_); }
        if (STOP_AT == 1 && l == STOP_L) { const Params p = ldp(lds); dump_bf16(p, (const bf16_t*)WSP(p, WS_U), NU, 0, wv_); return; }
        {
            const int Gh = G >> 1;
            if (c < Gh) { const Params p = ldp(lds); for (int it = c; it < 128; it += Gh) deltanet_item(p, l, it, lds, wv_); }
            else {
                { const Params p = ldp(lds); for (int it = c - Gh; it < 256; it += G - Gh) retention_item(p, it, lds, wv_); }
                { const Params p = ldp(lds); for (int it = c - Gh; it < 256; it += G - Gh) lru_item(p, l, it, lds, wv_); }
                if (l > 0) { const Params p = ldp(lds); prep_layer_down(p, l, (LAS float*)lds, wv_, G - Gh, c - Gh); }
                if (l + 1 < DEPTH) { const Params p = ldp(lds); prep_layer_main(p, l + 1, (LAS float*)lds, wv_, 1, G - Gh, c - Gh); }
            }
        }
        { const Params p = ldp(lds); grid_bar((unsigned*)WSP(p, WS_BAR), (unsigned)(++nbar) * (unsigned)G, wv_); if (TIMING_DUP == 6) grid_bar((unsigned*)WSP(p, WS_BAR), (unsigned)(++nbar) * (unsigned)G, wv_); }
        if (STOP_AT == 2 && l == STOP_L) { const Params p = ldp(lds); dump_bf16(p, (const bf16_t*)WSP(p, WS_Y) + (size_t)2 * MTOK * 512, 512, 0, wv_); return; }
        if (STOP_AT == 12 && l == STOP_L) { const Params p = ldp(lds); dump_bf16(p, (const bf16_t*)WSP(p, WS_Y), 512, 0, wv_); return; }
        if (STOP_AT == 13 && l == STOP_L) { const Params p = ldp(lds); dump_bf16(p, (const bf16_t*)WSP(p, WS_Y) + (size_t)MTOK * 512, 512, 0, wv_); return; }
        {
            const Params p = ldp(lds);
            finalize_y(p, wv_);
        }
        { const Params p = ldp(lds); grid_bar((unsigned*)WSP(p, WS_BAR), (unsigned)(++nbar) * (unsigned)G, wv_); if (TIMING_DUP == 6) grid_bar((unsigned*)WSP(p, WS_BAR), (unsigned)(++nbar) * (unsigned)G, wv_); }
        if (STOP_AT == 3 && l == STOP_L) { const Params p = ldp(lds); dump_bf16(p, (const bf16_t*)WSP(p, WS_Y), 512, 0, wv_); return; }
        {
            const Params p = ldp(lds);
            StaticOrder S; S.init(WSP(p, WS_XB), (bf16_t*)WSP(p, WS_W) + W_G, MTOK, NG, 1024, G, c);
            EpiScale<1> E; E.O = (bf16_t*)WSP(p, WS_U); E.ldc = NG; E.rowsq = (const float*)WSP(p, WS_ROWSQ + MiB);
            for (int rep = 0; rep < ((TIMING_DUP == 5) ? 2 + __builtin_amdgcn_readfirstlane(opaque0()) : 1); ++rep)
            gemm_phase(lds, 1024, S, E, wv_);
        }
        { const Params p = ldp(lds); grid_bar((unsigned*)WSP(p, WS_BAR), (unsigned)(++nbar) * (unsigned)G, wv_); if (TIMING_DUP == 6) grid_bar((unsigned*)WSP(p, WS_BAR), (unsigned)(++nbar) * (unsigned)G, wv_); }
        if (STOP_AT == 4 && l == STOP_L) { const Params p = ldp(lds); dump_bf16(p, (const bf16_t*)WSP(p, WS_U), NG, 0, wv_); return; }
        {
            const Params p = ldp(lds);
            BranchOrder S; S.Y = (const char*)WSP(p, WS_Y); S.Wb = (const char*)((bf16_t*)WSP(p, WS_W) + W_B); S.G = G; S.c = c;
            EpiMerge E; E.gates = (const bf16_t*)WSP(p, WS_U); E.scratch = (float*)WSP(p, WS_XB) + (size_t)c * 65536; E.merged = (bf16_t*)WSP(p, WS_U + 192 * MiB);
            gemm_phase(lds, 512, S, E, wv_);
        }
        { const Params p = ldp(lds); grid_bar((unsigned*)WSP(p, WS_BAR), (unsigned)(++nbar) * (unsigned)G, wv_); if (TIMING_DUP == 6) grid_bar((unsigned*)WSP(p, WS_BAR), (unsigned)(++nbar) * (unsigned)G, wv_); }
        if (STOP_AT == 5 && l == STOP_L) { const Params p = ldp(lds); dump_bf16(p, (const bf16_t*)WSP(p, WS_U + 192 * MiB), DM, 0, wv_); return; }
        {
            const Params p = ldp(lds);
            StaticOrder S; S.init(WSP(p, WS_U + 192 * MiB), (bf16_t*)WSP(p, WS_W) + W_O, MTOK, DM, 1024, G, c);
            EpiResid E; E.xin = (l == 0) ? p.x : p.out; E.xout = p.out; E.xb = (bf16_t*)WSP(p, WS_XB); E.rowsq = (float*)WSP(p, WS_ROWSQ); E.ex = (LAS float*)(lds + 131072);
            gemm_phase(lds, 1024, S, E, wv_);
        }
        { const Params p = ldp(lds); grid_bar((unsigned*)WSP(p, WS_BAR), (unsigned)(++nbar) * (unsigned)G, wv_); if (TIMING_DUP == 6) grid_bar((unsigned*)WSP(p, WS_BAR), (unsigned)(++nbar) * (unsigned)G, wv_); }
        if (STOP_AT == 6 && l == STOP_L) return;
        {
            const Params p = ldp(lds);
            StaticOrder S; S.init(WSP(p, WS_XB), (bf16_t*)WSP(p, WS_W) + W_UP, MTOK, NUP, 1024, G, c);
            EpiFfn E; E.act = (bf16_t*)WSP(p, WS_U); E.rowsq = (const float*)WSP(p, WS_ROWSQ); E.cw = p.ffn_conv_w + (size_t)l * 3 * NUP; E.cb = p.ffn_conv_b + (size_t)l * NUP; E.side = (float*)WSP(p, WS_Y);
            for (int rep = 0; rep < ((TIMING_DUP == 5) ? 2 + __builtin_amdgcn_readfirstlane(opaque0()) : 1); ++rep)
            gemm_phase(lds, 1024, S, E, wv_);
        }
        { const Params p = ldp(lds); grid_bar((unsigned*)WSP(p, WS_BAR), (unsigned)(++nbar) * (unsigned)G, wv_); if (TIMING_DUP == 6) grid_bar((unsigned*)WSP(p, WS_BAR), (unsigned)(++nbar) * (unsigned)G, wv_); }
        {
            const Params p = ldp(lds);
            ffn_fixup(p, l, wv_);
        }
        if (l + 1 < DEPTH) { const Params p = ldp(lds); prep_layer_main(p, l + 1, (LAS float*)lds, wv_, 2); }
        { const Params p = ldp(lds); grid_bar((unsigned*)WSP(p, WS_BAR), (unsigned)(++nbar) * (unsigned)G, wv_); if (TIMING_DUP == 6) grid_bar((unsigned*)WSP(p, WS_BAR), (unsigned)(++nbar) * (unsigned)G, wv_); }
        if (STOP_AT == 7 && l == STOP_L) { const Params p = ldp(lds); dump_bf16(p, (const bf16_t*)WSP(p, WS_U), DFF, 0, wv_); return; }
        {
            const Params p = ldp(lds);
            StaticOrder S; S.init(WSP(p, WS_U), (bf16_t*)WSP(p, WS_W) + W_DN, MTOK, DM, DFF, G, c);
            EpiResid E; E.xin = p.out; E.xout = p.out; E.xb = (bf16_t*)WSP(p, WS_XB); E.rowsq = (float*)WSP(p, WS_ROWSQ + MiB); E.ex = (LAS float*)(lds + 131072);
            gemm_phase(lds, DFF, S, E, wv_);
        }
        { const Params p = ldp(lds); grid_bar((unsigned*)WSP(p, WS_BAR), (unsigned)(++nbar) * (unsigned)G, wv_); if (TIMING_DUP == 6) grid_bar((unsigned*)WSP(p, WS_BAR), (unsigned)(++nbar) * (unsigned)G, wv_); }
        if (STOP_AT == 8 && l == STOP_L) return;
        if (STOP_AT == 10 && l == STOP_L) { const Params p = ldp(lds); dump_bf16(p, (const bf16_t*)WSP(p, WS_XB), DM, 0, wv_); return; }
        if (STOP_AT == 11 && l == STOP_L) { const Params p = ldp(lds); dump_bf16(p, (const bf16_t*)WSP(p, WS_W) + W_IN, 1024, 0, wv_); return; }
        if (STOP_AT == 9 && l == STOP_L) { const Params p = ldp(lds); const float* rq = (const float*)WSP(p, WS_ROWSQ + MiB); const int t_ = TIDX; for (int i0 = c * 512; i0 < MTOK * 256; i0 += G * 512) { const int i = i0 + t_; const float v = rq[i >> 8]; *(f32x4*)(p.out + (size_t)i * 4) = (f32x4){v, v, v, v}; } return; }
    }
    { const Params p = ldp(lds); final_norm(p, wv_); }
}

constexpr int LDS_BYTES = 163328 + 256;
extern "C" void kernel_launch(void* const* d_in, const int* in_sizes, int n_in, void* d_out, int out_size, void* d_ws, size_t ws_size, hipStream_t stream) {
    static int grid = 0;
    if (grid == 0) {
        int dev = 0, cus = 0, per_cu = 0;
        hipGetDevice(&dev);
        hipDeviceGetAttribute(&cus, hipDeviceAttributeMultiprocessorCount, dev);
        if (hipFuncSetAttribute((const void*)mega, hipFuncAttributeMaxDynamicSharedMemorySize, LDS_BYTES) != hipSuccess) fprintf(stderr, "kernel_launch: hipFuncSetAttribute failed\n");
        hipOccupancyMaxActiveBlocksPerMultiprocessor(&per_cu, (const void*)mega, 512, LDS_BYTES);
        (void)hipGetLastError();
        if (per_cu < 1) per_cu = 1;
        grid = cus * 1;
        if (grid > 256) grid = 256;
        if (ws_size < 496 * MiB) fprintf(stderr, "kernel_launch: workspace too small: %zu\n", ws_size);
    }
    Params p{};
    p.x = (const float*)d_in[0]; p.pos = (const int*)d_in[1]; p.attn_norm = (const float*)d_in[2]; p.w_in = (const float*)d_in[3]; p.dn_conv_w = (const float*)d_in[4];
    p.dn_a_log = (const float*)d_in[5]; p.dn_dt_bias = (const float*)d_in[6]; p.dn_norm_w = (const float*)d_in[7]; p.lru_conv_w = (const float*)d_in[8]; p.lru_conv_b = (const float*)d_in[9];
    p.lru_wa = (const float*)d_in[10]; p.lru_ba = (const float*)d_in[11]; p.lru_wx = (const float*)d_in[12]; p.lru_bx = (const float*)d_in[13]; p.lru_lambda = (const float*)d_in[14];
    p.w_branch = (const float*)d_in[15]; p.w_out = (const float*)d_in[16]; p.ffn_norm = (const float*)d_in[17]; p.w_up = (const float*)d_in[18]; p.ffn_conv_w = (const float*)d_in[19];
    p.ffn_conv_b = (const float*)d_in[20]; p.w_down = (const float*)d_in[21]; p.final_norm = (const float*)d_in[22];
    p.out = (float*)d_out; p.ws = (unsigned char*)d_ws;
    (void)hipMemsetAsync((unsigned char*)d_ws + WS_BAR, 0, 256, stream);
    void* args[] = {&p};
    hipError_t e = hipLaunchCooperativeKernel((const void*)mega, dim3(grid), dim3(512), args, LDS_BYTES, stream);
    if (e != hipSuccess) fprintf(stderr, "cooperative launch failed: %s (grid %d)\n", hipGetErrorString(e), grid);
}
```

```cpp
#include <hip/hip_runtime.h>
#include <hip/hip_cooperative_groups.h>
#include <cstdio>
#include <cstdint>
namespace cg = cooperative_groups;

#define LAS __attribute__((address_space(3)))
typedef unsigned short bf16_t;
typedef short bf16x8 __attribute__((ext_vector_type(8)));
typedef float f32x4 __attribute__((ext_vector_type(4)));
typedef float f32x2 __attribute__((ext_vector_type(2)));
typedef unsigned u32x4 __attribute__((ext_vector_type(4)));
typedef unsigned u32x2 __attribute__((ext_vector_type(2)));

constexpr int MTOK = 32768, DM = 1024, SEQ = 2048, NU = 4608, NG = 3072, NIN = 7688, DFF = 2816, NUP = 5632, DEPTH = 4;
constexpr float EPS = 1e-6f;
constexpr size_t MiB = 1u << 20;
constexpr size_t WS_ROWSQ = 0;
constexpr size_t WS_AB = 2 * MiB;
constexpr size_t WS_STA = 3 * MiB;
constexpr size_t WS_STB = 5 * MiB;
constexpr size_t WS_WAB = 9 * MiB;
constexpr size_t WS_BAR = 9 * MiB + 65536;
constexpr size_t WS_U0 = 9 * MiB + 131072;
constexpr size_t WS_XB = 10 * MiB;
constexpr size_t WS_W = 74 * MiB;
constexpr size_t WS_U = 112 * MiB;
constexpr size_t WS_ROT = 496 * MiB;
constexpr size_t WS_Y = 400 * MiB;
constexpr size_t W_IN = 0, W_G = W_IN + (size_t)NU * 1024, W_B = W_G + (size_t)NG * 1024, W_O = W_B + (size_t)3 * 1024 * 512,
                 W_UP = W_O + (size_t)1024 * 1024, W_DN = W_UP + (size_t)NUP * 1024;

struct Params {
    const float* x; const int* pos; const float* attn_norm; const float* w_in; const float* dn_conv_w; const float* dn_a_log; const float* dn_dt_bias; const float* dn_norm_w;
    const float* lru_conv_w; const float* lru_conv_b; const float* lru_wa; const float* lru_ba; const float* lru_wx; const float* lru_bx; const float* lru_lambda;
    const float* w_branch; const float* w_out; const float* ffn_norm; const float* w_up; const float* ffn_conv_w; const float* ffn_conv_b; const float* w_down; const float* final_norm;
    float* out; unsigned char* ws;
};


__device__ __forceinline__ int opaque0() { int z; asm volatile("v_mov_b32 %0, 0" : "=v"(z)); return z; }
constexpr int LDS_PARAMS = 163328;
__device__ __forceinline__ const void* ldptr(LAS const unsigned* lp, int i) {
    const unsigned lo = __builtin_amdgcn_readfirstlane(lp[2 * i]), hi = __builtin_amdgcn_readfirstlane(lp[2 * i + 1]);
    typedef const __attribute__((address_space(1))) unsigned char* gptr_t;
    return (const void*)(gptr_t)(((unsigned long long)hi << 32) | lo);
}
__device__ __forceinline__ Params ldp(LAS const unsigned char* ldsbase) {
    LAS const unsigned* lp = (LAS const unsigned*)(ldsbase + LDS_PARAMS + opaque0());
    Params p;
    p.x = (const float*)ldptr(lp, 0); p.pos = (const int*)ldptr(lp, 1); p.attn_norm = (const float*)ldptr(lp, 2); p.w_in = (const float*)ldptr(lp, 3); p.dn_conv_w = (const float*)ldptr(lp, 4);
    p.dn_a_log = (const float*)ldptr(lp, 5); p.dn_dt_bias = (const float*)ldptr(lp, 6); p.dn_norm_w = (const float*)ldptr(lp, 7); p.lru_conv_w = (const float*)ldptr(lp, 8); p.lru_conv_b = (const float*)ldptr(lp, 9);
    p.lru_wa = (const float*)ldptr(lp, 10); p.lru_ba = (const float*)ldptr(lp, 11); p.lru_wx = (const float*)ldptr(lp, 12); p.lru_bx = (const float*)ldptr(lp, 13); p.lru_lambda = (const float*)ldptr(lp, 14);
    p.w_branch = (const float*)ldptr(lp, 15); p.w_out = (const float*)ldptr(lp, 16); p.ffn_norm = (const float*)ldptr(lp, 17); p.w_up = (const float*)ldptr(lp, 18); p.ffn_conv_w = (const float*)ldptr(lp, 19);
    p.ffn_conv_b = (const float*)ldptr(lp, 20); p.w_down = (const float*)ldptr(lp, 21); p.final_norm = (const float*)ldptr(lp, 22); p.out = (float*)ldptr(lp, 23); p.ws = (unsigned char*)ldptr(lp, 24);
    return p;
}
__device__ __forceinline__ void stp(LAS unsigned char* ldsbase, const Params& p) {
    LAS unsigned long long* lp = (LAS unsigned long long*)(ldsbase + LDS_PARAMS);
    lp[0] = (unsigned long long)p.x; lp[1] = (unsigned long long)p.pos; lp[2] = (unsigned long long)p.attn_norm; lp[3] = (unsigned long long)p.w_in; lp[4] = (unsigned long long)p.dn_conv_w;
    lp[5] = (unsigned long long)p.dn_a_log; lp[6] = (unsigned long long)p.dn_dt_bias; lp[7] = (unsigned long long)p.dn_norm_w; lp[8] = (unsigned long long)p.lru_conv_w; lp[9] = (unsigned long long)p.lru_conv_b;
    lp[10] = (unsigned long long)p.lru_wa; lp[11] = (unsigned long long)p.lru_ba; lp[12] = (unsigned long long)p.lru_wx; lp[13] = (unsigned long long)p.lru_bx; lp[14] = (unsigned long long)p.lru_lambda;
    lp[15] = (unsigned long long)p.w_branch; lp[16] = (unsigned long long)p.w_out; lp[17] = (unsigned long long)p.ffn_norm; lp[18] = (unsigned long long)p.w_up; lp[19] = (unsigned long long)p.ffn_conv_w;
    lp[20] = (unsigned long long)p.ffn_conv_b; lp[21] = (unsigned long long)p.w_down; lp[22] = (unsigned long long)p.final_norm; lp[23] = (unsigned long long)p.out; lp[24] = (unsigned long long)p.ws;
}
__device__ __forceinline__ int lane_fresh() { int l; asm volatile("v_mbcnt_lo_u32_b32 %0, -1, 0\n\tv_mbcnt_hi_u32_b32 %0, -1, %0" : "=&v"(l)); return l; }
#define TIDX ((wv_ << 6) + lane_fresh())
__device__ __forceinline__ float opaque0_after(float dep) { float z; asm volatile("v_mov_b32 %0, 0" : "=v"(z) : "v"(dep)); return z; }
__device__ __forceinline__ float bflo(unsigned u) { return __uint_as_float(u << 16); }
__device__ __forceinline__ float bfhi(unsigned u) { return __uint_as_float(u & 0xffff0000u); }
typedef __bf16 bf16x2_t __attribute__((ext_vector_type(2)));
__device__ __forceinline__ unsigned cvt_pk_bf16(float lo, float hi) { const f32x2 v = {lo, hi}; return __builtin_bit_cast(unsigned, __builtin_convertvector(v, bf16x2_t)); }
__device__ __forceinline__ float sigmoidf_(float x) { return __builtin_amdgcn_rcpf(1.f + __expf(-x)); }
__device__ __forceinline__ float siluf_(float x) { return x * __builtin_amdgcn_rcpf(1.f + __expf(-x)); }
__device__ __forceinline__ float softplusf_(float x) { return fmaxf(x, 0.f) + log1pf(__expf(-fabsf(x))); }
__device__ __forceinline__ float gelu_tanh(float x) { const float u = 0.7978845608028654f * (x + 0.044715f * x * x * x); return x * __builtin_amdgcn_rcpf(1.f + __expf(-2.f * u)); }
template <int CTRL> __device__ __forceinline__ float dppmov(float v) { return __int_as_float(__builtin_amdgcn_update_dpp(0, __float_as_int(v), CTRL, 0xf, 0xf, true)); }
__device__ __forceinline__ float allreduce16(float x) {
    x += dppmov<0xB1>(x); x += dppmov<0x4E>(x); x += dppmov<0x141>(x); x += dppmov<0x140>(x); return x;
}
__device__ __forceinline__ float row_rs(const float* rowsq, int row) { const f32x4 q = *(const f32x4*)(rowsq + (size_t)row * 4); return rsqrtf(((q[0] + q[1]) + (q[2] + q[3])) * (1.0f / 1024.0f) + EPS); }

constexpr int BM = 256, BK = 64, HALF = 128, HTB = HALF * BK * 2, STAGE_BYTES = 8 * HTB, NXCD = 8, WGM = 8;
__device__ __forceinline__ int lds_byte(int r, int c) { const int st = (r >> 4) * 2 + (c >> 5), rr = r & 15, cc = c & 31, ob = rr * 64 + cc * 2; return st * 1024 + (ob ^ (((ob >> 9) & 1) << 5)); }
__device__ __forceinline__ void stage_rc(int b, int& R, int& C) { const int st = b / 1024, sb = b % 1024, swz = sb ^ (((sb >> 9) & 1) << 5); R = (st >> 1) * 16 + swz / 64; C = (st & 1) * 32 + (swz % 64) / 2; }
__device__ __forceinline__ int perm32(int rho) { const int n = rho >> 4, i = rho & 15; return 8 * (i >> 2) + 4 * n + (i & 3); }
struct Unit { int pm, pn, aux; };

struct StaticOrder {
    const char* A; const char* B; int nM, nN, nwg, G, c; size_t tstep;
    __device__ void init(const void* A_, const void* B_, int M, int N, int K, int G_, int c_) { A = (const char*)A_; B = (const char*)B_; nM = M / BM; nN = N / BM; nwg = nM * nN; G = G_; c = c_; tstep = (size_t)BM * K * 2; }
    __device__ __forceinline__ bool next(int i, Unit& u) const {
        const long L = (long)i * G + c; if (L >= nwg) return false;
        int wgid = (int)L; { const int q = nwg / NXCD, r = nwg % NXCD, xcd = wgid % NXCD, off = wgid / NXCD; wgid = (xcd < r ? xcd * (q + 1) : r * (q + 1) + (xcd - r) * q) + off; }
        const int nig = WGM * nN, gid = wgid / nig, fm = gid * WGM, gsz = (nM - fm) < WGM ? (nM - fm) : WGM;
        u.pm = fm + ((wgid % nig) % gsz); u.pn = (wgid % nig) / gsz; u.aux = 0; return true;
    }
    __device__ __forceinline__ void ptrs(const Unit& u, const char*& a, const char*& b) const { a = A + (size_t)u.pm * tstep; b = B + (size_t)u.pn * tstep; }
};
struct BranchOrder {
    const char* Y; const char* Wb; int G, c;
    __device__ __forceinline__ bool next(int i, Unit& u) const {
        const int tile = c + G * (i / 3); if (tile >= 512) return false;
        u.pm = tile >> 2; u.pn = tile & 3; u.aux = i % 3; return true;
    }
    __device__ __forceinline__ void ptrs(const Unit& u, const char*& a, const char*& b) const {
        a = Y + (size_t)u.aux * ((size_t)MTOK * 512 * 2) + (size_t)u.pm * (256 * 512 * 2);
        b = Wb + (size_t)u.aux * ((size_t)1024 * 512 * 2) + (size_t)u.pn * (256 * 512 * 2);
    }
};

template <class Epi, class Sched>
__device__ __forceinline__ void gemm_phase(LAS unsigned char* lds, const int K, const Sched& S, const Epi& E, const int wv_) {
    const int tid = TIDX, wid = __builtin_amdgcn_readfirstlane(tid >> 6), lane = tid & 63, wr = wid >> 2, wc = wid & 3, fr = lane & 15, fq = lane >> 4;
    const int nt = K / BK;
    unsigned voffA[2], voffB[2];
#pragma unroll
    for (int i = 0; i < 2; ++i) { int R, C; stage_rc(tid * 16 + i * 8192, R, C); const int Rb = Epi::PERM ? ((R & ~31) + perm32(R & 31)) : R;
        voffA[i] = (unsigned)(R * K + C) * 2u; voffB[i] = (unsigned)(Rb * K + C) * 2u; }
    const size_t kstep = (size_t)(BK * 2);
    const size_t hstep = (size_t)HALF * K * 2;
    const unsigned ldsw = (unsigned)wid * 1024u;
    const int aoff = lds_byte(wr * 64 + fr, fq * 8), boff = lds_byte(wc * 32 + fr, fq * 8);
#define PG8_SA(b, h) (((b) * 2 + (h)) * HTB)
#define PG8_SB(b, h) ((4 + (b) * 2 + (h)) * HTB)
#define PG8_STAGE(bufoff, gbase, voff) do { _Pragma("unroll") for (int _i = 0; _i < 2; ++_i) \
        __builtin_amdgcn_global_load_lds((const unsigned*)((const char*)(gbase) + (voff)[_i]), (LAS unsigned*)(lds + (bufoff) + ldsw + _i * 8192), 16, 0, 0); } while (0)
#define PG8_LDA(dst, b, h) do { _Pragma("unroll") for (int m = 0; m < 4; ++m) _Pragma("unroll") for (int k = 0; k < 2; ++k) dst[m][k] = *(const LAS bf16x8*)(lds + PG8_SA(b, h) + aoff + m * 2048 + k * 1024); } while (0)
#define PG8_LDB(dst, b, h) do { _Pragma("unroll") for (int n = 0; n < 2; ++n) _Pragma("unroll") for (int k = 0; k < 2; ++k) dst[n][k] = *(const LAS bf16x8*)(lds + PG8_SB(b, h) + boff + n * 2048 + k * 1024); } while (0)
#define PG8_MMA(ai, bj, At, Bt) do { __builtin_amdgcn_s_setprio(1); _Pragma("unroll") for (int m = 0; m < 4; ++m) _Pragma("unroll") for (int n = 0; n < 2; ++n) _Pragma("unroll") for (int k = 0; k < 2; ++k) \
        acc[ai][bj][m][n] = __builtin_amdgcn_mfma_f32_16x16x32_bf16(Bt[n][k], At[m][k], acc[ai][bj][m][n], 0, 0, 0); __builtin_amdgcn_s_setprio(0); } while (0)
#define PG8_WAIT_V(n) asm volatile("s_waitcnt vmcnt(" #n ")" ::: "memory")
#define PG8_WAIT_L(n) asm volatile("s_waitcnt lgkmcnt(" #n ")" ::: "memory")
#define PG8_BAR __builtin_amdgcn_s_barrier()
#define PG8_SCHED __builtin_amdgcn_sched_barrier(0)
    Unit cur, nxt; int ui = 0;
    if (!S.next(0, cur)) return;
    f32x4 acc[2][2][4][2];
#pragma unroll
    for (int a = 0; a < 2; ++a)
#pragma unroll
        for (int b = 0; b < 2; ++b)
#pragma unroll
            for (int m = 0; m < 4; ++m)
#pragma unroll
                for (int n = 0; n < 2; ++n) acc[a][b][m][n] = (f32x4){0.f, 0.f, 0.f, 0.f};
    bf16x8 At[4][2], B0[2][2], B1[2][2];
    const char* cA; const char* cB; S.ptrs(cur, cA, cB);
    PG8_STAGE(PG8_SB(0, 0), cB, voffB); PG8_STAGE(PG8_SB(0, 1), cB + hstep, voffB); PG8_STAGE(PG8_SA(0, 0), cA, voffA); PG8_STAGE(PG8_SA(0, 1), cA + hstep, voffA);
    if (wr == 1) PG8_BAR;
    PG8_WAIT_V(2); PG8_BAR;
    PG8_STAGE(PG8_SB(1, 0), cB + kstep, voffB); PG8_STAGE(PG8_SA(1, 0), cA + kstep, voffA); PG8_STAGE(PG8_SB(1, 1), cB + hstep + kstep, voffB);
    PG8_WAIT_V(6); PG8_BAR;
    for (;;) {
        const bool has_next = S.next(ui + 1, nxt);
        const char* nA = cA; const char* nB = cB; if (has_next) S.ptrs(nxt, nA, nB);
        for (int t = 0; t < nt; t += 2) {
            const bool last = (t == nt - 2);
            const char* a1 = cA + (size_t)(t + 1) * kstep;
            const char* a2 = last ? nA : cA + (size_t)(t + 2) * kstep; const char* b2 = last ? nB : cB + (size_t)(t + 2) * kstep;
            const char* a3 = a2 + kstep; const char* b3 = b2 + kstep;
            PG8_LDB(B0, 0, 0); PG8_LDB(B1, 0, 1); PG8_SCHED; PG8_LDA(At, 0, 0); PG8_STAGE(PG8_SA(1, 1), a1 + hstep, voffA);
            PG8_WAIT_V(8); PG8_WAIT_L(0); PG8_BAR; PG8_MMA(0, 0, At, B0); PG8_MMA(0, 1, At, B1); PG8_BAR; PG8_SCHED;
            PG8_LDA(At, 0, 1); PG8_STAGE(PG8_SB(0, 0), b2, voffB); PG8_STAGE(PG8_SB(0, 1), b2 + hstep, voffB); PG8_STAGE(PG8_SA(0, 0), a2, voffA);
            PG8_WAIT_V(8); PG8_WAIT_L(0); PG8_BAR; PG8_MMA(1, 0, At, B0); PG8_MMA(1, 1, At, B1); PG8_BAR; PG8_SCHED;
            PG8_LDB(B0, 1, 0); PG8_LDB(B1, 1, 1); PG8_SCHED; PG8_LDA(At, 1, 0); PG8_STAGE(PG8_SA(0, 1), a2 + hstep, voffA);
            PG8_WAIT_V(8); PG8_WAIT_L(0); PG8_BAR; PG8_MMA(0, 0, At, B0); PG8_MMA(0, 1, At, B1); PG8_BAR; PG8_SCHED;
            PG8_LDA(At, 1, 1); PG8_STAGE(PG8_SB(1, 0), b3, voffB); PG8_STAGE(PG8_SB(1, 1), b3 + hstep, voffB); PG8_STAGE(PG8_SA(1, 0), a3, voffA);
            PG8_WAIT_V(8); PG8_WAIT_L(0); PG8_BAR; PG8_MMA(1, 0, At, B0); PG8_MMA(1, 1, At, B1); PG8_BAR; PG8_SCHED;
        }
        if (wr == 0) PG8_BAR;
        E(acc, cur, wv_);
        if (!has_next) break;
        if (!(Epi::KEEP_ACC && cur.aux < 2)) {
#pragma unroll
        for (int a = 0; a < 2; ++a)
#pragma unroll
            for (int b = 0; b < 2; ++b)
#pragma unroll
                for (int m = 0; m < 4; ++m)
#pragma unroll
                    for (int n = 0; n < 2; ++n) acc[a][b][m][n] = (f32x4){0.f, 0.f, 0.f, 0.f};
        }
        cur = nxt; cA = nA; cB = nB; ++ui;
        if (wr == 1) PG8_BAR;
    }
    PG8_WAIT_V(0);
    PG8_BAR;
#undef PG8_SA
#undef PG8_SB
#undef PG8_STAGE
#undef PG8_LDA
#undef PG8_LDB
#undef PG8_MMA
#undef PG8_WAIT_V
#undef PG8_WAIT_L
#undef PG8_BAR
#undef PG8_SCHED
}

#define EPI_FENCE __builtin_amdgcn_sched_barrier(0)
template <int ACT> struct EpiScale {
    static constexpr bool PERM = true, KEEP_ACC = false;
    bf16_t* O; int ldc; const float* rowsq;
    __device__ __forceinline__ void operator()(f32x4 (&acc)[2][2][4][2], const Unit& u, const int wv_) const {
        const int lane_ = TIDX & 63, wr = wv_ >> 2, wc = wv_ & 3, fr = lane_ & 15, fq = lane_ >> 4;
        const int row0 = u.pm * BM + wr * 64 + fr + opaque0(), col0 = u.pn * BM + wc * 32 + 8 * fq;
#pragma unroll
        for (int ai = 0; ai < 2; ++ai) {
            float rs[4];
#pragma unroll
            for (int m = 0; m < 4; ++m) rs[m] = row_rs(rowsq, row0 + ai * HALF + m * 16);
            EPI_FENCE;
#pragma unroll
            for (int m = 0; m < 4; ++m) {
                const int row = row0 + ai * HALF + m * 16;
                bf16_t* rowp = O + (size_t)row * ldc + col0;
#pragma unroll
                for (int bj = 0; bj < 2; ++bj) {
                    f32x4 v0 = acc[ai][bj][m][0] * rs[m], v1 = acc[ai][bj][m][1] * rs[m];
                    if (ACT == 1) {
#pragma unroll
                        for (int j = 0; j < 4; ++j) { v0[j] = sigmoidf_(v0[j]); v1[j] = sigmoidf_(v1[j]); } }
                    u32x4 w; w.x = cvt_pk_bf16(v0[0], v0[1]); w.y = cvt_pk_bf16(v0[2], v0[3]); w.z = cvt_pk_bf16(v1[0], v1[1]); w.w = cvt_pk_bf16(v1[2], v1[3]);
                    *(u32x4*)(rowp + bj * HALF) = w; }
            }
            EPI_FENCE;
        }
    }
};
struct EpiMerge {
    static constexpr bool PERM = true, KEEP_ACC = true;
    const bf16_t* gates; float* scratch; bf16_t* merged;
    __device__ __forceinline__ void operator()(f32x4 (&acc)[2][2][4][2], const Unit& u, const int wv_) const {
        const int tid_ = TIDX, lane_ = tid_ & 63, wr = wv_ >> 2, wc = wv_ & 3, fr = lane_ & 15, fq = lane_ >> 4;
        const int n = u.aux; const int row0 = u.pm * BM + wr * 64 + fr + opaque0(), col0 = u.pn * BM + wc * 32 + 8 * fq;
#pragma unroll
        for (int ai = 0; ai < 2; ++ai)
#pragma unroll
            for (int m = 0; m < 4; ++m) {
                const int row = row0 + ai * HALF + m * 16;
#pragma unroll
                for (int bj = 0; bj < 2; ++bj) {
                    const bf16_t* gp = gates + (size_t)row * NG + n * 1024 + col0 + bj * HALF;
                    const u32x4 g = *(const u32x4*)gp;
                    float f[8] = {bflo(g.x), bfhi(g.x), bflo(g.y), bfhi(g.y), bflo(g.z), bfhi(g.z), bflo(g.w), bfhi(g.w)};
                    if (n < 2) { const u32x4 d = *(const u32x4*)(gp + 1024);
                        const float dn[8] = {bflo(d.x), bfhi(d.x), bflo(d.y), bfhi(d.y), bflo(d.z), bfhi(d.z), bflo(d.w), bfhi(d.w)};
#pragma unroll
                        for (int j = 0; j < 8; ++j) f[j] *= __builtin_amdgcn_rcpf(fmaxf(dn[j], 1e-30f)); }
                    f32x4 p0 = acc[ai][bj][m][0], p1 = acc[ai][bj][m][1];
                    p0[0] *= f[0]; p0[1] *= f[1]; p0[2] *= f[2]; p0[3] *= f[3]; p1[0] *= f[4]; p1[1] *= f[5]; p1[2] *= f[6]; p1[3] *= f[7];
                    if (n < 2) { acc[ai][bj][m][0] = p0; acc[ai][bj][m][1] = p1; }
                    else { u32x4 w; w.x = cvt_pk_bf16(p0[0], p0[1]); w.y = cvt_pk_bf16(p0[2], p0[3]); w.z = cvt_pk_bf16(p1[0], p1[1]); w.w = cvt_pk_bf16(p1[2], p1[3]);
                        *(u32x4*)(merged + (size_t)row * DM + col0 + bj * HALF) = w; }
                }
                if (m & 1) EPI_FENCE;
            }
    }
};
struct EpiResid {
    static constexpr bool PERM = false, KEEP_ACC = false;
    const float* xin; float* xout; bf16_t* xb; float* rowsq; LAS float* ex;
    __device__ __forceinline__ void operator()(f32x4 (&acc)[2][2][4][2], const Unit& u, const int wv_) const {
        const int tid_ = TIDX, lane_ = tid_ & 63, wr = wv_ >> 2, wc = wv_ & 3, fr = lane_ & 15, fq = lane_ >> 4;
        const int row0 = u.pm * BM + wr * 64 + fr + opaque0(), col0 = u.pn * BM + wc * 32 + 4 * fq;
#pragma unroll
        for (int ai = 0; ai < 2; ++ai)
#pragma unroll
            for (int m = 0; m < 4; ++m) {
                const int row = row0 + ai * HALF + m * 16; float ss = 0.f;
#pragma unroll
                for (int bj = 0; bj < 2; ++bj)
#pragma unroll
                    for (int n = 0; n < 2; ++n) {
                        const size_t o = (size_t)row * DM + col0 + bj * HALF + n * 16;
                        const f32x4 xn = *(const f32x4*)(xin + o) + acc[ai][bj][m][n];
                        *(f32x4*)(xout + o) = xn;
                        ss += (xn[0] * xn[0] + xn[1] * xn[1]) + (xn[2] * xn[2] + xn[3] * xn[3]);
                        u32x2 w; w.x = cvt_pk_bf16(xn[0], xn[1]); w.y = cvt_pk_bf16(xn[2], xn[3]); *(u32x2*)(xb + o) = w;
                    }
                ss += __shfl_xor(ss, 16); ss += __shfl_xor(ss, 32);
                if (fq == 0) ex[(ai * HALF + wr * 64 + m * 16 + fr) * 4 + wc] = ss;
                if (m & 1) EPI_FENCE;
            }
        asm volatile("s_waitcnt lgkmcnt(0)" ::: "memory"); __builtin_amdgcn_s_barrier(); asm volatile("" ::: "memory");
        if (tid_ < 256) { const f32x4 q = *(LAS f32x4*)(ex + tid_ * 4); rowsq[(size_t)(u.pm * BM + tid_) * 4 + u.pn] = (q[0] + q[1]) + (q[2] + q[3]); }
    }
};
struct EpiFfn {
    static constexpr bool PERM = false, KEEP_ACC = false;
    bf16_t* act; const float* rowsq; const float* cw; const float* cb; float* side;
    __device__ __forceinline__ void operator()(f32x4 (&acc)[2][2][4][2], const Unit& u, const int wv_) const {
        const int lane_ = TIDX & 63, wr = wv_ >> 2, wc = wv_ & 3, fr = lane_ & 15, fq = lane_ >> 4;
        const int row0 = u.pm * BM + wr * 64 + fr + opaque0();
        float rs[2][4];
#pragma unroll
        for (int ai = 0; ai < 2; ++ai)
#pragma unroll
            for (int m = 0; m < 4; ++m) rs[ai][m] = row_rs(rowsq, row0 + ai * HALF + m * 16);
        EPI_FENCE;
        float chain = rs[0][0];
#pragma unroll
        for (int nn = 0; nn < 2; ++nn) {
#pragma unroll
            for (int hf = 0; hf < 2; ++hf) {
                const int ch0 = hf * DFF + u.pn * 128 + wc * 32 + 16 * nn + 4 * fq + __float_as_int(opaque0_after(chain));
                const f32x4 w0 = *(const f32x4*)(cw + ch0), w1 = *(const f32x4*)(cw + NUP + ch0), w2 = *(const f32x4*)(cw + 2 * NUP + ch0), wb = *(const f32x4*)(cb + ch0);
                const int fr2 = fr + __float_as_int(opaque0_after(chain));
                if (fr2 < 2 || fr2 >= 14) {
                    const int slot = fr2 < 2 ? fr2 : fr2 - 12;
#pragma unroll
                    for (int ai = 0; ai < 2; ++ai) {
                        const int blk = u.pm * 4 + ai * 2 + wr;
                        const f32x4 xe = fr2 < 2 ? acc[ai][hf][0][nn] * rs[ai][0] : acc[ai][hf][3][nn] * rs[ai][3];
                        *(f32x4*)((char*)side + (unsigned)(((blk * 4 + slot) * NUP + ch0) * 4)) = xe;
                    }
                }
                EPI_FENCE;
#pragma unroll
                for (int ai = 0; ai < 2; ++ai) {
                    f32x4 p1 = (f32x4){0.f, 0.f, 0.f, 0.f}, p2 = p1;
#pragma unroll
                    for (int m = 0; m < 4; ++m) {
                        const float rsm = rs[ai][m] + ((m & 1) ? 0.f : opaque0_after(chain));
                        f32x4 r1, r2, res;
#pragma unroll
                        for (int j = 0; j < 4; ++j) {
                            const float x = acc[ai][hf][m][nn][j] * rsm;
                            r1[j] = dppmov<0x121>(x); r2[j] = dppmov<0x122>(x);
                            const float q1 = fr >= 1 ? r1[j] : p1[j], q2 = fr >= 2 ? r2[j] : p2[j];
                            const float pre = w2[j] * x + w1[j] * q1 + w0[j] * q2 + wb[j];
                            res[j] = (hf == 0) ? siluf_(pre) : acc[ai][0][m][nn][j] * pre;
                        }
                        chain = res[3];
                        if (hf == 0) acc[ai][0][m][nn] = res;
                        else {
                            u32x2 w; w.x = cvt_pk_bf16(res[0], res[1]); w.y = cvt_pk_bf16(res[2], res[3]);
                            *(u32x2*)((char*)act + (unsigned)(((row0 + ai * HALF + m * 16) * DFF + (ch0 - DFF)) * 2)) = w;
                        }
                        p1 = r1; p2 = r2;
                    }
                }
            }
        }
    }
};

__device__ __forceinline__ int srccol(int map, int s0, int n) {
    if (map == 1) return n < 1536 ? n : n + 8;
    if (map == 2) return ((n >> 7) & 1) * DFF + (n >> 8) * 128 + (n & 127);
    return s0 + n;
}
__device__ __forceinline__ void prep_w(LAS float* L, bf16_t* dst, const float* src, int K, int N, int ld, int s0, int map, const float* g, int& off, const int wv_, int Gp = 0, int cp = 0) {
    const int G = Gp > 0 ? Gp : (int)gridDim.x, c = Gp > 0 ? cp : (int)blockIdx.x, tid = TIDX;
    const int nkt = K >> 6, ntiles = (N >> 6) * nkt;
    const int i0 = tid >> 6, j = tid & 63, nn = tid >> 3, kc = tid & 7;
    float r[8];
#define PREP_LOAD(T) do { const int n0_ = ((T) / nkt) << 6, k0_ = ((T) % nkt) << 6; const int col_ = srccol(map, s0, n0_) + j; \
        _Pragma("unroll") for (int pp = 0; pp < 8; ++pp) { const int k_ = k0_ + i0 + 8 * pp; float v_ = src[(size_t)k_ * ld + col_]; if (g) v_ *= g[k_]; r[pp] = v_; } } while (0)
    int t = (c + G - off % G) % G;
    if (t < ntiles) PREP_LOAD(t);
    for (; t < ntiles; t += G) {
        const int n0 = (t / nkt) << 6, k0 = (t % nkt) << 6;
#pragma unroll
        for (int pp = 0; pp < 8; ++pp) L[(i0 + 8 * pp) * 65 + j] = r[pp];
        __syncthreads();
        if (t + G < ntiles) PREP_LOAD(t + G);
        u32x4 w;
        w.x = cvt_pk_bf16(L[(kc * 8 + 0) * 65 + nn], L[(kc * 8 + 1) * 65 + nn]); w.y = cvt_pk_bf16(L[(kc * 8 + 2) * 65 + nn], L[(kc * 8 + 3) * 65 + nn]);
        w.z = cvt_pk_bf16(L[(kc * 8 + 4) * 65 + nn], L[(kc * 8 + 5) * 65 + nn]); w.w = cvt_pk_bf16(L[(kc * 8 + 6) * 65 + nn], L[(kc * 8 + 7) * 65 + nn]);
        *(u32x4*)(dst + (size_t)(n0 + nn) * K + k0 + kc * 8) = w;
        __syncthreads();
    }
#undef PREP_LOAD
    off += ntiles;
}
__device__ __forceinline__ void prep_layer_main(const Params& p, int l, LAS float* L, const int wv_, int part = 3, int Gp = 0, int cp = 0) {
    bf16_t* W = (bf16_t*)(p.ws + WS_W); int off = 0;
    const int G = Gp > 0 ? Gp : (int)gridDim.x, c = Gp > 0 ? cp : (int)blockIdx.x;
    const float* win = p.w_in + (size_t)l * 1024 * NIN; const float* gn = p.attn_norm + l * 1024;
    if (part & 1) {
        prep_w(L, W + W_IN, win, 1024, NU, NIN, 0, 1, gn, off, wv_, Gp, cp);
        bf16_t* wab = (bf16_t*)(p.ws + WS_WAB);
        for (int i0 = c * 512; i0 < 8192; i0 += G * 512) { const int i = i0 + TIDX; const int jj = i >> 10, k = i & 1023; const float wv = win[(size_t)k * NIN + 1536 + jj] * gn[k];
            const unsigned hi = cvt_pk_bf16(wv, 0.f) & 0xffffu; const float lo = wv - bflo(hi); wab[jj * 1024 + k] = (bf16_t)hi; wab[(8 + jj) * 1024 + k] = (bf16_t)(cvt_pk_bf16(lo, 0.f) & 0xffffu); }
    }
    if (part & 2) {
        prep_w(L, W + W_G, win, 1024, NG, NIN, 4616, 0, gn, off, wv_, Gp, cp);
        for (int n = 0; n < 3; ++n) prep_w(L, W + W_B + (size_t)n * 1024 * 512, p.w_branch + ((size_t)l * 3 + n) * 512 * 1024, 512, 1024, 1024, 0, 0, nullptr, off, wv_, Gp, cp);
        prep_w(L, W + W_O, p.w_out + (size_t)l * 1024 * 1024, 1024, 1024, 1024, 0, 0, nullptr, off, wv_, Gp, cp);
        prep_w(L, W + W_UP, p.w_up + (size_t)l * 1024 * NUP, 1024, NUP, NUP, 0, 2, p.ffn_norm + l * 1024, off, wv_, Gp, cp);
    }
}
__device__ __forceinline__ void prep_layer_down(const Params& p, int l, LAS float* L, const int wv_, int Gp = 0, int cp = 0) {
    bf16_t* W = (bf16_t*)(p.ws + WS_W); int off = 0;
    prep_w(L, W + W_DN, p.w_down + (size_t)l * DFF * 1024, DFF, 1024, 1024, 0, 0, nullptr, off, wv_, Gp, cp);
}

__device__ __forceinline__ void rownorm(const Params& p, const float* src, float* rowsq, const int wv_) {
    const int tid = TIDX, lane = tid & 63, gw = blockIdx.x * 8 + (tid >> 6), nw = gridDim.x * 8;
    bf16_t* xb = (bf16_t*)(p.ws + WS_XB);
    for (int row = gw; row < MTOK; row += nw) {
        float ss = 0.f;
#pragma unroll
        for (int i = 0; i < 4; ++i) { const size_t o = (size_t)row * DM + i * 256 + lane * 4; const f32x4 v = *(const f32x4*)(src + o);
            ss += (v[0] * v[0] + v[1] * v[1]) + (v[2] * v[2] + v[3] * v[3]); u32x2 w; w.x = cvt_pk_bf16(v[0], v[1]); w.y = cvt_pk_bf16(v[2], v[3]); *(u32x2*)(xb + o) = w; }
#pragma unroll
        for (int s = 32; s >= 1; s >>= 1) ss += __shfl_xor(ss, s);
        if (lane == 0) *(f32x4*)(rowsq + (size_t)row * 4) = (f32x4){ss, 0.f, 0.f, 0.f};
    }
}

__device__ __forceinline__ void rot_table(const Params& p, const int wv_) {
    const int t_ = TIDX; float* tab = (float*)(p.ws + WS_ROT);
    for (int i0 = blockIdx.x * 512; i0 < MTOK * 32; i0 += gridDim.x * 512) {
        const int i = i0 + t_, token = i >> 5, j = i & 31;
        const float inv = (float)pow(10000.0, -(double)j / 32.0); float sn, cs; sincosf((float)p.pos[token] * inv, &sn, &cs);
        *(f32x2*)(tab + (size_t)i * 2) = (f32x2){cs, sn};
    }
}
__device__ __forceinline__ void ab_tail(const Params& p, const int wv_) {
    const int tid = TIDX, lane = tid & 63, gw = blockIdx.x * 8 + (tid >> 6), nw = gridDim.x * 8, r16 = lane & 15, kq = lane >> 4;
    const bf16_t* xb = (const bf16_t*)(p.ws + WS_XB); const float* rowsq = (const float*)(p.ws + WS_ROWSQ + MiB); const bf16_t* wab = (const bf16_t*)(p.ws + WS_WAB); float* ab = (float*)(p.ws + WS_AB);
    for (int rb = gw; rb < MTOK / 16; rb += nw) {
        const bf16_t* ap = xb + (size_t)(rb * 16 + r16) * DM + kq * 8; const bf16_t* bp = wab + r16 * 1024 + kq * 8;
        f32x4 acc = (f32x4){0.f, 0.f, 0.f, 0.f};
#pragma unroll 8
        for (int kk = 0; kk < 32; ++kk) acc = __builtin_amdgcn_mfma_f32_16x16x32_bf16(*(const bf16x8*)(ap + kk * 32), *(const bf16x8*)(bp + kk * 32), acc, 0, 0, 0);
#pragma unroll
        for (int j = 0; j < 4; ++j) { const float v = acc[j] + __shfl_xor(acc[j], 8); const int row = rb * 16 + kq * 4 + j; if (r16 < 8) ab[(size_t)row * 8 + r16] = v * row_rs(rowsq, row); }
    }
}

__device__ __forceinline__ void u0_tail(const Params& p, int layer, LAS float* L, const int wv_) {
    const int tid = TIDX;
    if ((int)blockIdx.x >= 192) return;
    const int cgp = (int)blockIdx.x % 24, ksl = (int)blockIdx.x / 24, kb0 = ksl * 128;
    const float* xs = (layer == 0) ? p.x : p.out; const float* rowsq = (const float*)(p.ws + WS_ROWSQ + MiB); const float* gn = p.attn_norm + layer * 1024;
    const float* win = p.w_in + (size_t)layer * 1024 * NIN; float* u0 = (float*)(p.ws + WS_U0) + (size_t)ksl * 16 * 1536;
    for (int i = tid; i < 16 * 128; i += 512) { const int r = i >> 7, k = kb0 + (i & 127); L[i] = xs[(size_t)(r * SEQ) * DM + k] * row_rs(rowsq, r * SEQ) * gn[k]; }
    __syncthreads();
    const int c = cgp * 64 + (tid & 63), rg = tid >> 6;
    const int sc = c < 1024 ? c : 2056 + (c - 1024);
    const float* wp = win + (size_t)kb0 * NIN + sc;
    float a0 = 0.f, a1 = 0.f;
#pragma unroll 32
    for (int k = 0; k < 128; ++k) { const float w = wp[(size_t)k * NIN]; a0 += L[(2 * rg) * 128 + k] * w; a1 += L[(2 * rg + 1) * 128 + k] * w; }
    u0[(2 * rg) * 1536 + c] = a0; u0[(2 * rg + 1) * 1536 + c] = a1;
    __syncthreads();
}
__device__ __forceinline__ float u0_read(const float* u0, int b, int col) {
    float s = 0.f;
#pragma unroll
    for (int ks = 0; ks < 8; ++ks) s += u0[((size_t)ks * 16 + b) * 1536 + col];
    return s;
}

__device__ __forceinline__ void lds_barrier() { asm volatile("s_waitcnt lgkmcnt(0)" ::: "memory"); __builtin_amdgcn_s_barrier(); asm volatile("" ::: "memory"); }
constexpr int DN_QF = 0, DN_KF = 32768, DN_LM = 0, DN_OS = 16384, DN_QB = 65536, DN_KB = 82944, DN_KT = 100352, DN_AB = 118784, DN_ST = 128000, DN_U = 145408, DN_VT = 32768, DN_VTS = 41984, DN_MISC = 162048;
__device__ __forceinline__ void deltanet_item(const Params& p, int layer, int item, LAS unsigned char* Lb, const int wv_) {
    const int tid0 = TIDX, w = wv_;
    const int b = item >> 3, h = (item >> 1) & 3, sl = item & 1;
    LAS float* qs = (LAS float*)(Lb + DN_QF); LAS float* ks = (LAS float*)(Lb + DN_KF);
    LAS bf16_t* XT = (LAS bf16_t*)(Lb + DN_OS); LAS bf16_t* LB21 = (LAS bf16_t*)(Lb + DN_OS + 12288);
    LAS float* Lm = (LAS float*)(Lb + DN_LM); LAS float* os = (LAS float*)(Lb + DN_OS);
    LAS bf16_t* qb = (LAS bf16_t*)(Lb + DN_QB); LAS bf16_t* kb = (LAS bf16_t*)(Lb + DN_KB);
    LAS bf16_t* kT = (LAS bf16_t*)(Lb + DN_KT);
    LAS bf16_t* Ab = (LAS bf16_t*)(Lb + DN_AB);
    LAS bf16_t* Stl = (LAS bf16_t*)(Lb + DN_ST);
    LAS float* U = (LAS float*)(Lb + DN_U);
    LAS bf16_t* vT = (LAS bf16_t*)(Lb + DN_VT); LAS bf16_t* vTs = (LAS bf16_t*)(Lb + DN_VTS);
    LAS float* gcs = (LAS float*)(Lb + DN_MISC); LAS float* bes = gcs + 64; LAS float* egs = gcs + 128; LAS float* egl = gcs + 192;
    const bf16_t* u = (const bf16_t*)(p.ws + WS_U); const float* ab = (const float*)(p.ws + WS_AB);
    float* sta = (float*)(p.ws + WS_STA); bf16_t* ya = (bf16_t*)(p.ws + WS_Y);
    const float* cw = p.dn_conv_w + (size_t)layer * 4 * 1536;
    const int cp0 = tid0 & 127;
    const int colq = (cp0 < 64) ? (h * 128 + 2 * cp0) : (512 + h * 128 + 2 * (cp0 - 64));
    float cwa[4], cwb[4];
#pragma unroll
    for (int j = 0; j < 4; ++j) { cwa[j] = cw[j * 1536 + colq]; cwb[j] = cw[j * 1536 + colq + 1]; }
    const int c80 = tid0 & 7;
    const int colv = 1024 + h * 128 + sl * 64 + c80 * 8;
    const float Aexp = __expf(p.dn_a_log[layer * 4 + h]), dtb = p.dn_dt_bias[layer * 4 + h];
    f32x4 Sacc[4] = {(f32x4){0.f, 0.f, 0.f, 0.f}, (f32x4){0.f, 0.f, 0.f, 0.f}, (f32x4){0.f, 0.f, 0.f, 0.f}, (f32x4){0.f, 0.f, 0.f, 0.f}};
    for (int i = tid0; i < 64 * 136 / 2; i += 512) ((LAS unsigned*)Stl)[i] = 0u;
    unsigned rq[19]; u32x4 rv[4]; float ralpha = 0.f, rbeta = 0.f;
#define DN_PREFETCH(CH) do { const int tid_ = TIDX; const int tq_ = tid_ >> 7, tl8_ = tid_ >> 3, ln_ = tid_ & 63; \
        const int t0_ = (CH) * 64 + tq_ * 16; const bf16_t* up_ = u + (size_t)(b * SEQ + t0_) * NU + colq; \
        _Pragma("unroll") for (int i_ = 0; i_ < 19; ++i_) { rq[i_] = 0u; if (t0_ - 3 + i_ >= 0) rq[i_] = *(const unsigned*)(up_ + (ptrdiff_t)(i_ - 3) * NU); } \
        const int t_ = (CH) * 64 + tl8_; \
        _Pragma("unroll") for (int j_ = 0; j_ < 4; ++j_) { rv[j_] = (u32x4){0u, 0u, 0u, 0u}; if (t_ - 3 + j_ >= 0) rv[j_] = *(const u32x4*)(u + (size_t)(b * SEQ + t_ - 3 + j_) * NU + colv); } \
        if (w == 0) { const float* abp_ = ab + (size_t)(b * SEQ + (CH) * 64 + ln_) * 8; ralpha = abp_[h]; rbeta = abp_[4 + h]; } } while (0)
    DN_PREFETCH(0);
    for (int ch = 0; ch < 32; ++ch) {
        const int tbase = b * SEQ + ch * 64;
        const int tid = TIDX, lane = tid & 63, cp = tid & 127, tq = tid >> 7, tl8 = tid >> 3, c8 = tid & 7, r16 = lane & 15, kq = lane >> 4;
        LAS float* dstq = (cp < 64) ? (qs + 2 * cp) : (ks + 2 * (cp - 64));
        {
            const int t0 = ch * 64 + tq * 16;
            float xa[3] = {bflo(rq[0]), bflo(rq[1]), bflo(rq[2])}, xb_[3] = {bfhi(rq[0]), bfhi(rq[1]), bfhi(rq[2])};
#pragma unroll
            for (int i = 0; i < 16; ++i) {
                float ca = bflo(rq[3 + i]), cb = bfhi(rq[3 + i]);
                if (i == 0 && t0 == 0) { const float* u0p = (const float*)(p.ws + WS_U0); ca = u0_read(u0p, b, colq); cb = u0_read(u0p, b, colq + 1); }
                const float ya_ = cwa[0] * xa[0] + cwa[1] * xa[1] + cwa[2] * xa[2] + cwa[3] * ca, yb_ = cwb[0] * xb_[0] + cwb[1] * xb_[1] + cwb[2] * xb_[2] + cwb[3] * cb;
                *(LAS f32x2*)(dstq + (tq * 16 + i) * 128) = (f32x2){siluf_(ya_), siluf_(yb_)};
                xa[0] = xa[1]; xa[1] = xa[2]; xa[2] = ca; xb_[0] = xb_[1]; xb_[1] = xb_[2]; xb_[2] = cb;
            }
        }
        {
            f32x4 cwv[4][2]; { const float* cwp = cw + colv + opaque0();
#pragma unroll
                for (int j = 0; j < 4; ++j) { cwv[j][0] = *(const f32x4*)(cwp + j * 1536); cwv[j][1] = *(const f32x4*)(cwp + j * 1536 + 4); } }
            f32x4 accv0 = (f32x4){0.f, 0.f, 0.f, 0.f}, accv1 = accv0;
#pragma unroll
            for (int j = 0; j < 4; ++j) { accv0 += cwv[j][0] * (f32x4){bflo(rv[j].x), bfhi(rv[j].x), bflo(rv[j].y), bfhi(rv[j].y)}; accv1 += cwv[j][1] * (f32x4){bflo(rv[j].z), bfhi(rv[j].z), bflo(rv[j].w), bfhi(rv[j].w)}; }
#pragma unroll
            for (int j = 0; j < 4; ++j) { U[tl8 * 65 + c8 * 8 + j] = siluf_(accv0[j]); U[tl8 * 65 + c8 * 8 + 4 + j] = siluf_(accv1[j]); }
        }
        if (w == 0) {
            float g = -Aexp * softplusf_(ralpha + dtb);
#pragma unroll
            for (int sft = 1; sft < 64; sft <<= 1) { const float o = __shfl_up(g, sft); if (lane >= sft) g += o; }
            const float gl = __shfl(g, 63);
            gcs[lane] = g; bes[lane] = sigmoidf_(rbeta); egs[lane] = __expf(g); egl[lane] = __expf(gl - g);
        }
        lds_barrier();
        {
            LAS f32x4* qp = (LAS f32x4*)(qs + tl8 * 128 + c8 * 16); LAS f32x4* kp = (LAS f32x4*)(ks + tl8 * 128 + c8 * 16);
            f32x4 q0 = qp[0], q1 = qp[1], q2 = qp[2], q3 = qp[3], k0 = kp[0], k1 = kp[1], k2 = kp[2], k3 = kp[3];
            float sq = 0.f, sk = 0.f;
#pragma unroll
            for (int j = 0; j < 4; ++j) { sq += q0[j] * q0[j] + q1[j] * q1[j] + q2[j] * q2[j] + q3[j] * q3[j]; sk += k0[j] * k0[j] + k1[j] * k1[j] + k2[j] * k2[j] + k3[j] * k3[j]; }
            sq += __shfl_xor(sq, 1); sq += __shfl_xor(sq, 2); sq += __shfl_xor(sq, 4); sk += __shfl_xor(sk, 1); sk += __shfl_xor(sk, 2); sk += __shfl_xor(sk, 4);
            const float fq_ = rsqrtf(sq + EPS) * 0.08838834764831845f, fk = rsqrtf(sk + EPS);
            q0 *= fq_; q1 *= fq_; q2 *= fq_; q3 *= fq_; k0 *= fk; k1 *= fk; k2 *= fk; k3 *= fk;
            if (ch == 0) {
                float d = 0.f;
#pragma unroll
                for (int j = 0; j < 4; ++j) d += q0[j] * k0[j] + q1[j] * k1[j] + q2[j] * k2[j] + q3[j] * k3[j];
                d += __shfl_xor(d, 1); d += __shfl_xor(d, 2); d += __shfl_xor(d, 4);
                if (tid == 0) gcs[256] = d;
            }
            u32x4 wq0, wq1, wk0, wk1;
            wq0.x = cvt_pk_bf16(q0[0], q0[1]); wq0.y = cvt_pk_bf16(q0[2], q0[3]); wq0.z = cvt_pk_bf16(q1[0], q1[1]); wq0.w = cvt_pk_bf16(q1[2], q1[3]);
            wq1.x = cvt_pk_bf16(q2[0], q2[1]); wq1.y = cvt_pk_bf16(q2[2], q2[3]); wq1.z = cvt_pk_bf16(q3[0], q3[1]); wq1.w = cvt_pk_bf16(q3[2], q3[3]);
            wk0.x = cvt_pk_bf16(k0[0], k0[1]); wk0.y = cvt_pk_bf16(k0[2], k0[3]); wk0.z = cvt_pk_bf16(k1[0], k1[1]); wk0.w = cvt_pk_bf16(k1[2], k1[3]);
            wk1.x = cvt_pk_bf16(k2[0], k2[1]); wk1.y = cvt_pk_bf16(k2[2], k2[3]); wk1.z = cvt_pk_bf16(k3[0], k3[1]); wk1.w = cvt_pk_bf16(k3[2], k3[3]);
            *(LAS u32x4*)(qb + tl8 * 136 + c8 * 16) = wq0; *(LAS u32x4*)(qb + tl8 * 136 + c8 * 16 + 8) = wq1;
            *(LAS u32x4*)(kb + tl8 * 136 + c8 * 16) = wk0; *(LAS u32x4*)(kb + tl8 * 136 + c8 * 16 + 8) = wk1;
            const unsigned kw[8] = {wk0.x, wk0.y, wk0.z, wk0.w, wk1.x, wk1.y, wk1.z, wk1.w};
#pragma unroll
            for (int j = 0; j < 8; ++j) { kT[(c8 * 16 + 2 * j) * 72 + tl8] = (bf16_t)(kw[j] & 0xffffu); kT[(c8 * 16 + 2 * j + 1) * 72 + tl8] = (bf16_t)(kw[j] >> 16); }
            const float be = bes[tl8], bg = be * egs[tl8];
            kp[0] = k0 * bg; kp[1] = k1 * bg; kp[2] = k2 * bg; kp[3] = k3 * bg;
#pragma unroll
            for (int j = 0; j < 8; ++j) U[tl8 * 65 + c8 * 8 + j] *= be;
        }
        lds_barrier();
        if (ch + 1 < 32) DN_PREFETCH(ch + 1);
        {
            const int mt = w & 3, ntb = (w >> 2) * 2;
            f32x4 akk[2] = {(f32x4){0.f, 0.f, 0.f, 0.f}, (f32x4){0.f, 0.f, 0.f, 0.f}}, aqk[2] = {akk[0], akk[0]};
#pragma unroll
            for (int kk = 0; kk < 4; ++kk) {
                const bf16x8 fk_ = *(const LAS bf16x8*)(kb + (mt * 16 + r16) * 136 + kk * 32 + kq * 8);
                const bf16x8 fq2 = *(const LAS bf16x8*)(qb + (mt * 16 + r16) * 136 + kk * 32 + kq * 8);
#pragma unroll
                for (int q = 0; q < 2; ++q) {
                    const bf16x8 fb = *(const LAS bf16x8*)(kb + ((ntb + q) * 16 + r16) * 136 + kk * 32 + kq * 8);
                    akk[q] = __builtin_amdgcn_mfma_f32_16x16x32_bf16(fk_, fb, akk[q], 0, 0, 0);
                    aqk[q] = __builtin_amdgcn_mfma_f32_16x16x32_bf16(fq2, fb, aqk[q], 0, 0, 0);
                }
            }
#pragma unroll
            for (int q = 0; q < 2; ++q)
#pragma unroll
                for (int j = 0; j < 4; ++j) {
                    const int c_ = mt * 16 + kq * 4 + j, s_ = (ntb + q) * 16 + r16;
                    const float dec = __expf(s_ <= c_ ? gcs[c_] - gcs[s_] : 0.f);
                    const float lv = (s_ < c_) ? bes[c_] * akk[q][j] * dec : 0.f;
                    Lm[c_ * 64 + s_] = lv;
                    if (c_ >= 32 && s_ < 32) LB21[(c_ - 32) * 40 + s_] = (bf16_t)(cvt_pk_bf16(lv, 0.f) & 0xffffu);
                    float av = (s_ <= c_) ? aqk[q][j] * dec : 0.f; if (ch == 0 && c_ == 0 && s_ == 0) av = gcs[256];
                    Ab[c_ * 72 + s_] = (bf16_t)(cvt_pk_bf16(av, 0.f) & 0xffffu);
                }
        }
        lds_barrier();
        {
            LAS float* bp = (tid < 64) ? (U + tid) : (ks + (tid - 64)); const int bstr = (tid < 64) ? 65 : 128;
            if (tid < 192) {
                float x[32];
#pragma unroll
                for (int i = 0; i < 32; ++i) x[i] = 0.f;
#pragma unroll
                for (int i = 0; i < 32; ++i) {
                    float a0 = bp[i * bstr], a1 = 0.f;
#pragma unroll
                    for (int m4 = 0; m4 < (i + 3) / 4; ++m4) { const f32x4 l = *(LAS f32x4*)(Lm + i * 64 + m4 * 4);
                        a0 -= l[0] * x[m4 * 4 + 0]; a1 -= l[1] * x[m4 * 4 + 1]; a0 -= l[2] * x[m4 * 4 + 2]; a1 -= l[3] * x[m4 * 4 + 3]; }
                    x[i] = a0 + a1;
                }
                if (tid < 64) {
#pragma unroll
                    for (int i = 0; i < 32; ++i) U[i * 65 + tid] = x[i];
                } else {
#pragma unroll
                    for (int i = 0; i < 32; ++i) kb[i * 136 + (tid - 64)] = (bf16_t)(cvt_pk_bf16(x[i], 0.f) & 0xffffu);
                }
#pragma unroll
                for (int i8 = 0; i8 < 4; ++i8) { u32x4 t; t.x = cvt_pk_bf16(x[i8 * 8 + 0], x[i8 * 8 + 1]); t.y = cvt_pk_bf16(x[i8 * 8 + 2], x[i8 * 8 + 3]); t.z = cvt_pk_bf16(x[i8 * 8 + 4], x[i8 * 8 + 5]); t.w = cvt_pk_bf16(x[i8 * 8 + 6], x[i8 * 8 + 7]);
                    *(LAS u32x4*)(XT + tid * 32 + i8 * 8) = t; }
            }
            lds_barrier();
#pragma unroll
            for (int q = 0; q < 3; ++q) {
                const int t_ = w * 3 + q, mt = t_ & 1, nt = t_ >> 1;
                const bf16x8 fa = *(const LAS bf16x8*)(LB21 + (mt * 16 + r16) * 40 + kq * 8);
                const bf16x8 fb = *(const LAS bf16x8*)(XT + (nt * 16 + r16) * 32 + kq * 8);
                const f32x4 cacc = __builtin_amdgcn_mfma_f32_16x16x32_bf16(fa, fb, (f32x4){0.f, 0.f, 0.f, 0.f}, 0, 0, 0);
                const int col_ = nt * 16 + r16;
                LAS float* cp_ = (col_ < 64) ? (U + col_) : (ks + (col_ - 64)); const int cstr = (col_ < 64) ? 65 : 128;
#pragma unroll
                for (int j = 0; j < 4; ++j) cp_[(32 + mt * 16 + kq * 4 + j) * cstr] -= cacc[j];
            }
            lds_barrier();
            if (tid < 192) {
                float x[32];
#pragma unroll
                for (int i = 0; i < 32; ++i) x[i] = 0.f;
#pragma unroll
                for (int i = 0; i < 32; ++i) {
                    float a0 = bp[(32 + i) * bstr], a1 = 0.f;
#pragma unroll
                    for (int m4 = 0; m4 < (i + 3) / 4; ++m4) { const f32x4 l = *(LAS f32x4*)(Lm + (32 + i) * 64 + 32 + m4 * 4);
                        a0 -= l[0] * x[m4 * 4 + 0]; a1 -= l[1] * x[m4 * 4 + 1]; a0 -= l[2] * x[m4 * 4 + 2]; a1 -= l[3] * x[m4 * 4 + 3]; }
                    x[i] = a0 + a1;
                }
                if (tid < 64) {
#pragma unroll
                    for (int i = 0; i < 32; ++i) U[(32 + i) * 65 + tid] = x[i];
                } else {
#pragma unroll
                    for (int i = 0; i < 32; ++i) kb[(32 + i) * 136 + (tid - 64)] = (bf16_t)(cvt_pk_bf16(x[i], 0.f) & 0xffffu);
                }
            }
        }
        lds_barrier();
        const u32x4 zr = *(const u32x4*)(u + (size_t)(tbase + tl8) * NU + 1536 + h * 128 + sl * 64 + c8 * 8);
        const float* nwp = p.dn_norm_w + layer * 128 + sl * 64 + c8 * 8 + opaque0(); const f32x4 nw0 = *(const f32x4*)nwp, nw1 = *(const f32x4*)(nwp + 4);
        f32x4 qsv[2];
        const int mtE = w & 3, ntE = (w >> 2) * 2;
        {
            f32x4 aws[2] = {(f32x4){0.f, 0.f, 0.f, 0.f}, (f32x4){0.f, 0.f, 0.f, 0.f}}, aqs[2] = {aws[0], aws[0]};
#pragma unroll
            for (int kk = 0; kk < 4; ++kk) {
                const bf16x8 fw = *(const LAS bf16x8*)(kb + (mtE * 16 + r16) * 136 + kk * 32 + kq * 8);
                const bf16x8 fq2 = *(const LAS bf16x8*)(qb + (mtE * 16 + r16) * 136 + kk * 32 + kq * 8);
#pragma unroll
                for (int q = 0; q < 2; ++q) {
                    const bf16x8 fs = *(const LAS bf16x8*)(Stl + ((ntE + q) * 16 + r16) * 136 + kk * 32 + kq * 8);
                    aws[q] = __builtin_amdgcn_mfma_f32_16x16x32_bf16(fw, fs, aws[q], 0, 0, 0);
                    aqs[q] = __builtin_amdgcn_mfma_f32_16x16x32_bf16(fq2, fs, aqs[q], 0, 0, 0);
                }
            }
#pragma unroll
            for (int q = 0; q < 2; ++q)
#pragma unroll
                for (int j = 0; j < 4; ++j) {
                    const int c_ = mtE * 16 + kq * 4 + j, v_ = (ntE + q) * 16 + r16;
                    const float vn = U[c_ * 65 + v_] - aws[q][j];
                    qsv[q][j] = aqs[q][j] * egs[c_];
                    vT[v_ * 72 + c_] = (bf16_t)(cvt_pk_bf16(vn, 0.f) & 0xffffu);
                    vTs[v_ * 72 + c_] = (bf16_t)(cvt_pk_bf16(vn * egl[c_], 0.f) & 0xffffu);
                }
        }
        lds_barrier();
        {
            f32x4 aav[2] = {(f32x4){0.f, 0.f, 0.f, 0.f}, (f32x4){0.f, 0.f, 0.f, 0.f}};
#pragma unroll
            for (int kk = 0; kk < 2; ++kk) {
                const bf16x8 fa = *(const LAS bf16x8*)(Ab + (mtE * 16 + r16) * 72 + kk * 32 + kq * 8);
#pragma unroll
                for (int q = 0; q < 2; ++q) { const bf16x8 fv = *(const LAS bf16x8*)(vT + ((ntE + q) * 16 + r16) * 72 + kk * 32 + kq * 8); aav[q] = __builtin_amdgcn_mfma_f32_16x16x32_bf16(fa, fv, aav[q], 0, 0, 0); }
            }
#pragma unroll
            for (int q = 0; q < 2; ++q)
#pragma unroll
                for (int j = 0; j < 4; ++j) os[(mtE * 16 + kq * 4 + j) * 64 + (ntE + q) * 16 + r16] = qsv[q][j] + aav[q][j];
            const float ge = __expf(gcs[63]);
            const int mtS = w & 3, ntS = (w >> 2) * 4;
#pragma unroll
            for (int q = 0; q < 4; ++q) {
                Sacc[q] *= ge;
#pragma unroll
                for (int kk = 0; kk < 2; ++kk) {
                    const bf16x8 fv = *(const LAS bf16x8*)(vTs + (mtS * 16 + r16) * 72 + kk * 32 + kq * 8);
                    const bf16x8 fk_ = *(const LAS bf16x8*)(kT + ((ntS + q) * 16 + r16) * 72 + kk * 32 + kq * 8);
                    Sacc[q] = __builtin_amdgcn_mfma_f32_16x16x32_bf16(fv, fk_, Sacc[q], 0, 0, 0);
                }
            }
        }
        lds_barrier();
#pragma unroll
        for (int q = 0; q < 4; ++q)
#pragma unroll
            for (int j = 0; j < 4; ++j) Stl[((w & 3) * 16 + kq * 4 + j) * 136 + ((w >> 2) * 4 + q) * 16 + r16] = (bf16_t)(cvt_pk_bf16(Sacc[q][j], 0.f) & 0xffffu);
        {
            const int token = tbase + tl8;
            const f32x4 o4 = *(LAS f32x4*)(os + tl8 * 64 + c8 * 8), o5 = *(LAS f32x4*)(os + tl8 * 64 + c8 * 8 + 4);
            float ss = ((o4[0] * o4[0] + o4[1] * o4[1]) + (o4[2] * o4[2] + o4[3] * o4[3])) + ((o5[0] * o5[0] + o5[1] * o5[1]) + (o5[2] * o5[2] + o5[3] * o5[3]));
            ss += __shfl_xor(ss, 1); ss += __shfl_xor(ss, 2); ss += __shfl_xor(ss, 4);
            if (c8 == 0) { sta[((size_t)token * 4 + h) * 4 + sl] = ss; sta[((size_t)token * 4 + h) * 4 + 2 + sl] = 0.f; }
            u32x4 wv2;
            wv2.x = cvt_pk_bf16(o4[0] * nw0[0] * siluf_(bflo(zr.x)), o4[1] * nw0[1] * siluf_(bfhi(zr.x))); wv2.y = cvt_pk_bf16(o4[2] * nw0[2] * siluf_(bflo(zr.y)), o4[3] * nw0[3] * siluf_(bfhi(zr.y)));
            wv2.z = cvt_pk_bf16(o5[0] * nw1[0] * siluf_(bflo(zr.z)), o5[1] * nw1[1] * siluf_(bfhi(zr.z))); wv2.w = cvt_pk_bf16(o5[2] * nw1[2] * siluf_(bflo(zr.w)), o5[3] * nw1[3] * siluf_(bfhi(zr.w)));
            *(u32x4*)(ya + (size_t)token * 512 + h * 128 + sl * 64 + c8 * 8) = wv2;
        }
        lds_barrier();
    }
#undef DN_PREFETCH
}

constexpr int RT_QB = 0, RT_KB = 9216, RT_KZT = 18432, RT_VT = 27648, RT_PB = 32256, RT_ST = 41472, RT_OS = 46080, RT_MISC = 54272;
__device__ __forceinline__ void retention_item(const Params& p, int item, LAS unsigned char* Lb, const int wv_) {
    const int tid0 = TIDX, w = wv_;
    const int b = item >> 4, h = (item >> 2) & 3, sl = item & 3;
    LAS bf16_t* qb = (LAS bf16_t*)(Lb + RT_QB); LAS bf16_t* kb = (LAS bf16_t*)(Lb + RT_KB);
    LAS bf16_t* kzT = (LAS bf16_t*)(Lb + RT_KZT);
    LAS bf16_t* vT = (LAS bf16_t*)(Lb + RT_VT);
    LAS bf16_t* Pb = (LAS bf16_t*)(Lb + RT_PB);
    LAS bf16_t* Stl = (LAS bf16_t*)(Lb + RT_ST);
    LAS float* os = (LAS float*)(Lb + RT_OS); LAS float* misc = (LAS float*)(Lb + RT_MISC);
    const bf16_t* u = (const bf16_t*)(p.ws + WS_U);
    float* stb = (float*)(p.ws + WS_STB); bf16_t* yb = (bf16_t*)(p.ws + WS_Y) + (size_t)MTOK * 512;
    const float* rtab = (const float*)(p.ws + WS_ROT);
    const float lg2 = log2f(1.0f - exp2f(-5.0f - (float)h));
    f32x4 Sacc = (f32x4){0.f, 0.f, 0.f, 0.f};
    for (int i = tid0; i < 32 * 72 / 2; i += 512) ((LAS unsigned*)Stl)[i] = 0u;
    u32x2 rq1, rq2, rk1, rk2, rvv; f32x4 rcs0, rcs1;
#define RT_PREFETCH(CH) do { const int tid_ = TIDX; const int tl8_ = tid_ >> 3, c8_ = tid_ & 7; const int token_ = b * SEQ + (CH) * 64 + tl8_; const bf16_t* ur_ = u + (size_t)token_ * NU; \
        rq1 = *(const u32x2*)(ur_ + 2048 + h * 64 + c8_ * 4); rq2 = *(const u32x2*)(ur_ + 2048 + h * 64 + 32 + c8_ * 4); \
        rk1 = *(const u32x2*)(ur_ + 2304 + h * 64 + c8_ * 4); rk2 = *(const u32x2*)(ur_ + 2304 + h * 64 + 32 + c8_ * 4); \
        rvv = *(const u32x2*)(ur_ + 2560 + h * 128 + sl * 32 + c8_ * 4); \
        rcs0 = *(const f32x4*)(rtab + ((size_t)token_ * 32 + c8_ * 4) * 2); rcs1 = *(const f32x4*)(rtab + ((size_t)token_ * 32 + c8_ * 4) * 2 + 4); } while (0)
    RT_PREFETCH(0);
    for (int ch = 0; ch < 32; ++ch) {
        const int tid = TIDX, lane = tid & 63, tl8 = tid >> 3, c8 = tid & 7, r16 = lane & 15, kq = lane >> 4;
        const int token = b * SEQ + ch * 64 + tl8;
        {
            float q1f[4] = {bflo(rq1.x), bfhi(rq1.x), bflo(rq1.y), bfhi(rq1.y)}, q2f[4] = {bflo(rq2.x), bfhi(rq2.x), bflo(rq2.y), bfhi(rq2.y)};
            float k1f[4] = {bflo(rk1.x), bfhi(rk1.x), bflo(rk1.y), bfhi(rk1.y)}, k2f[4] = {bflo(rk2.x), bfhi(rk2.x), bflo(rk2.y), bfhi(rk2.y)};
            if (ch == 0 && tl8 == 0) {
                const float* u0p = (const float*)(p.ws + WS_U0); const int cb_ = 1024 + h * 64 + c8 * 4;
#pragma unroll
                for (int j = 0; j < 4; ++j) { q1f[j] = u0_read(u0p, b, cb_ + j); q2f[j] = u0_read(u0p, b, cb_ + 32 + j); k1f[j] = u0_read(u0p, b, cb_ + 256 + j); k2f[j] = u0_read(u0p, b, cb_ + 256 + 32 + j); }
            }
            float qo1[4], qo2[4], ko1[4], ko2[4]; float d00 = 0.f;
#pragma unroll
            for (int j = 0; j < 4; ++j) { const float cs = (j < 2) ? rcs0[2 * j] : rcs1[2 * (j - 2)], sn = (j < 2) ? rcs0[2 * j + 1] : rcs1[2 * (j - 2) + 1];
                qo1[j] = q1f[j] * cs - q2f[j] * sn; qo2[j] = q1f[j] * sn + q2f[j] * cs;
                ko1[j] = (k1f[j] * cs - k2f[j] * sn) * 0.125f; ko2[j] = (k1f[j] * sn + k2f[j] * cs) * 0.125f;
                d00 += qo1[j] * ko1[j] + qo2[j] * ko2[j]; }
            if (ch == 0) { d00 += __shfl_xor(d00, 1); d00 += __shfl_xor(d00, 2); d00 += __shfl_xor(d00, 4); if (tid == 0) misc[0] = d00; }
            u32x2 wq1, wq2, wk1, wk2;
            wq1.x = cvt_pk_bf16(qo1[0], qo1[1]); wq1.y = cvt_pk_bf16(qo1[2], qo1[3]); wq2.x = cvt_pk_bf16(qo2[0], qo2[1]); wq2.y = cvt_pk_bf16(qo2[2], qo2[3]);
            wk1.x = cvt_pk_bf16(ko1[0], ko1[1]); wk1.y = cvt_pk_bf16(ko1[2], ko1[3]); wk2.x = cvt_pk_bf16(ko2[0], ko2[1]); wk2.y = cvt_pk_bf16(ko2[2], ko2[3]);
            *(LAS u32x2*)(qb + tl8 * 72 + c8 * 4) = wq1; *(LAS u32x2*)(qb + tl8 * 72 + 32 + c8 * 4) = wq2;
            *(LAS u32x2*)(kb + tl8 * 72 + c8 * 4) = wk1; *(LAS u32x2*)(kb + tl8 * 72 + 32 + c8 * 4) = wk2;
            const float zeta = exp2f((float)(63 - tl8) * lg2);
#pragma unroll
            for (int j = 0; j < 4; ++j) { kzT[(c8 * 4 + j) * 72 + tl8] = (bf16_t)(cvt_pk_bf16(ko1[j] * zeta, 0.f) & 0xffffu); kzT[(32 + c8 * 4 + j) * 72 + tl8] = (bf16_t)(cvt_pk_bf16(ko2[j] * zeta, 0.f) & 0xffffu); }
            vT[(c8 * 4 + 0) * 72 + tl8] = (bf16_t)(rvv.x & 0xffffu); vT[(c8 * 4 + 1) * 72 + tl8] = (bf16_t)(rvv.x >> 16);
            vT[(c8 * 4 + 2) * 72 + tl8] = (bf16_t)(rvv.y & 0xffffu); vT[(c8 * 4 + 3) * 72 + tl8] = (bf16_t)(rvv.y >> 16);
        }
        lds_barrier();
        if (ch + 1 < 32) RT_PREFETCH(ch + 1);
        f32x4 cross = (f32x4){0.f, 0.f, 0.f, 0.f};
        const int mtE = w & 3, ntE = w >> 2;
        {
            const int mt = w & 3, ntb = (w >> 2) * 2;
            f32x4 asc[2] = {(f32x4){0.f, 0.f, 0.f, 0.f}, (f32x4){0.f, 0.f, 0.f, 0.f}};
#pragma unroll
            for (int kk = 0; kk < 2; ++kk) {
                const bf16x8 fq2 = *(const LAS bf16x8*)(qb + (mt * 16 + r16) * 72 + kk * 32 + kq * 8);
#pragma unroll
                for (int q = 0; q < 2; ++q) { const bf16x8 fb = *(const LAS bf16x8*)(kb + ((ntb + q) * 16 + r16) * 72 + kk * 32 + kq * 8); asc[q] = __builtin_amdgcn_mfma_f32_16x16x32_bf16(fq2, fb, asc[q], 0, 0, 0); }
                const bf16x8 fs = *(const LAS bf16x8*)(Stl + (ntE * 16 + r16) * 72 + kk * 32 + kq * 8);
                cross = __builtin_amdgcn_mfma_f32_16x16x32_bf16(fq2, fs, cross, 0, 0, 0);
            }
#pragma unroll
            for (int q = 0; q < 2; ++q)
#pragma unroll
                for (int j = 0; j < 4; ++j) {
                    const int c_ = mt * 16 + kq * 4 + j, s_ = (ntb + q) * 16 + r16;
                    float sc = (s_ <= c_) ? asc[q][j] * exp2f((float)(c_ - s_) * lg2) : 0.f;
                    if (ch == 0 && c_ == 0 && s_ == 0) sc = misc[0];
                    Pb[c_ * 72 + s_] = (bf16_t)(cvt_pk_bf16(sc, 0.f) & 0xffffu);
                }
#pragma unroll
            for (int j = 0; j < 4; ++j) cross[j] *= exp2f((float)(mtE * 16 + kq * 4 + j + 1) * lg2);
        }
        lds_barrier();
        {
            f32x4 inner = (f32x4){0.f, 0.f, 0.f, 0.f};
#pragma unroll
            for (int kk = 0; kk < 2; ++kk) {
                const bf16x8 fa = *(const LAS bf16x8*)(Pb + (mtE * 16 + r16) * 72 + kk * 32 + kq * 8);
                const bf16x8 fv = *(const LAS bf16x8*)(vT + (ntE * 16 + r16) * 72 + kk * 32 + kq * 8);
                inner = __builtin_amdgcn_mfma_f32_16x16x32_bf16(fa, fv, inner, 0, 0, 0);
            }
#pragma unroll
            for (int j = 0; j < 4; ++j) os[(mtE * 16 + kq * 4 + j) * 32 + ntE * 16 + r16] = cross[j] + inner[j];
            const int mtS = w & 1, ntS = w >> 1;
            Sacc *= exp2f(64.0f * lg2);
#pragma unroll
            for (int kk = 0; kk < 2; ++kk) {
                const bf16x8 fv = *(const LAS bf16x8*)(vT + (mtS * 16 + r16) * 72 + kk * 32 + kq * 8);
                const bf16x8 fk_ = *(const LAS bf16x8*)(kzT + (ntS * 16 + r16) * 72 + kk * 32 + kq * 8);
                Sacc = __builtin_amdgcn_mfma_f32_16x16x32_bf16(fv, fk_, Sacc, 0, 0, 0);
            }
        }
        lds_barrier();
#pragma unroll
        for (int j = 0; j < 4; ++j) Stl[((w & 1) * 16 + kq * 4 + j) * 72 + (w >> 1) * 16 + r16] = (bf16_t)(cvt_pk_bf16(Sacc[j], 0.f) & 0xffffu);
        {
            const f32x4 o4 = *(LAS f32x4*)(os + tl8 * 32 + c8 * 4);
            float s1 = (o4[0] + o4[1]) + (o4[2] + o4[3]), s2 = (o4[0] * o4[0] + o4[1] * o4[1]) + (o4[2] * o4[2] + o4[3] * o4[3]);
            s1 += __shfl_xor(s1, 1); s1 += __shfl_xor(s1, 2); s1 += __shfl_xor(s1, 4); s2 += __shfl_xor(s2, 1); s2 += __shfl_xor(s2, 2); s2 += __shfl_xor(s2, 4);
            if (c8 == 0) *(f32x2*)(stb + (((size_t)token * 4 + h) * 4 + sl) * 2) = (f32x2){s1, s2};
            u32x2 wv2; wv2.x = cvt_pk_bf16(o4[0], o4[1]); wv2.y = cvt_pk_bf16(o4[2], o4[3]);
            *(u32x2*)(yb + (size_t)token * 512 + h * 128 + sl * 32 + c8 * 4) = wv2;
        }
        lds_barrier();
    }
#undef RT_PREFETCH
}

__device__ __forceinline__ void lru_item(const Params& p, int layer, int item, LAS unsigned char* Lb, const int wv_) {
    const int tid = TIDX, lane = tid & 63, w = tid >> 6;
    const int b = item >> 4, nb = (item >> 2) & 3, cs = item & 3;
    LAS bf16_t* Wt = (LAS bf16_t*)Lb;
    LAS bf16_t* xcb = (LAS bf16_t*)(Lb + 17408);
    LAS float* xcf = (LAS float*)(Lb + 34816);
    LAS float* pre = xcf + 2048;
    LAS float* aa = pre + 4096;
    LAS float* bbs = aa + 2048;
    LAS float* hs = bbs + 2048;
    const bf16_t* u = (const bf16_t*)(p.ws + WS_U); bf16_t* yc = (bf16_t*)(p.ws + WS_Y) + (size_t)2 * MTOK * 512;
    {
        const float* wa = p.lru_wa + ((size_t)layer * 4 + nb) * 128 * 128; const float* wx = p.lru_wx + ((size_t)layer * 4 + nb) * 128 * 128;
        for (int i = tid; i < 8192; i += 512) { const int k = i >> 6, j = i & 63; const float v = j < 32 ? wa[k * 128 + cs * 32 + j] : wx[k * 128 + cs * 32 + j - 32];
            Wt[j * 136 + k] = (bf16_t)(cvt_pk_bf16(v, 0.f) & 0xffffu); }
    }
    const int cp = tid & 63, tg = tid >> 6;
    const int cch = nb * 128 + 2 * cp;
    float cwa[4], cwb[4];
#pragma unroll
    for (int j = 0; j < 4; ++j) { cwa[j] = p.lru_conv_w[((size_t)layer * 4 + j) * 512 + cch]; cwb[j] = p.lru_conv_w[((size_t)layer * 4 + j) * 512 + cch + 1]; }
    const float cba = p.lru_conv_b[layer * 512 + cch], cbb = p.lru_conv_b[layer * 512 + cch + 1];
    const int ce = tid & 31, te = tid >> 5;
    const int och = nb * 128 + cs * 32 + ce;
    const float ba = p.lru_ba[layer * 512 + och], bx = p.lru_bx[layer * 512 + och], sp8 = 8.0f * softplusf_(-p.lru_lambda[layer * 512 + och]);
    const int tl8 = tid >> 3, c8 = tid & 7;
    float hcar = 0.f;
    unsigned rc[11]; u32x2 rgg;
#define LRU_PREFETCH(CH) do { const int t0_ = (CH) * 64 + tg * 8; const bf16_t* up_ = u + (size_t)(b * SEQ + t0_) * NU + 3584 + cch; \
        _Pragma("unroll") for (int i_ = 0; i_ < 11; ++i_) { rc[i_] = 0u; if (t0_ - 3 + i_ >= 0) rc[i_] = *(const unsigned*)(up_ + (ptrdiff_t)(i_ - 3) * NU); } \
        rgg = *(const u32x2*)(u + (size_t)(b * SEQ + (CH) * 64 + tl8) * NU + 4096 + nb * 128 + cs * 32 + c8 * 4); } while (0)
    LRU_PREFETCH(0);
    lds_barrier();
    for (int ch = 0; ch < 32; ++ch) {
        const u32x2 gr = rgg;
        {
            float xa[3] = {bflo(rc[0]), bflo(rc[1]), bflo(rc[2])}, xb_[3] = {bfhi(rc[0]), bfhi(rc[1]), bfhi(rc[2])};
#pragma unroll
            for (int i = 0; i < 8; ++i) {
                const float ca = bflo(rc[3 + i]), cb = bfhi(rc[3 + i]);
                const float ya_ = cwa[0] * xa[0] + cwa[1] * xa[1] + cwa[2] * xa[2] + cwa[3] * ca + cba, yb_ = cwb[0] * xb_[0] + cwb[1] * xb_[1] + cwb[2] * xb_[2] + cwb[3] * cb + cbb;
                const int tl = tg * 8 + i;
                *(LAS unsigned*)(xcb + tl * 136 + 2 * cp) = cvt_pk_bf16(ya_, yb_);
                if ((cp >> 4) == cs) *(LAS f32x2*)(xcf + tl * 32 + ((2 * cp) & 31)) = (f32x2){ya_, yb_};
                xa[0] = xa[1]; xa[1] = xa[2]; xa[2] = ca; xb_[0] = xb_[1]; xb_[1] = xb_[2]; xb_[2] = cb;
            }
        }
        if (ch + 1 < 32) LRU_PREFETCH(ch + 1);
        lds_barrier();
        {
            const int mt = w & 3, ntb = (w >> 2) * 2, r16 = lane & 15, kq = lane >> 4;
#pragma unroll
            for (int q = 0; q < 2; ++q) {
                const int ntile = ntb + q; f32x4 acc = (f32x4){0.f, 0.f, 0.f, 0.f};
#pragma unroll
                for (int kk = 0; kk < 4; ++kk) {
                    const bf16x8 af = *(const LAS bf16x8*)(xcb + (mt * 16 + r16) * 136 + kk * 32 + kq * 8);
                    const bf16x8 bf = *(const LAS bf16x8*)(Wt + (ntile * 16 + r16) * 136 + kk * 32 + kq * 8);
                    acc = __builtin_amdgcn_mfma_f32_16x16x32_bf16(af, bf, acc, 0, 0, 0);
                }
#pragma unroll
                for (int j = 0; j < 4; ++j) pre[(mt * 16 + kq * 4 + j) * 64 + ntile * 16 + r16] = acc[j];
            }
        }
        lds_barrier();
#pragma unroll
        for (int i = 0; i < 4; ++i) {
            const int tl = te * 4 + i;
            const float r = sigmoidf_(pre[tl * 64 + ce] + ba), ig = sigmoidf_(pre[tl * 64 + 32 + ce] + bx);
            const float la = -r * sp8; const float a = __expf(la); const float mult = sqrtf(fmaxf(-expm1f(2.0f * la), 0.f));
            aa[tl * 32 + ce] = a; bbs[tl * 32 + ce] = mult * ig * xcf[tl * 32 + ce];
        }
        lds_barrier();
        if (tid < 32) {
#pragma unroll 8
            for (int tl = 0; tl < 64; ++tl) { hcar = aa[tl * 32 + tid] * hcar + bbs[tl * 32 + tid]; hs[tl * 32 + tid] = hcar; }
        }
        lds_barrier();
        {
            const int token = b * SEQ + ch * 64 + tl8;
            const f32x4 h4 = *(LAS f32x4*)(hs + tl8 * 32 + c8 * 4);
            u32x2 wv_; wv_.x = cvt_pk_bf16(h4[0] * gelu_tanh(bflo(gr.x)), h4[1] * gelu_tanh(bfhi(gr.x))); wv_.y = cvt_pk_bf16(h4[2] * gelu_tanh(bflo(gr.y)), h4[3] * gelu_tanh(bfhi(gr.y)));
            *(u32x2*)(yc + (size_t)token * 512 + nb * 128 + cs * 32 + c8 * 4) = wv_;
        }
    }
    lds_barrier();
}

__device__ __forceinline__ void finalize_y(const Params& p, const int wv_) {
    const bf16_t* u = (const bf16_t*)(p.ws + WS_U); const float* sta = (const float*)(p.ws + WS_STA); const float* stb = (const float*)(p.ws + WS_STB);
    bf16_t* ya = (bf16_t*)(p.ws + WS_Y); bf16_t* yb = ya + (size_t)MTOK * 512;
    const int t_ = TIDX;
    for (int i0 = blockIdx.x * 512; i0 < MTOK * 128; i0 += gridDim.x * 512) {
        const int i = i0 + t_; const int token = i >> 7, v = i & 127;
        if (v < 64) {
            const int chn = v * 8, h = chn >> 7;
            const f32x4 s = *(const f32x4*)(sta + ((size_t)token * 4 + h) * 4);
            const float sc = rsqrtf(((s[0] + s[1]) + (s[2] + s[3])) * (1.0f / 128.0f) + EPS);
            u32x4* yp = (u32x4*)(ya + (size_t)token * 512 + chn); const u32x4 r = *yp; u32x4 o;
            o.x = cvt_pk_bf16(bflo(r.x) * sc, bfhi(r.x) * sc); o.y = cvt_pk_bf16(bflo(r.y) * sc, bfhi(r.y) * sc); o.z = cvt_pk_bf16(bflo(r.z) * sc, bfhi(r.z) * sc); o.w = cvt_pk_bf16(bflo(r.w) * sc, bfhi(r.w) * sc);
            *yp = o;
        } else {
            const int chn = (v - 64) * 8, h = chn >> 7;
            const f32x4 sA = *(const f32x4*)(stb + ((size_t)token * 4 + h) * 8), sB = *(const f32x4*)(stb + ((size_t)token * 4 + h) * 8 + 4);
            const float mu = ((sA[0] + sA[2]) + (sB[0] + sB[2])) * (1.0f / 128.0f), ex2 = ((sA[1] + sA[3]) + (sB[1] + sB[3])) * (1.0f / 128.0f);
            const float rstd = rsqrtf(fmaxf(ex2 - mu * mu, 0.f) + EPS);
            u32x4* yp = (u32x4*)(yb + (size_t)token * 512 + chn); const u32x4 r = *yp; const u32x4 g = *(const u32x4*)(u + (size_t)token * NU + 3072 + chn); u32x4 o;
            o.x = cvt_pk_bf16((bflo(r.x) - mu) * rstd * siluf_(bflo(g.x)), (bfhi(r.x) - mu) * rstd * siluf_(bfhi(g.x)));
            o.y = cvt_pk_bf16((bflo(r.y) - mu) * rstd * siluf_(bflo(g.y)), (bfhi(r.y) - mu) * rstd * siluf_(bfhi(g.y)));
            o.z = cvt_pk_bf16((bflo(r.z) - mu) * rstd * siluf_(bflo(g.z)), (bfhi(r.z) - mu) * rstd * siluf_(bfhi(g.z)));
            o.w = cvt_pk_bf16((bflo(r.w) - mu) * rstd * siluf_(bflo(g.w)), (bfhi(r.w) - mu) * rstd * siluf_(bfhi(g.w)));
            *yp = o;
        }
    }
}
__device__ __forceinline__ void ffn_fixup(const Params& p, int layer, const int wv_) {
    const float* side = (const float*)(p.ws + WS_Y); bf16_t* act = (bf16_t*)(p.ws + WS_U);
    const float* cw = p.ffn_conv_w + (size_t)layer * 3 * NUP; const float* cb = p.ffn_conv_b + (size_t)layer * NUP;
    const int t_ = TIDX;
    for (int i0 = blockIdx.x * 512; i0 < 512 * DFF; i0 += gridDim.x * 512) {
        const int i = i0 + t_; const int blk = i / DFF, chn = i - blk * DFF;
        if ((blk & 31) == 0) continue;
        const float* s0 = side + (size_t)blk * 4 * NUP; const float* sm = side + (size_t)(blk - 1) * 4 * NUP;
        const float g0 = s0[chn], g1 = s0[NUP + chn], gm2 = sm[2 * NUP + chn], gm1 = sm[3 * NUP + chn];
        const float v0 = s0[DFF + chn], v1 = s0[NUP + DFF + chn], vm2 = sm[2 * NUP + DFF + chn], vm1 = sm[3 * NUP + DFF + chn];
        const float wg0 = cw[chn], wg1 = cw[NUP + chn], wg2 = cw[2 * NUP + chn], bg = cb[chn];
        const float wv0 = cw[DFF + chn], wv1 = cw[NUP + DFF + chn], wv2 = cw[2 * NUP + DFF + chn], bv = cb[DFF + chn];
        const float pg0 = wg2 * g0 + wg1 * gm1 + wg0 * gm2 + bg, pg1 = wg2 * g1 + wg1 * g0 + wg0 * gm1 + bg;
        const float pv0 = wv2 * v0 + wv1 * vm1 + wv0 * vm2 + bv, pv1 = wv2 * v1 + wv1 * v0 + wv0 * vm1 + bv;
        act[(size_t)(blk * 64) * DFF + chn] = (bf16_t)(cvt_pk_bf16(siluf_(pg0) * pv0, 0.f) & 0xffffu);
        act[(size_t)(blk * 64 + 1) * DFF + chn] = (bf16_t)(cvt_pk_bf16(siluf_(pg1) * pv1, 0.f) & 0xffffu);
    }
}
__device__ __forceinline__ void final_norm(const Params& p, const int wv_) {
    const float* rowsq = (const float*)(p.ws + WS_ROWSQ + MiB);
    const int t_ = TIDX;
    for (int i0 = blockIdx.x * 512; i0 < MTOK * 256; i0 += gridDim.x * 512) {
        const int i = i0 + t_; const int row = i >> 8, c = (i & 255) * 4; const float rs = row_rs(rowsq, row);
        const f32x4 g = *(const f32x4*)(p.final_norm + c); f32x4* xp = (f32x4*)(p.out + (size_t)row * DM + c);
        *xp = *xp * rs * g;
    }
}


#define XB_TMO      128
#define XB_XCNT(j)  (256  + 64 * (j))
#define XB_XSUB(j)  (1280 + 64 * (j))
#define XB_XGEN(j)  (2304 + 64 * (j))
#define XB_TOP      3328
#define XB_TOPGEN   3392
#define XCD_BAR_WORDS 3456
#define XB_SPIN_CAP (1u << 20)
__device__ __forceinline__ unsigned xb_ld(unsigned* p)              { return __hip_atomic_load(p, __ATOMIC_RELAXED, __HIP_MEMORY_SCOPE_AGENT); }
__device__ __forceinline__ unsigned xb_add(unsigned* p, unsigned v) { return __hip_atomic_fetch_add(p, v, __ATOMIC_RELAXED, __HIP_MEMORY_SCOPE_AGENT); }
__device__ __forceinline__ unsigned xb_xcc_id() { return (unsigned)__builtin_amdgcn_s_getreg((3 << 11) | 20) & 0xFu; }
#define XB_SPIN(cond, bar) do { unsigned _sp = 0; while (cond) { __builtin_amdgcn_s_sleep(1); \
    if ((++_sp & 255u) == 0u) { if (xb_ld(&(bar)[XB_TMO])) break; if (_sp > XB_SPIN_CAP) { (void)xb_add(&(bar)[XB_TMO], 1u); break; } } } } while (0)
__device__ __forceinline__ unsigned xcd_complete(unsigned* bar, unsigned x) {
    const unsigned G = gridDim.x; unsigned sum, cnt, mine, sp = 0u;
    for (;;) {
        sum = 0u; cnt = 0u; mine = 0u;
#pragma unroll
        for (unsigned j = 0; j < 16; ++j) { const unsigned c = xb_ld(&bar[XB_XCNT(j)]); sum += c; cnt += (c > 0u) ? 1u : 0u; mine = (j == x) ? c : mine; }
        if (sum == G) break;
        __builtin_amdgcn_s_sleep(1);
        if ((++sp & 255u) == 0u) { if (xb_ld(&bar[XB_TMO])) break; if (sp > XB_SPIN_CAP) { (void)xb_add(&bar[XB_TMO], 1u); break; } }
    }
    return ((mine > 0u ? mine : 1u) << 16) | (cnt > 0u ? cnt : 1u);
}
__device__ __forceinline__ void grid_bar(unsigned* bar, volatile LAS unsigned* st, const unsigned k, const int wv_) {
    asm volatile("s_waitcnt vmcnt(0) lgkmcnt(0)" ::: "memory");
    __syncthreads();
    if (TIDX == 0) {
        const unsigned x = xb_xcc_id();
        unsigned nloc = st[0], nx = st[1];
        if (nloc == 0u) { const unsigned r_ = xcd_complete(bar, x); nloc = r_ >> 16; nx = r_ & 0xffffu; st[0] = nloc; st[1] = nx; }
        const unsigned old = xb_add(&bar[XB_XSUB(x)], 1u);
        if (old + 1u == k * nloc) {
            __builtin_amdgcn_fence(__ATOMIC_RELEASE, "agent");
            asm volatile("s_waitcnt vmcnt(0)" ::: "memory");
            const unsigned og = xb_add(&bar[XB_TOP], 1u);
            if (og + 1u == k * nx) xb_add(&bar[XB_TOPGEN], 1u);
            else XB_SPIN(xb_ld(&bar[XB_TOPGEN]) < k, bar);
            __builtin_amdgcn_fence(__ATOMIC_ACQUIRE, "agent");
            xb_add(&bar[XB_XGEN(x)], 1u);
            asm volatile("s_waitcnt vmcnt(0)" ::: "memory");
        } else {
            XB_SPIN(xb_ld(&bar[XB_XGEN(x)]) < k, bar);
            __builtin_amdgcn_fence(__ATOMIC_ACQUIRE, "agent");
            asm volatile("s_waitcnt vmcnt(0)" ::: "memory");
        }
    }
    __syncthreads();
}

#ifndef TIMING_DUP
#define TIMING_DUP 0
#endif
#ifndef STOP_AT
#define STOP_AT 0
#endif
#define STOP_L 0
__device__ __forceinline__ void dump_bf16(const Params& p, const bf16_t* src, int ld, int col0, const int wv_) {
    const int t_ = TIDX;
    for (int i0 = blockIdx.x * 512; i0 < MTOK * 128; i0 += gridDim.x * 512) {
        const int i = i0 + t_; const int row = i >> 7, c = (i & 127) * 8;
        const u32x4 r = *(const u32x4*)(src + (size_t)row * ld + col0 + (c % ld));
        float* o = p.out + (size_t)row * DM + c;
        *(f32x4*)o = (f32x4){bflo(r.x), bfhi(r.x), bflo(r.y), bfhi(r.y)}; *(f32x4*)(o + 4) = (f32x4){bflo(r.z), bfhi(r.z), bflo(r.w), bfhi(r.w)};
    }
}
__global__ void __launch_bounds__(512, 2) mega(Params kp) {
    extern __shared__ __attribute__((aligned(16))) unsigned char smem[];
    LAS unsigned char* lds = (LAS unsigned char*)smem;
    cg::grid_group grid = cg::this_grid();
    const int G = gridDim.x, c = blockIdx.x;
    const int wv_ = __builtin_amdgcn_readfirstlane((int)threadIdx.x >> 6);
    if (threadIdx.x == 0) stp(lds, kp);
    if (threadIdx.x == 0) { ((LAS unsigned*)(lds + LDS_PARAMS + 208))[0] = 0u; ((LAS unsigned*)(lds + LDS_PARAMS + 208))[1] = 0u; }
    if (c == 0) for (int i = threadIdx.x; i < XCD_BAR_WORDS; i += 512) __hip_atomic_store((unsigned*)(kp.ws + WS_BAR) + i, 0u, __ATOMIC_RELAXED, __HIP_MEMORY_SCOPE_AGENT);
    __syncthreads();
    grid.sync();
    int nbar = 0;
    if (threadIdx.x == 0) (void)xb_add((unsigned*)(kp.ws + WS_BAR) + XB_XCNT(xb_xcc_id()), 1u);
#define WSP(p_, off) ((p_).ws + (off))
    {
        const Params p = ldp(lds);
        rownorm(p, p.x, (float*)WSP(p, WS_ROWSQ + MiB), wv_);
        rot_table(p, wv_);
        prep_layer_main(p, 0, (LAS float*)lds, wv_);
        prep_layer_down(p, 0, (LAS float*)lds, wv_);
    }
    { const Params p = ldp(lds); grid_bar((unsigned*)WSP(p, WS_BAR), (volatile LAS unsigned*)(lds + LDS_PARAMS + 208), (unsigned)(++nbar), wv_); if (TIMING_DUP == 6) grid_bar((unsigned*)WSP(p, WS_BAR), (volatile LAS unsigned*)(lds + LDS_PARAMS + 208), (unsigned)(++nbar), wv_); }

    for (int l = 0; l < DEPTH; ++l) {
        {
            const Params p = ldp(lds);
            StaticOrder S; S.init(WSP(p, WS_XB), (bf16_t*)WSP(p, WS_W) + W_IN, MTOK, NU, 1024, G, c);
            EpiScale<0> E; E.O = (bf16_t*)WSP(p, WS_U); E.ldc = NU; E.rowsq = (const float*)WSP(p, WS_ROWSQ + MiB);
            for (int rep = 0; rep < ((TIMING_DUP == 5) ? 2 + __builtin_amdgcn_readfirstlane(opaque0()) : 1); ++rep)
            gemm_phase(lds, 1024, S, E, wv_);
        }
        { const Params p = ldp(lds); ab_tail(p, wv_); u0_tail(p, l, (LAS float*)lds, wv_); }
        { const Params p = ldp(lds); grid_bar((unsigned*)WSP(p, WS_BAR), (volatile LAS unsigned*)(lds + LDS_PARAMS + 208), (unsigned)(++nbar), wv_); if (TIMING_DUP == 6) grid_bar((unsigned*)WSP(p, WS_BAR), (volatile LAS unsigned*)(lds + LDS_PARAMS + 208), (unsigned)(++nbar), wv_); }
        if (STOP_AT == 1 && l == STOP_L) { const Params p = ldp(lds); dump_bf16(p, (const bf16_t*)WSP(p, WS_U), NU, 0, wv_); return; }
        {
            const int Gh = G >> 1;
            if (c < Gh) { const Params p = ldp(lds); for (int it = c; it < 128; it += Gh) deltanet_item(p, l, it, lds, wv_); }
            else {
                { const Params p = ldp(lds); for (int it = c - Gh; it < 256; it += G - Gh) retention_item(p, it, lds, wv_); }
                { const Params p = ldp(lds); for (int it = c - Gh; it < 256; it += G - Gh) lru_item(p, l, it, lds, wv_); }
                if (l > 0) { const Params p = ldp(lds); prep_layer_down(p, l, (LAS float*)lds, wv_, G - Gh, c - Gh); }
                if (l + 1 < DEPTH) { const Params p = ldp(lds); prep_layer_main(p, l + 1, (LAS float*)lds, wv_, 1, G - Gh, c - Gh); }
            }
        }
        { const Params p = ldp(lds); grid_bar((unsigned*)WSP(p, WS_BAR), (volatile LAS unsigned*)(lds + LDS_PARAMS + 208), (unsigned)(++nbar), wv_); if (TIMING_DUP == 6) grid_bar((unsigned*)WSP(p, WS_BAR), (volatile LAS unsigned*)(lds + LDS_PARAMS + 208), (unsigned)(++nbar), wv_); }
        if (STOP_AT == 2 && l == STOP_L) { const Params p = ldp(lds); dump_bf16(p, (const bf16_t*)WSP(p, WS_Y) + (size_t)2 * MTOK * 512, 512, 0, wv_); return; }
        if (STOP_AT == 12 && l == STOP_L) { const Params p = ldp(lds); dump_bf16(p, (const bf16_t*)WSP(p, WS_Y), 512, 0, wv_); return; }
        if (STOP_AT == 13 && l == STOP_L) { const Params p = ldp(lds); dump_bf16(p, (const bf16_t*)WSP(p, WS_Y) + (size_t)MTOK * 512, 512, 0, wv_); return; }
        {
            const Params p = ldp(lds);
            finalize_y(p, wv_);
        }
        { const Params p = ldp(lds); grid_bar((unsigned*)WSP(p, WS_BAR), (volatile LAS unsigned*)(lds + LDS_PARAMS + 208), (unsigned)(++nbar), wv_); if (TIMING_DUP == 6) grid_bar((unsigned*)WSP(p, WS_BAR), (volatile LAS unsigned*)(lds + LDS_PARAMS + 208), (unsigned)(++nbar), wv_); }
        if (STOP_AT == 3 && l == STOP_L) { const Params p = ldp(lds); dump_bf16(p, (const bf16_t*)WSP(p, WS_Y), 512, 0, wv_); return; }
        {
            const Params p = ldp(lds);
            StaticOrder S; S.init(WSP(p, WS_XB), (bf16_t*)WSP(p, WS_W) + W_G, MTOK, NG, 1024, G, c);
            EpiScale<1> E; E.O = (bf16_t*)WSP(p, WS_U); E.ldc = NG; E.rowsq = (const float*)WSP(p, WS_ROWSQ + MiB);
            for (int rep = 0; rep < ((TIMING_DUP == 5) ? 2 + __builtin_amdgcn_readfirstlane(opaque0()) : 1); ++rep)
            gemm_phase(lds, 1024, S, E, wv_);
        }
        { const Params p = ldp(lds); grid_bar((unsigned*)WSP(p, WS_BAR), (volatile LAS unsigned*)(lds + LDS_PARAMS + 208), (unsigned)(++nbar), wv_); if (TIMING_DUP == 6) grid_bar((unsigned*)WSP(p, WS_BAR), (volatile LAS unsigned*)(lds + LDS_PARAMS + 208), (unsigned)(++nbar), wv_); }
        if (STOP_AT == 4 && l == STOP_L) { const Params p = ldp(lds); dump_bf16(p, (const bf16_t*)WSP(p, WS_U), NG, 0, wv_); return; }
        {
            const Params p = ldp(lds);
            BranchOrder S; S.Y = (const char*)WSP(p, WS_Y); S.Wb = (const char*)((bf16_t*)WSP(p, WS_W) + W_B); S.G = G; S.c = c;
            EpiMerge E; E.gates = (const bf16_t*)WSP(p, WS_U); E.scratch = (float*)WSP(p, WS_XB) + (size_t)c * 65536; E.merged = (bf16_t*)WSP(p, WS_U + 192 * MiB);
            gemm_phase(lds, 512, S, E, wv_);
        }
        { const Params p = ldp(lds); grid_bar((unsigned*)WSP(p, WS_BAR), (volatile LAS unsigned*)(lds + LDS_PARAMS + 208), (unsigned)(++nbar), wv_); if (TIMING_DUP == 6) grid_bar((unsigned*)WSP(p, WS_BAR), (volatile LAS unsigned*)(lds + LDS_PARAMS + 208), (unsigned)(++nbar), wv_); }
        if (STOP_AT == 5 && l == STOP_L) { const Params p = ldp(lds); dump_bf16(p, (const bf16_t*)WSP(p, WS_U + 192 * MiB), DM, 0, wv_); return; }
        {
            const Params p = ldp(lds);
            StaticOrder S; S.init(WSP(p, WS_U + 192 * MiB), (bf16_t*)WSP(p, WS_W) + W_O, MTOK, DM, 1024, G, c);
            EpiResid E; E.xin = (l == 0) ? p.x : p.out; E.xout = p.out; E.xb = (bf16_t*)WSP(p, WS_XB); E.rowsq = (float*)WSP(p, WS_ROWSQ); E.ex = (LAS float*)(lds + 131072);
            gemm_phase(lds, 1024, S, E, wv_);
        }
        { const Params p = ldp(lds); grid_bar((unsigned*)WSP(p, WS_BAR), (volatile LAS unsigned*)(lds + LDS_PARAMS + 208), (unsigned)(++nbar), wv_); if (TIMING_DUP == 6) grid_bar((unsigned*)WSP(p, WS_BAR), (volatile LAS unsigned*)(lds + LDS_PARAMS + 208), (unsigned)(++nbar), wv_); }
        if (STOP_AT == 6 && l == STOP_L) return;
        {
            const Params p = ldp(lds);
            StaticOrder S; S.init(WSP(p, WS_XB), (bf16_t*)WSP(p, WS_W) + W_UP, MTOK, NUP, 1024, G, c);
            EpiFfn E; E.act = (bf16_t*)WSP(p, WS_U); E.rowsq = (const float*)WSP(p, WS_ROWSQ); E.cw = p.ffn_conv_w + (size_t)l * 3 * NUP; E.cb = p.ffn_conv_b + (size_t)l * NUP; E.side = (float*)WSP(p, WS_Y);
            for (int rep = 0; rep < ((TIMING_DUP == 5) ? 2 + __builtin_amdgcn_readfirstlane(opaque0()) : 1); ++rep)
            gemm_phase(lds, 1024, S, E, wv_);
        }
        { const Params p = ldp(lds); grid_bar((unsigned*)WSP(p, WS_BAR), (volatile LAS unsigned*)(lds + LDS_PARAMS + 208), (unsigned)(++nbar), wv_); if (TIMING_DUP == 6) grid_bar((unsigned*)WSP(p, WS_BAR), (volatile LAS unsigned*)(lds + LDS_PARAMS + 208), (unsigned)(++nbar), wv_); }
        {
            const Params p = ldp(lds);
            ffn_fixup(p, l, wv_);
        }
        if (l + 1 < DEPTH) { const Params p = ldp(lds); prep_layer_main(p, l + 1, (LAS float*)lds, wv_, 2); }
        { const Params p = ldp(lds); grid_bar((unsigned*)WSP(p, WS_BAR), (volatile LAS unsigned*)(lds + LDS_PARAMS + 208), (unsigned)(++nbar), wv_); if (TIMING_DUP == 6) grid_bar((unsigned*)WSP(p, WS_BAR), (volatile LAS unsigned*)(lds + LDS_PARAMS + 208), (unsigned)(++nbar), wv_); }
        if (STOP_AT == 7 && l == STOP_L) { const Params p = ldp(lds); dump_bf16(p, (const bf16_t*)WSP(p, WS_U), DFF, 0, wv_); return; }
        {
            const Params p = ldp(lds);
            StaticOrder S; S.init(WSP(p, WS_U), (bf16_t*)WSP(p, WS_W) + W_DN, MTOK, DM, DFF, G, c);
            EpiResid E; E.xin = p.out; E.xout = p.out; E.xb = (bf16_t*)WSP(p, WS_XB); E.rowsq = (float*)WSP(p, WS_ROWSQ + MiB); E.ex = (LAS float*)(lds + 131072);
            gemm_phase(lds, DFF, S, E, wv_);
        }
        { const Params p = ldp(lds); grid_bar((unsigned*)WSP(p, WS_BAR), (volatile LAS unsigned*)(lds + LDS_PARAMS + 208), (unsigned)(++nbar), wv_); if (TIMING_DUP == 6) grid_bar((unsigned*)WSP(p, WS_BAR), (volatile LAS unsigned*)(lds + LDS_PARAMS + 208), (unsigned)(++nbar), wv_); }
        if (STOP_AT == 8 && l == STOP_L) return;
        if (STOP_AT == 10 && l == STOP_L) { const Params p = ldp(lds); dump_bf16(p, (const bf16_t*)WSP(p, WS_XB), DM, 0, wv_); return; }
        if (STOP_AT == 11 && l == STOP_L) { const Params p = ldp(lds); dump_bf16(p, (const bf16_t*)WSP(p, WS_W) + W_IN, 1024, 0, wv_); return; }
        if (STOP_AT == 9 && l == STOP_L) { const Params p = ldp(lds); const float* rq = (const float*)WSP(p, WS_ROWSQ + MiB); const int t_ = TIDX; for (int i0 = c * 512; i0 < MTOK * 256; i0 += G * 512) { const int i = i0 + t_; const float v = rq[i >> 8]; *(f32x4*)(p.out + (size_t)i * 4) = (f32x4){v, v, v, v}; } return; }
    }
    { const Params p = ldp(lds); final_norm(p, wv_); }
}

constexpr int LDS_BYTES = 163328 + 256;
extern "C" void kernel_launch(void* const* d_in, const int* in_sizes, int n_in, void* d_out, int out_size, void* d_ws, size_t ws_size, hipStream_t stream) {
    static int grid = 0;
    if (grid == 0) {
        int dev = 0, cus = 0, per_cu = 0;
        hipGetDevice(&dev);
        hipDeviceGetAttribute(&cus, hipDeviceAttributeMultiprocessorCount, dev);
        if (hipFuncSetAttribute((const void*)mega, hipFuncAttributeMaxDynamicSharedMemorySize, LDS_BYTES) != hipSuccess) fprintf(stderr, "kernel_launch: hipFuncSetAttribute failed\n");
        hipOccupancyMaxActiveBlocksPerMultiprocessor(&per_cu, (const void*)mega, 512, LDS_BYTES);
        (void)hipGetLastError();
        if (per_cu < 1) per_cu = 1;
        grid = cus * 1;
        if (grid > 256) grid = 256;
        if (ws_size < 496 * MiB) fprintf(stderr, "kernel_launch: workspace too small: %zu\n", ws_size);
    }
    Params p{};
    p.x = (const float*)d_in[0]; p.pos = (const int*)d_in[1]; p.attn_norm = (const float*)d_in[2]; p.w_in = (const float*)d_in[3]; p.dn_conv_w = (const float*)d_in[4];
    p.dn_a_log = (const float*)d_in[5]; p.dn_dt_bias = (const float*)d_in[6]; p.dn_norm_w = (const float*)d_in[7]; p.lru_conv_w = (const float*)d_in[8]; p.lru_conv_b = (const float*)d_in[9];
    p.lru_wa = (const float*)d_in[10]; p.lru_ba = (const float*)d_in[11]; p.lru_wx = (const float*)d_in[12]; p.lru_bx = (const float*)d_in[13]; p.lru_lambda = (const float*)d_in[14];
    p.w_branch = (const float*)d_in[15]; p.w_out = (const float*)d_in[16]; p.ffn_norm = (const float*)d_in[17]; p.w_up = (const float*)d_in[18]; p.ffn_conv_w = (const float*)d_in[19];
    p.ffn_conv_b = (const float*)d_in[20]; p.w_down = (const float*)d_in[21]; p.final_norm = (const float*)d_in[22];
    p.out = (float*)d_out; p.ws = (unsigned char*)d_ws;
    (void)hipMemsetAsync((unsigned char*)d_ws + WS_BAR, 0, 16384, stream);
    void* args[] = {&p};
    hipError_t e = hipLaunchCooperativeKernel((const void*)mega, dim3(grid), dim3(512), args, LDS_BYTES, stream);
    if (e != hipSuccess) fprintf(stderr, "cooperative launch failed: %s (grid %d)\n", hipGetErrorString(e), grid);
}
```
